# Optimizing an MI355X kernel written in HIP

```python
import math
import jax, jax.numpy as jnp
from jax import lax
import numpy as np

D_MODEL = 1024
BATCH = 16
SEQ = 4096
DEPTH = 1

HEAD_DIM = 64
RWKV_HEADS = 8
RWKV_DIM = RWKV_HEADS * HEAD_DIM
DECAY_LORA = 64
AAA_LORA = 64
GATE_LORA = 128
GN_EPS = 64e-5
ATTN_HEADS = 8
ATTN_DIM = ATTN_HEADS * HEAD_DIM
IDX_HEADS = 8
IDX_DIM = 64
MAX_TOPK = 256
Q_BLOCK = 128
N_BUCKETS = 32
MAX_EXACT = N_BUCKETS // 2
MAX_DISTANCE = 128
N_GROUPS = 4
EXPERTS_PER_GROUP = 8
N_EXPERTS = N_GROUPS * EXPERTS_PER_GROUP
EXPERT_TOP_K = 2
D_EXPERT = 512
LN_EPS = 1e-5
ALPHA = (2 * DEPTH) ** 0.25
BETA = (8 * DEPTH) ** -0.25

RWKV_SIZES = [RWKV_DIM, DECAY_LORA, RWKV_DIM, RWKV_DIM, AAA_LORA, GATE_LORA]
RWKV_COLS = sum(RWKV_SIZES)
IN_SIZES = [RWKV_COLS, ATTN_DIM, ATTN_DIM, ATTN_DIM,
            IDX_HEADS * IDX_DIM, IDX_DIM, IDX_HEADS, D_MODEL, D_MODEL]
N_IN = sum(IN_SIZES)

kernel_name = "hybrid_rwkv7_dsa_hmoe_deepnorm"


def _split(t, sizes):
    return jnp.split(t, [int(i) for i in np.cumsum(sizes)[:-1]], axis=-1)


def _layer_norm(x, g, b, eps=LN_EPS):
    xf = x.astype(jnp.float32)
    mu = jnp.mean(xf, -1, keepdims=True)
    var = jnp.mean(jnp.square(xf - mu), -1, keepdims=True)
    return ((xf - mu) * lax.rsqrt(var + eps)) * g + b


def _t5_bucket(n):
    n = jnp.maximum(n, 0)
    nf = jnp.maximum(n, 1).astype(jnp.float32)
    large = MAX_EXACT + (jnp.log(nf / MAX_EXACT) / math.log(MAX_DISTANCE / MAX_EXACT)
                         * (N_BUCKETS - MAX_EXACT)).astype(jnp.int32)
    large = jnp.minimum(large, N_BUCKETS - 1)
    return jnp.where(n < MAX_EXACT, n, large)


def _rwkv7_step(state, inp):
    r, w, k, v, a, b = inp
    sa = jnp.einsum('bhij,bhj->bhi', state, a)
    state = state * w[:, :, None, :] + sa[..., None] * b[:, :, None, :] + v[..., None] * k[:, :, None, :]
    y = jnp.einsum('bhij,bhj->bhi', state, r)
    return state, y


def _rwkv7_mix(p, mu_shift, w0, w_lora_up, a0, a_lora_up, g_lora_up, k_k, k_a, r_k, ln_x_g, ln_x_b):
    B, S, _ = p.shape
    prev = jnp.pad(p[:, :-1], ((0, 0), (1, 0), (0, 0)))
    p = p + (prev - p) * mu_shift
    r, wd, k, v, ad, gd = _split(p, RWKV_SIZES)
    w = -jax.nn.softplus(-(w0 + jnp.tanh(wd) @ w_lora_up)) - 0.5
    decay = jnp.exp(-jnp.exp(w.astype(jnp.float32)))
    a = jax.nn.sigmoid(a0 + ad @ a_lora_up)
    g = jax.nn.sigmoid(gd) @ g_lora_up
    heads = lambda t: t.reshape(B, S, RWKV_HEADS, HEAD_DIM).astype(jnp.float32)
    kk = heads(k * k_k)
    kk = kk / jnp.maximum(jnp.sqrt(jnp.sum(kk * kk, -1, keepdims=True)), 1e-12)
    k = k * (1.0 + (a - 1.0) * k_a)
    r_h, k_h, v_h, a_h, w_h = heads(r), heads(k), heads(v), heads(a), heads(decay)
    xs = tuple(jnp.moveaxis(t, 1, 0) for t in (r_h, w_h, k_h, v_h, -kk, kk * a_h))
    state0 = jnp.zeros((B, RWKV_HEADS, HEAD_DIM, HEAD_DIM), jnp.float32)
    _, y = lax.scan(_rwkv7_step, state0, xs)
    y = jnp.moveaxis(y, 0, 1)
    mu = jnp.mean(y, -1, keepdims=True)
    var = jnp.mean(jnp.square(y - mu), -1, keepdims=True)
    y = ((y - mu) * lax.rsqrt(var + GN_EPS)).reshape(B, S, RWKV_DIM) * ln_x_g + ln_x_b
    bonus = jnp.sum(r_h * k_h * r_k, -1, keepdims=True) * v_h
    return (y + bonus.reshape(B, S, RWKV_DIM)) * g


def _dsa_attention(q, k, v, q_idx, k_idx, w_idx, rel_bias, top_k):
    B, S = q.shape[:2]
    nb = S // Q_BLOCK
    blocks = lambda t: t.reshape(B * nb, Q_BLOCK, *t.shape[2:])
    b_ids = jnp.repeat(jnp.arange(B, dtype=jnp.int32), nb)
    t0s = jnp.tile(jnp.arange(nb, dtype=jnp.int32) * Q_BLOCK, B)
    s_pos = jnp.arange(S, dtype=jnp.int32)

    def one_block(args):
        b, t0, qb, qib, wib = args
        kb, vb, kib = k[b], v[b], k_idx[b]
        t = t0 + jnp.arange(Q_BLOCK, dtype=jnp.int32)
        sc = jax.nn.relu(jnp.einsum('qhd,sd->qhs', qib, kib).astype(jnp.float32) * IDX_DIM ** -0.5)
        index = jnp.einsum('qhs,qh->qs', sc, wib.astype(jnp.float32))
        index = jnp.where(s_pos[None, :] <= t[:, None], index, -jnp.inf)
        _, sel = lax.top_k(index, top_k)
        ks, vs = kb[sel], vb[sel]
        dist = t[:, None] - sel
        bias = rel_bias[_t5_bucket(dist)].astype(jnp.float32)
        logits = jnp.einsum('qhd,qkhd->qhk', qb, ks).astype(jnp.float32) * HEAD_DIM ** -0.5
        logits = logits + jnp.transpose(bias, (0, 2, 1))
        logits = jnp.where((dist >= 0)[:, None, :], logits, -jnp.inf)
        prob = jax.nn.softmax(logits, axis=-1)
        return jnp.einsum('qhk,qkhd->qhd', prob.astype(vs.dtype), vs)

    out = lax.map(one_block, (b_ids, t0s, blocks(q), blocks(q_idx), blocks(w_idx)))
    return out.reshape(B, S, ATTN_DIM)


def _hier_moe(h, w_router_grp, b_router_grp, w_router_exp, b_router_exp, w_gate, w_up, w_down):
    B, S, D = h.shape
    T = B * S
    hf = h.reshape(T, D)
    p_grp = jax.nn.softmax((hf @ w_router_grp + b_router_grp).astype(jnp.float32), axis=-1)
    p_g, g_sel = lax.top_k(p_grp, 1)
    e_logits = (hf @ w_router_exp + b_router_exp).astype(jnp.float32).reshape(T, N_GROUPS, EXPERTS_PER_GROUP)
    e_logits = jnp.take_along_axis(e_logits, g_sel[:, :, None], axis=1)[:, 0]
    p_e = jax.nn.softmax(e_logits, axis=-1)
    top_v, top_i = lax.top_k(p_e, EXPERT_TOP_K)
    gate = p_g * top_v / jnp.sum(top_v, -1, keepdims=True)
    eid = (g_sel * EXPERTS_PER_GROUP + top_i).reshape(-1)
    order = jnp.argsort(eid)
    tok = order // EXPERT_TOP_K
    xs = hf[tok]
    sizes = jnp.bincount(eid, length=N_EXPERTS).astype(jnp.int32)
    hg = lax.ragged_dot(xs, w_gate, sizes)
    hu = lax.ragged_dot(xs, w_up, sizes)
    ys = lax.ragged_dot(jax.nn.silu(hg) * hu, w_down, sizes)
    y = jnp.zeros_like(ys).at[order].set(ys).reshape(T, EXPERT_TOP_K, D)
    return jnp.einsum('tkd,tk->td', y, gate.astype(y.dtype)).reshape(B, S, D)


def setup_inputs(seed: int = 0) -> dict:
    key = jax.random.key(seed)
    ks = jax.random.split(key, 32)
    L = DEPTH
    nrm = lambda k, shape, scale: jax.random.normal(k, shape, jnp.float32) * scale
    v_rwkv0 = RWKV_DIM + DECAY_LORA + RWKV_DIM
    v_attn0 = RWKV_COLS + 2 * ATTN_DIM
    col_scale = (jnp.ones((N_IN,), jnp.float32)
                 .at[v_rwkv0:v_rwkv0 + RWKV_DIM].set(BETA)
                 .at[v_attn0:v_attn0 + ATTN_DIM].set(BETA))
    return {
        "x": nrm(ks[0], (BATCH, SEQ, D_MODEL), 1.0),
        "w_in": nrm(ks[1], (L, D_MODEL, N_IN), D_MODEL ** -0.5) * col_scale,
        "mu_shift": jax.random.uniform(ks[2], (L, RWKV_COLS), jnp.float32),
        "w0": jax.random.uniform(ks[3], (L, RWKV_DIM), jnp.float32, -6.0, -1.0),
        "w_lora_up": nrm(ks[4], (L, DECAY_LORA, RWKV_DIM), 0.5 * DECAY_LORA ** -0.5),
        "a0": nrm(ks[5], (L, RWKV_DIM), 0.1),
        "a_lora_up": nrm(ks[6], (L, AAA_LORA, RWKV_DIM), AAA_LORA ** -0.5),
        "g_lora_up": nrm(ks[7], (L, GATE_LORA, RWKV_DIM), GATE_LORA ** -0.5),
        "k_k": 0.85 + nrm(ks[8], (L, RWKV_DIM), 0.02),
        "k_a": 1.0 + nrm(ks[9], (L, RWKV_DIM), 0.02),
        "r_k": nrm(ks[10], (L, RWKV_HEADS, HEAD_DIM), 0.1),
        "ln_x_g": 1.0 + nrm(ks[11], (L, RWKV_DIM), 0.02),
        "ln_x_b": nrm(ks[12], (L, RWKV_DIM), 0.02),
        "w_branch_a": nrm(ks[13], (L, RWKV_DIM, D_MODEL), BETA * RWKV_DIM ** -0.5),
        "idx_k_ln_g": 1.0 + nrm(ks[14], (L, IDX_DIM), 0.02),
        "idx_k_ln_b": nrm(ks[15], (L, IDX_DIM), 0.02),
        "rel_bias": nrm(ks[16], (N_BUCKETS, ATTN_HEADS), 0.5),
        "w_branch_b": nrm(ks[17], (L, ATTN_DIM, D_MODEL), BETA * ATTN_DIM ** -0.5),
        "w_out": nrm(ks[18], (L, D_MODEL, D_MODEL), BETA * D_MODEL ** -0.5),
        "ln1_g": 1.0 + nrm(ks[19], (L, D_MODEL), 0.02),
        "ln1_b": nrm(ks[20], (L, D_MODEL), 0.02),
        "w_router_grp": nrm(ks[21], (L, D_MODEL, N_GROUPS), D_MODEL ** -0.5),
        "b_router_grp": nrm(ks[22], (L, N_GROUPS), 0.01),
        "w_router_exp": nrm(ks[23], (L, D_MODEL, N_EXPERTS), D_MODEL ** -0.5),
        "b_router_exp": nrm(ks[24], (L, N_EXPERTS), 0.01),
        "w_expert_gate": nrm(ks[25], (L, N_EXPERTS, D_MODEL, D_EXPERT), D_MODEL ** -0.5),
        "w_expert_up": nrm(ks[26], (L, N_EXPERTS, D_MODEL, D_EXPERT), D_MODEL ** -0.5),
        "w_expert_down": nrm(ks[27], (L, N_EXPERTS, D_EXPERT, D_MODEL), BETA * D_EXPERT ** -0.5),
        "ln2_g": 1.0 + nrm(ks[28], (L, D_MODEL), 0.02),
        "ln2_b": nrm(ks[29], (L, D_MODEL), 0.02),
    }


def reference(x, w_in, mu_shift, w0, w_lora_up, a0, a_lora_up, g_lora_up, k_k, k_a, r_k,
              ln_x_g, ln_x_b, w_branch_a, idx_k_ln_g, idx_k_ln_b, rel_bias, w_branch_b, w_out,
              ln1_g, ln1_b, w_router_grp, b_router_grp, w_router_exp, b_router_exp,
              w_expert_gate, w_expert_up, w_expert_down, ln2_g, ln2_b):
    B, S, _ = x.shape
    top_k = min(MAX_TOPK, S // 4)
    h = x
    for l in range(DEPTH):
        p = h @ w_in[l]
        p_rwkv, q, k, v, q_idx, k_idx, w_idx, g_a, g_b = _split(p, IN_SIZES)
        y_a = _rwkv7_mix(p_rwkv, mu_shift[l], w0[l], w_lora_up[l], a0[l], a_lora_up[l], g_lora_up[l],
                         k_k[l], k_a[l], r_k[l], ln_x_g[l], ln_x_b[l]) @ w_branch_a[l]
        hd = lambda t: t.reshape(B, S, ATTN_HEADS, HEAD_DIM)
        k_idx_n = _layer_norm(k_idx, idx_k_ln_g[l], idx_k_ln_b[l]).astype(k_idx.dtype)
        y_b = _dsa_attention(hd(q), hd(k), hd(v), q_idx.reshape(B, S, IDX_HEADS, IDX_DIM), k_idx_n,
                             w_idx * IDX_HEADS ** -0.5, rel_bias, top_k) @ w_branch_b[l]
        mix = (jax.nn.sigmoid(g_a) * y_a + jax.nn.sigmoid(g_b) * y_b) @ w_out[l]
        h = _layer_norm(ALPHA * h + mix, ln1_g[l], ln1_b[l]).astype(x.dtype)
        moe = _hier_moe(h, w_router_grp[l], b_router_grp[l], w_router_exp[l], b_router_exp[l],
                        w_expert_gate[l], w_expert_up[l], w_expert_down[l])
        h = _layer_norm(ALPHA * h + moe, ln2_g[l], ln2_b[l]).astype(x.dtype)
    return h
```

```cpp
#include <hip/hip_runtime.h>
#include <hip/hip_bf16.h>
#include <hip/hip_cooperative_groups.h>
#include <cstdio>
#include <cstdint>
#include <cmath>
__device__ __forceinline__ int mk_tid() { int t = threadIdx.x; asm volatile("" : "+v"(t)); return t; }
namespace pg8 {
#define PG8_LAS __attribute__((address_space(3)))
typedef unsigned short bf16_t;
typedef short bf16x8 __attribute__((ext_vector_type(8)));
typedef float f32x4 __attribute__((ext_vector_type(4)));
typedef unsigned u32x4 __attribute__((ext_vector_type(4)));
constexpr int BM = 256, BK = 64, HALF = 128, HTB = HALF * BK * 2  , STAGE_BYTES = 8 * HTB, NXCD = 8, WGM = 8;

__host__ __device__ __forceinline__ int lds_byte(int r, int c) { const int st = (r >> 4) * 2 + (c >> 5), rr = r & 15, cc = c & 31, ob = rr * 64 + cc * 2; return st * 1024 + (ob ^ (((ob >> 9) & 1) << 5)); }
__host__ __device__ __forceinline__ void stage_rc(int b, int& R, int& C) { const int st = b / 1024, sb = b % 1024, swz = sb ^ (((sb >> 9) & 1) << 5); R = (st >> 1) * 16 + swz / 64; C = (st & 1) * 32 + (swz % 64) / 2; }
__host__ __device__ __forceinline__ int perm32(int rho) { const int n = rho >> 4, i = rho & 15; return 8 * (i >> 2) + 4 * n + (i & 3); }

struct Unit { int pm, pn; };
struct Gemm { const bf16_t* A; const bf16_t* Bt; int M, N, K; };

struct StaticOrder {
    int nM, nN, nwg, G, c;
    __host__ __device__ void init(int M, int N, int G_, int c_) { nM = M / BM; nN = N / BM; nwg = nM * nN; G = G_; c = c_; }
    __host__ __device__ bool next(int i, Unit& u) const {
        const long L = (long)i * G + c; if (L >= nwg) return false;
        int wgid = (int)L; { const int q = nwg / NXCD, r = nwg % NXCD, xcd = wgid % NXCD, off = wgid / NXCD; wgid = (xcd < r ? xcd * (q + 1) : r * (q + 1) + (xcd - r) * q) + off; }
        const int nig = WGM * nN, gid = wgid / nig, fm = gid * WGM, gsz = (nM - fm) < WGM ? (nM - fm) : WGM;
        u.pm = fm + ((wgid % nig) % gsz); u.pn = (wgid % nig) / gsz; return true;
    }
    __device__ __forceinline__ void a_ready(const Unit&) const {}
    __device__ __forceinline__ void done(const Unit&) const {}
};

__device__ __forceinline__ unsigned cvt_pk_bf16(float lo, float hi) { unsigned r; asm volatile("v_cvt_pk_bf16_f32 %0, %1, %2" : "=v"(r) : "v"(lo), "v"(hi)); return r; }

template <class Epi, class Sched, bool ALIGN_EPI = false, bool SP2 = false>
__device__ __forceinline__ void gemm_phase(PG8_LAS unsigned char* lds, const Gemm g, const Sched& S, const Epi& E) {
    const int tid = mk_tid(), wid = __builtin_amdgcn_readfirstlane(tid >> 6), lane = tid & 63, wr = wid >> 2, wc = wid & 3, fr = lane & 15, fq = lane >> 4;
    const int K = g.K, nt = K / BK;
    unsigned voffA[2], voffB[2];
#pragma unroll
    for (int i = 0; i < 2; ++i) { int R, C; stage_rc(tid * 16 + i * 8192, R, C); const int Rb = Epi::PERM ? ((R & ~31) + perm32(R & 31)) : R;
        voffA[i] = (unsigned)(R * K + C) * 2u; voffB[i] = (unsigned)(Rb * K + C) * 2u; }
    const size_t kstep = (size_t)(BK * 2);
    const size_t hstep = (size_t)HALF * K * 2;
    const size_t tstep = 2 * hstep;
    const unsigned ldsw = (unsigned)wid * 1024u;
    const int aoff = lds_byte(wr * 64 + fr, fq * 8), boff = lds_byte(wc * 32 + fr, fq * 8);
#define PG8_SA(b, h) (((b) * 2 + (h)) * HTB)
#define PG8_SB(b, h) ((4 + (b) * 2 + (h)) * HTB)
#define PG8_STAGE(bufoff, gbase, voff) do { _Pragma("unroll") for (int _i = 0; _i < 2; ++_i) \
        __builtin_amdgcn_global_load_lds((const unsigned*)((const char*)(gbase) + (voff)[_i]), (PG8_LAS unsigned*)(lds + (bufoff) + ldsw + _i * 8192), 16, 0, 0); } while (0)
#define PG8_LDA(dst, b, h) do { _Pragma("unroll") for (int m = 0; m < 4; ++m) _Pragma("unroll") for (int k = 0; k < 2; ++k) dst[m][k] = *(const PG8_LAS bf16x8*)(lds + PG8_SA(b, h) + aoff + m * 2048 + k * 1024); } while (0)
#define PG8_LDB(dst, b, h) do { _Pragma("unroll") for (int n = 0; n < 2; ++n) _Pragma("unroll") for (int k = 0; k < 2; ++k) dst[n][k] = *(const PG8_LAS bf16x8*)(lds + PG8_SB(b, h) + boff + n * 2048 + k * 1024); } while (0)
#define PG8_MMA(ai, bj, At, Bt) do { __builtin_amdgcn_s_setprio(1); _Pragma("unroll") for (int m = 0; m < 4; ++m) _Pragma("unroll") for (int n = 0; n < 2; ++n) _Pragma("unroll") for (int k = 0; k < 2; ++k) \
        acc[ai][bj][m][n] = __builtin_amdgcn_mfma_f32_16x16x32_bf16(Bt[n][k], At[m][k], acc[ai][bj][m][n], 0, 0, 0); __builtin_amdgcn_s_setprio(0); } while (0)
#define PG8_WAIT_V(n) asm volatile("s_waitcnt vmcnt(" #n ")" ::: "memory")
#define PG8_WAIT_L(n) asm volatile("s_waitcnt lgkmcnt(" #n ")" ::: "memory")
#define PG8_BAR __builtin_amdgcn_s_barrier()
#define PG8_SCHED __builtin_amdgcn_sched_barrier(0)
    Unit cur, nxt; int ui = 0;
    if (!S.next(0, cur)) return;
    f32x4 acc[2][2][4][2];
#pragma unroll
    for (int a = 0; a < 2; ++a)
#pragma unroll
        for (int b = 0; b < 2; ++b)
#pragma unroll
            for (int m = 0; m < 4; ++m)
#pragma unroll
                for (int n = 0; n < 2; ++n) acc[a][b][m][n] = (f32x4){0.f, 0.f, 0.f, 0.f};
    bf16x8 At[4][2], B0[2][2], B1[2][2];
    const char* cA = (const char*)g.A + (size_t)cur.pm * tstep; const char* cB = (const char*)g.Bt + (size_t)cur.pn * tstep;
    S.a_ready(cur);
    if constexpr (SP2) {
        PG8_STAGE(PG8_SB(0, 0), cB, voffB); PG8_STAGE(PG8_SB(0, 1), cB + hstep, voffB); PG8_STAGE(PG8_SA(0, 0), cA, voffA); PG8_STAGE(PG8_SA(0, 1), cA + hstep, voffA);
        if (wr == 1) PG8_BAR;
        PG8_WAIT_V(2); PG8_BAR;
        PG8_STAGE(PG8_SB(1, 0), cB + kstep, voffB); PG8_STAGE(PG8_SA(1, 0), cA + kstep, voffA); PG8_STAGE(PG8_SB(1, 1), cB + hstep + kstep, voffB);
        PG8_WAIT_V(6); PG8_BAR;
    } else {
        PG8_STAGE(PG8_SB(0, 0), cB, voffB); PG8_STAGE(PG8_SA(0, 0), cA, voffA); PG8_STAGE(PG8_SB(0, 1), cB + hstep, voffB); PG8_STAGE(PG8_SA(0, 1), cA + hstep, voffA);
        if (wr == 1) PG8_BAR;
        PG8_WAIT_V(4); PG8_BAR;
        PG8_STAGE(PG8_SB(1, 0), cB + kstep, voffB); PG8_STAGE(PG8_SA(1, 0), cA + kstep, voffA); PG8_STAGE(PG8_SB(1, 1), cB + hstep + kstep, voffB);
        PG8_WAIT_V(6); PG8_BAR;
    }
    for (;;) {
        const bool has_next = S.next(ui + 1, nxt);
        const char* nA = has_next ? (const char*)g.A + (size_t)nxt.pm * tstep : cA; const char* nB = has_next ? (const char*)g.Bt + (size_t)nxt.pn * tstep : cB;
        for (int t = 0; t < nt; t += 2) {
            const bool last = (t == nt - 2);
            const char* a1 = cA + (size_t)(t + 1) * kstep;
            const char* a2 = last ? nA : cA + (size_t)(t + 2) * kstep; const char* b2 = last ? nB : cB + (size_t)(t + 2) * kstep;
            const char* a3 = a2 + kstep; const char* b3 = b2 + kstep;
            if (last && has_next) S.a_ready(nxt);
            if constexpr (SP2) {
            PG8_LDB(B0, 0, 0); PG8_LDB(B1, 0, 1); PG8_SCHED; PG8_LDA(At, 0, 0); PG8_STAGE(PG8_SA(1, 1), a1 + hstep, voffA);
            PG8_WAIT_V(8); PG8_WAIT_L(0); PG8_BAR; PG8_MMA(0, 0, At, B0); PG8_MMA(0, 1, At, B1); PG8_BAR; PG8_SCHED;
            PG8_LDA(At, 0, 1); PG8_STAGE(PG8_SB(0, 0), b2, voffB); PG8_STAGE(PG8_SB(0, 1), b2 + hstep, voffB); PG8_STAGE(PG8_SA(0, 0), a2, voffA);
            PG8_WAIT_V(8); PG8_WAIT_L(0); PG8_BAR; PG8_MMA(1, 0, At, B0); PG8_MMA(1, 1, At, B1); PG8_BAR; PG8_SCHED;
            PG8_LDB(B0, 1, 0); PG8_LDB(B1, 1, 1); PG8_SCHED; PG8_LDA(At, 1, 0); PG8_STAGE(PG8_SA(0, 1), a2 + hstep, voffA);
            PG8_WAIT_V(8); PG8_WAIT_L(0); PG8_BAR; PG8_MMA(0, 0, At, B0); PG8_MMA(0, 1, At, B1); PG8_BAR; PG8_SCHED;
            PG8_LDA(At, 1, 1); PG8_STAGE(PG8_SB(1, 0), b3, voffB); PG8_STAGE(PG8_SB(1, 1), b3 + hstep, voffB); PG8_STAGE(PG8_SA(1, 0), a3, voffA);
            PG8_WAIT_V(8); PG8_WAIT_L(0); PG8_BAR; PG8_MMA(1, 0, At, B0); PG8_MMA(1, 1, At, B1); PG8_BAR; PG8_SCHED;
            } else {
            PG8_LDB(B0, 0, 0); PG8_SCHED; PG8_LDA(At, 0, 0); PG8_STAGE(PG8_SA(1, 1), a1 + hstep, voffA);
            PG8_WAIT_L(8); PG8_BAR; PG8_WAIT_L(0); PG8_MMA(0, 0, At, B0); PG8_BAR; PG8_SCHED;
            PG8_LDB(B1, 0, 1); PG8_STAGE(PG8_SB(0, 0), b2, voffB);
            PG8_BAR; PG8_WAIT_L(0); PG8_MMA(0, 1, At, B1); PG8_BAR;
            PG8_LDA(At, 0, 1); PG8_STAGE(PG8_SA(0, 0), a2, voffA);
            PG8_BAR; PG8_WAIT_L(0); PG8_MMA(1, 0, At, B0); PG8_BAR; PG8_SCHED;
            PG8_STAGE(PG8_SB(0, 1), b2 + hstep, voffB);
            PG8_WAIT_V(6); PG8_BAR; PG8_MMA(1, 1, At, B1); PG8_BAR;
            PG8_LDB(B0, 1, 0); PG8_SCHED; PG8_LDA(At, 1, 0); PG8_STAGE(PG8_SA(0, 1), a2 + hstep, voffA);
            PG8_WAIT_L(8); PG8_BAR; PG8_WAIT_L(0); PG8_MMA(0, 0, At, B0); PG8_BAR; PG8_SCHED;
            PG8_LDB(B1, 1, 1); PG8_STAGE(PG8_SB(1, 0), b3, voffB);
            PG8_BAR; PG8_WAIT_L(0); PG8_MMA(0, 1, At, B1); PG8_BAR;
            PG8_LDA(At, 1, 1); PG8_STAGE(PG8_SA(1, 0), a3, voffA);
            PG8_BAR; PG8_WAIT_L(0); PG8_MMA(1, 0, At, B0); PG8_BAR; PG8_SCHED;
            PG8_STAGE(PG8_SB(1, 1), b3 + hstep, voffB);
            PG8_WAIT_V(6); PG8_BAR; PG8_MMA(1, 1, At, B1); PG8_BAR;
            }
        }
        if constexpr (ALIGN_EPI) { if (wr == 0) PG8_BAR; }
        if constexpr (!Epi::AFTER_DRAIN) { E(acc, cur, wr, wc, fr, fq); S.done(cur); }
        if (!has_next) break;
#pragma unroll
        for (int a = 0; a < 2; ++a)
#pragma unroll
            for (int b = 0; b < 2; ++b)
#pragma unroll
                for (int m = 0; m < 4; ++m)
#pragma unroll
                    for (int n = 0; n < 2; ++n) acc[a][b][m][n] = (f32x4){0.f, 0.f, 0.f, 0.f};
        cur = nxt; cA = nA; cB = nB; ++ui;
        if constexpr (ALIGN_EPI) { if (wr == 1) PG8_BAR; }
    }
    PG8_WAIT_V(0);
    if constexpr (!ALIGN_EPI) { if (wr == 0) PG8_BAR; }
    PG8_BAR;
    if constexpr (Epi::AFTER_DRAIN) { E.fused(acc, cur, wr, wc, fr, fq, lds, wid, lane); S.done(cur); }
#undef PG8_SA
#undef PG8_SB
#undef PG8_STAGE
#undef PG8_LDA
#undef PG8_LDB
#undef PG8_MMA
#undef PG8_WAIT_V
#undef PG8_WAIT_L
#undef PG8_BAR
#undef PG8_SCHED
}
}
namespace attn_body {
using bf16=__hip_bfloat16;
using bf16x8=__attribute__((ext_vector_type(8)))short;
using s16x4=__attribute__((ext_vector_type(4)))short;
using f32x16=__attribute__((ext_vector_type(16)))float;
using u32x4=__attribute__((ext_vector_type(4)))unsigned;
constexpr int BATCH=16,NHEAD=8,SEQ=4096,D=64,DM=NHEAD*D;
constexpr int NW=8,QBLK=32,QB=QBLK*NW,KVBLK=64,NQB=SEQ/QB;
constexpr int ATTN_PITCH=DM, ATTN_UNIT_ROWS=QB;
__device__ __forceinline__ int crow(int r,int hi){return (r&3)+8*(r>>2)+4*hi;}
#define SBAR() __builtin_amdgcn_sched_barrier(0)
__device__ __forceinline__ void biasw(f32x16&p0,f32x16&p1,int dbase,const __attribute__((address_space(3))) float*bdl){
  #pragma unroll
  for(int r=0;r<16;++r){const int pos=(r&3)+8*(r>>2);
    int d0=dbase-pos, d1=d0-32; d0=d0<0?0:(d0>127?127:d0); d1=d1<0?0:(d1>127?127:d1); p0[r]+=bdl[d0]; p1[r]+=bdl[d1]; }
}
#define MPOS(r) (((r)&3)+8*((r)>>2))
__device__ __forceinline__ float mand(float p,unsigned w,int pos){ return __builtin_bit_cast(float,__builtin_bit_cast(unsigned,p)&(unsigned)__builtin_amdgcn_sbfe((int)w,pos,1)); }

constexpr int NSLOT=3, SLOTB=8192;
constexpr int LDS_K=0, LDS_V=NSLOT*SLOTB, LDS_WS=2*NSLOT*SLOTB, LDS_OST=LDS_WS+NW*64*4, LDS_BIAS=LDS_OST+NW*4096, LDS_BYTES=LDS_BIAS+NHEAD*128*4;
constexpr float C2=0.125f*1.4426950408889634f;
__device__ __forceinline__ void glds16(const void*gsrc,unsigned lds_dst){unsigned keep;
  asm volatile("s_mov_b32 %0, m0\n\ts_mov_b32 m0, %2\n\ts_nop 0\n\tglobal_load_lds_dwordx4 %1, off\n\ts_mov_b32 m0, %0":"=&s"(keep):"v"(gsrc),"s"(lds_dst):"memory");}
__device__ __forceinline__ float max3f(float a,float b,float c){float r;asm("v_max3_f32 %0, %1, %2, %3":"=v"(r):"v"(a),"v"(b),"v"(c));return r;}
__device__ __forceinline__ float max2f(float a,float b){float r;asm("v_max_f32_e32 %0, %1, %2":"=v"(r):"v"(a),"v"(b));return r;}
__device__ __forceinline__ float fadd_s(float a,float b){float r;asm("v_add_f32_e32 %0, %1, %2":"=v"(r):"v"(a),"v"(b));return r;}
__device__ __forceinline__ float fsub_s(float a,float b){float r;asm("v_sub_f32_e32 %0, %1, %2":"=v"(r):"v"(a),"v"(b));return r;}
typedef float f32x2_t __attribute__((ext_vector_type(2))); typedef __bf16 bf16x2_t __attribute__((ext_vector_type(2)));
__device__ __forceinline__ unsigned cvtpk_s(float lo,float hi){f32x2_t v={lo,hi};bf16x2_t b=__builtin_convertvector(v,bf16x2_t);return __builtin_bit_cast(unsigned,b);}
#define WAIT_BAR(N) asm volatile("s_waitcnt vmcnt(" #N ") lgkmcnt(0)\n\ts_barrier":::"memory")

__device__ __forceinline__ void qkt(f32x16&p0,f32x16&p1,const char*Kslot,const bf16x8*qr,const f32x16&negm,int r32,int hi){
  const char*kb=Kslot+hi*1024+r32*16;
  #pragma unroll
  for(int d0=0;d0<4;++d0){
    const bf16x8 b0=*reinterpret_cast<const bf16x8*>(kb+d0*2048);
    const bf16x8 b1=*reinterpret_cast<const bf16x8*>(kb+d0*2048+512);
    if(d0==0){p0=__builtin_amdgcn_mfma_f32_32x32x16_bf16(b0,qr[0],negm,0,0,0);p1=__builtin_amdgcn_mfma_f32_32x32x16_bf16(b1,qr[0],negm,0,0,0);}
    else{p0=__builtin_amdgcn_mfma_f32_32x32x16_bf16(b0,qr[d0],p0,0,0,0);p1=__builtin_amdgcn_mfma_f32_32x32x16_bf16(b1,qr[d0],p1,0,0,0);}}
}
typedef __attribute__((address_space(3))) const char* lds_cptr;
typedef short v4i16_t __attribute__((ext_vector_type(4)));
__device__ __forceinline__ void kload8(bf16x8*kf,lds_cptr kp){
  kf[0]=*(const __attribute__((address_space(3))) bf16x8*)(kp);      kf[1]=*(const __attribute__((address_space(3))) bf16x8*)(kp+512);
  kf[2]=*(const __attribute__((address_space(3))) bf16x8*)(kp+2048); kf[3]=*(const __attribute__((address_space(3))) bf16x8*)(kp+2560);
  kf[4]=*(const __attribute__((address_space(3))) bf16x8*)(kp+4096); kf[5]=*(const __attribute__((address_space(3))) bf16x8*)(kp+4608);
  kf[6]=*(const __attribute__((address_space(3))) bf16x8*)(kp+6144); kf[7]=*(const __attribute__((address_space(3))) bf16x8*)(kp+6656);
}
__device__ __forceinline__ void kload2(bf16x8*kf,lds_cptr kp,int j){ kf[2*j]=*(const __attribute__((address_space(3))) bf16x8*)(kp+j*2048); kf[2*j+1]=*(const __attribute__((address_space(3))) bf16x8*)(kp+j*2048+512); }
__device__ __forceinline__ s16x4 vtr(lds_cptr p){ return __builtin_bit_cast(s16x4,__builtin_amdgcn_ds_read_tr16_b64_v4i16((__attribute__((address_space(3))) v4i16_t*)p)); }
__device__ __forceinline__ float rowmax(const f32x16&p0,const f32x16&p1){
  float a=max3f(p0[0],p0[1],p1[0]),b=max3f(p0[2],p0[3],p1[1]);a=max3f(a,p1[2],p1[3]);
  #pragma unroll
  for(int r=4;r<16;r+=4){a=max3f(a,p0[r],p0[r+1]);b=max3f(b,p0[r+2],p0[r+3]);a=max3f(a,p1[r],p1[r+1]);b=max3f(b,p1[r+2],p1[r+3]);}
  const float m=max2f(a,b);
  auto rr=__builtin_amdgcn_permlane32_swap(__float_as_uint(m),__float_as_uint(m),false,false);
  return max2f(__uint_as_float(rr[0]),__uint_as_float(rr[1]));
}
__device__ __forceinline__ void pv(f32x16*o,int vb,bf16x8 pa0,bf16x8 pa1,bf16x8 pa2,bf16x8 pa3){
  #pragma unroll
  for(int d0=0;d0<2;++d0){s16x4 lo[4],hi[4];
    #pragma unroll
    for(int ks=0;ks<4;++ks){
      asm volatile("ds_read_b64_tr_b16 %0,%1 offset:%c2":"=&v"(lo[ks]):"v"(vb),"i"(d0*4096+ks*1024):"memory");
      asm volatile("ds_read_b64_tr_b16 %0,%1 offset:%c2":"=&v"(hi[ks]):"v"(vb),"i"(d0*4096+ks*1024+512):"memory");}
    asm volatile("s_waitcnt lgkmcnt(0)":::"memory");SBAR();
    #define PK(k) (bf16x8){lo[k][0],lo[k][1],lo[k][2],lo[k][3],hi[k][0],hi[k][1],hi[k][2],hi[k][3]}
    o[d0]=__builtin_amdgcn_mfma_f32_32x32x16_bf16(pa0,PK(0),o[d0],0,0,0);
    o[d0]=__builtin_amdgcn_mfma_f32_32x32x16_bf16(pa1,PK(1),o[d0],0,0,0);
    o[d0]=__builtin_amdgcn_mfma_f32_32x32x16_bf16(pa2,PK(2),o[d0],0,0,0);
    o[d0]=__builtin_amdgcn_mfma_f32_32x32x16_bf16(pa3,PK(3),o[d0],0,0,0);
    #undef PK
  }
}

#ifndef ATTN_STORE16
#define ATTN_STORE16(p,v) (*(u32x4*)(p)=(v))
#endif
template<int THRL> __device__ __forceinline__ void attn_unit(int b,int h,int qb,const bf16*Q,const bf16*__restrict__ K,const bf16*__restrict__ V,bf16*O,const unsigned long long*MK,char*shm){
  const int tid=mk_tid(),lane=tid&63,r32=lane&31,hi=lane>>5; const int wid=__builtin_amdgcn_readfirstlane(tid>>6);
  const long rowbase=(long)b*SEQ; const int q0=qb*QB;
  const bf16*Qw=Q+(rowbase+q0+wid*QBLK)*DM+h*D;
  const bf16*Kh=K+rowbase*DM+h*D,*Vh=V+rowbase*DM+h*D;
  const lds_cptr shm3=(lds_cptr)shm;
  const unsigned lds0=(unsigned)(uintptr_t)shm;
  float*wsf=(float*)(shm+LDS_WS)+wid*64;
  const bf16*ksrc=Kh+(long)lane*DM+wid*8;
  const bf16*vsrc=Vh+(long)(16*(wid&3)+(lane>>2))*DM+(wid>>2)*32+(lane&3)*8;
  const unsigned kdst=lds0+LDS_K+wid*1024, vdst=lds0+LDS_V+wid*1024;
  #define DMA_K(t,slot) glds16(ksrc+(long)(t)*KVBLK*DM,(unsigned)__builtin_amdgcn_readfirstlane(kdst+(slot)))
  #define DMA_V(t,slot) glds16(vsrc+(long)(t)*KVBLK*DM,(unsigned)__builtin_amdgcn_readfirstlane(vdst+(slot)))
  const int vb0=(int)(lds0+LDS_V)+((lane>>4)&1)*32+(lane&3)*8+(4*hi+((lane&15)>>2))*64;
  const char*Kbase=shm+LDS_K; bf16x8 kf[8];
  const lds_cptr kp0=shm3+LDS_K+hi*1024+r32*16; const lds_cptr vp0=shm3+LDS_V+((lane>>4)&1)*32+(lane&3)*8+(4*hi+((lane&15)>>2))*64;
  const int NT=(q0+QB)/KVBLK;
  const int qrel=wid*QBLK+r32;
  const unsigned long long*mkp=MK+(rowbase+q0+qrel)*64;
  const __attribute__((address_space(3))) float*bdl=(const __attribute__((address_space(3))) float*)(shm3+LDS_BIAS)+h*128;
  unsigned long long mwA,mwB;
  #define MLOAD(M,t) asm volatile("global_load_dwordx2 %0, %1, off":"=&v"(M):"v"(mkp+(t)):"memory")
  #define MPIN(M) asm volatile("":"+v"(M))
  MLOAD(mwA,0);MLOAD(mwB,1);
  DMA_K(0,0);DMA_V(0,0);DMA_K(1,SLOTB);
  bf16x8 qr[4];
  #pragma unroll
  for(int d0=0;d0<4;++d0)qr[d0]=*reinterpret_cast<const bf16x8*>(&Qw[(long)r32*DM+d0*16+hi*8]);
  float mhat=0.f,l_reg=0.f;f32x16 o[2];o[0]=f32x16{};o[1]=f32x16{};const f32x16 negm=f32x16{};
  #define CMASK(P0,P1,t,M) do{ if((t)>=NT-6)biasw(P0,P1,q0+qrel-64*(t)-4*hi,bdl); }while(0)
  bool resc=false;
  #define START(P0,P1) do{ const float rm=rowmax(P0,P1); resc=false; mhat=__builtin_fmaxf(rm,0.f); \
    _Pragma("unroll") for(int r=0;r<16;++r)P0[r]=mand(__builtin_amdgcn_exp2f(P0[r]-mhat),((unsigned)mwA)>>(4*hi),MPOS(r)); }while(0)
  #define RESC() do{ if(resc){ asm volatile("s_waitcnt lgkmcnt(0)":::"memory"); \
      _Pragma("unroll") for(int d_=0;d_<2;++d_) _Pragma("unroll") for(int r=0;r<16;++r)o[d_][r]*=wsf[crow(r,hi)]; } }while(0)
  f32x16 pA0,pA1,pB0,pB1;
  int sl_prev=0,sl_cur=0,sl_next=SLOTB;
  #define ROT() do{sl_prev=sl_cur;sl_cur=sl_next;sl_next=(sl_next==(NSLOT-1)*SLOTB)?0:sl_next+SLOTB;}while(0)
  DMA_K(2,2*SLOTB);
  WAIT_BAR(3); MPIN(mwA); MPIN(mwB);
  qkt(pA0,pA1,Kbase,qr,negm,r32,hi);asm volatile("s_nop 15\n\ts_nop 7":"+v"(pA0),"+v"(pA1));CMASK(pA0,pA1,0,mwA);
  START(pA0,pA1);
  _Pragma("unroll") for(int r=0;r<16;++r)pA1[r]=mand(__builtin_amdgcn_exp2f(pA1[r]-mhat),((unsigned)(mwA>>32))>>(4*hi),MPOS(r));
  WAIT_BAR(0);
  DMA_K(3,0);DMA_V(1,SLOTB);
  ROT();
  kload8(kf,kp0+sl_cur);
  WAIT_BAR(2);
  s16x4 vlo[8],vhi[8]; u32x4 pw0,pw1,pw2,pw3;
  #define PKW(P,B) cvtpk_s(P[B],P[B+1])
  #define PAF(k) __builtin_bit_cast(bf16x8,pw##k)
  #define VFR(i) (bf16x8){vlo[i][0],vlo[i][1],vlo[i][2],vlo[i][3],vhi[i][0],vhi[i][1],vhi[i][2],vhi[i][3]}
  #define PIN(x) asm volatile("":"+v"(x))
  #define MX3(a,b,c) __builtin_fmaxf(__builtin_fmaxf((a),(b)),(c))
  #define GAPA(MF,A0,A1,A2,A3,W0,W1,PW) do{ MF; sacc+=A0; sacc+=A1; sacc+=A2; sacc+=A3; PIN(sacc); W0; W1; PIN(PW); SBAR(); }while(0)
  #define EX(v) __builtin_amdgcn_exp2f(v)
  #define GAPB(MF,X,B,W) do{ MF; X[B]=mand(EX(X[B]-mhat),W,MPOS(B)); X[B+1]=mand(EX(X[B+1]-mhat),W,MPOS(B+1)); X[B+2]=mand(EX(X[B+2]-mhat),W,MPOS(B+2)); X[B+3]=mand(EX(X[B+3]-mhat),W,MPOS(B+3)); PIN(X); SBAR(); }while(0)
  #define VRD(i) do{ vlo[i]=vtr(vp_+(((i)>>2)*4096+((i)&3)*1024)); vhi[i]=vtr(vp_+(((i)>>2)*4096+((i)&3)*1024+512)); }while(0)
  #define KRD(G,j) do{ if(G){ kload2(kf,kp0+sl_next,j); SBAR(); } }while(0)
  #define STEP(C0,C1,P0,P1,t,GK,GV,GL,MC,MN) do{ SBAR(); if(GV){MLOAD(MN,(t)+1);} \
    const lds_cptr vp_=vp0+sl_prev; \
    VRD(0); SBAR(); float sacc=(P0[0]+P0[1]); \
    GAPA(C0=__builtin_amdgcn_mfma_f32_32x32x16_bf16(kf[0],qr[0],negm,0,0,0), P0[2],P0[3],P0[4],P0[5],     pw0[0]=PKW(P0,0), pw0[1]=PKW(P0,2), pw0); \
    VRD(4); SBAR(); GAPA(C1=__builtin_amdgcn_mfma_f32_32x32x16_bf16(kf[1],qr[0],negm,0,0,0), P0[6],P0[7],P0[8],P0[9],     pw0[2]=PKW(P0,4), pw0[3]=PKW(P0,6), pw0); \
    VRD(1); SBAR(); GAPA(C0=__builtin_amdgcn_mfma_f32_32x32x16_bf16(kf[2],qr[1],C0,0,0,0),   P0[10],P0[11],P0[12],P0[13], pw1[0]=PKW(P0,8), pw1[1]=PKW(P0,10), pw1); \
    VRD(5); SBAR(); GAPA(C1=__builtin_amdgcn_mfma_f32_32x32x16_bf16(kf[3],qr[1],C1,0,0,0),   P0[14],P0[15],P1[0],P1[1],   pw1[2]=PKW(P0,12),pw1[3]=PKW(P0,14), pw1); \
    VRD(2); SBAR(); GAPA(C0=__builtin_amdgcn_mfma_f32_32x32x16_bf16(kf[4],qr[2],C0,0,0,0),   P1[2],P1[3],P1[4],P1[5],     pw2[0]=PKW(P1,0), pw2[1]=PKW(P1,2), pw2); \
    VRD(6); SBAR(); GAPA(C1=__builtin_amdgcn_mfma_f32_32x32x16_bf16(kf[5],qr[2],C1,0,0,0),   P1[6],P1[7],P1[8],P1[9],     pw2[2]=PKW(P1,4), pw2[3]=PKW(P1,6), pw2); \
    VRD(3); SBAR(); GAPA(C0=__builtin_amdgcn_mfma_f32_32x32x16_bf16(kf[6],qr[3],C0,0,0,0),   P1[10],P1[11],P1[12],P1[13], pw3[0]=PKW(P1,8), pw3[1]=PKW(P1,10), pw3); \
    VRD(7); SBAR(); GAPA(C1=__builtin_amdgcn_mfma_f32_32x32x16_bf16(kf[7],qr[3],C1,0,0,0),   P1[14],P1[15],0.f,0.f,       pw3[2]=PKW(P1,12),pw3[3]=PKW(P1,14), pw3); \
    l_reg+=sacc; \
    if(GK){DMA_K((t)+3,sl_cur);} if(GV){DMA_V((t)+1,sl_next);} \
    CMASK(C0,C1,t,MC); const unsigned mlo_=((unsigned)(MC))>>(4*hi), mhi_=((unsigned)((MC)>>32))>>(4*hi); \
    { float a=MX3(C0[0],C0[1],C1[0]),b=MX3(C0[2],C0[3],C1[1]); a=MX3(a,C1[2],C1[3]); \
      _Pragma("unroll") for(int r=4;r<16;r+=4){a=MX3(a,C0[r],C0[r+1]);b=MX3(b,C0[r+2],C0[r+3]);a=MX3(a,C1[r],C1[r+1]);b=MX3(b,C1[r+2],C1[r+3]);} \
      float rm=__builtin_fmaxf(a,b); { auto rr=__builtin_amdgcn_permlane32_swap(__float_as_uint(rm),__float_as_uint(rm),false,false); rm=__builtin_fmaxf(__uint_as_float(rr[0]),__uint_as_float(rr[1])); } \
      resc=false; const float rd=rm-mhat; \
      if(__builtin_expect(__any(rd>(float)THRL),0)){ const float dl=__builtin_fmaxf(rd,0.f); mhat+=dl; \
        const float f=__builtin_amdgcn_exp2f(-dl); l_reg*=f; if(hi==0)wsf[r32]=f; resc=true; } } \
    SBAR(); \
    GAPB(o[0]=__builtin_amdgcn_mfma_f32_32x32x16_bf16(PAF(0),VFR(0),o[0],0,0,0), C0,0,mlo_); \
    GAPB(o[1]=__builtin_amdgcn_mfma_f32_32x32x16_bf16(PAF(0),VFR(4),o[1],0,0,0), C0,4,mlo_); \
    KRD(GL,0); GAPB(o[0]=__builtin_amdgcn_mfma_f32_32x32x16_bf16(PAF(1),VFR(1),o[0],0,0,0), C0,8,mlo_); \
    KRD(GL,1); GAPB(o[1]=__builtin_amdgcn_mfma_f32_32x32x16_bf16(PAF(1),VFR(5),o[1],0,0,0), C0,12,mlo_); \
    KRD(GL,2); GAPB(o[0]=__builtin_amdgcn_mfma_f32_32x32x16_bf16(PAF(2),VFR(2),o[0],0,0,0), C1,0,mhi_); \
    KRD(GL,3); GAPB(o[1]=__builtin_amdgcn_mfma_f32_32x32x16_bf16(PAF(2),VFR(6),o[1],0,0,0), C1,4,mhi_); \
    GAPB(o[0]=__builtin_amdgcn_mfma_f32_32x32x16_bf16(PAF(3),VFR(3),o[0],0,0,0), C1,8,mhi_); \
    GAPB(o[1]=__builtin_amdgcn_mfma_f32_32x32x16_bf16(PAF(3),VFR(7),o[1],0,0,0), C1,12,mhi_); \
    }while(0)
  int t=1;
  #undef CMASK
  #define CMASK(P0,P1,t,M) do{}while(0)
  for(;t+7<NT;t+=2){
    STEP(pB0,pB1,pA0,pA1,t,true,true,true,mwB,mwA);     WAIT_BAR(2); MPIN(mwA); RESC(); ROT();
    STEP(pA0,pA1,pB0,pB1,t+1,true,true,true,mwA,mwB);   WAIT_BAR(2); MPIN(mwB); RESC(); ROT();
  }
  #undef CMASK
  #define CMASK(P0,P1,t,M) do{ if((t)>=NT-6)biasw(P0,P1,q0+qrel-64*(t)-4*hi,bdl); }while(0)
  #define ENDW(tt) do{ if((tt)+3<NT){WAIT_BAR(2);} else if((tt)+2<NT){WAIT_BAR(1);} else {WAIT_BAR(0);} }while(0)
  for(;t+1<NT;t+=2){
    STEP(pB0,pB1,pA0,pA1,t,(t+3<NT),(t+1<NT),(t+1<NT),mwB,mwA);       ENDW(t);   MPIN(mwA); RESC(); ROT();
    STEP(pA0,pA1,pB0,pB1,t+1,(t+4<NT),(t+2<NT),(t+2<NT),mwA,mwB);     ENDW(t+1); MPIN(mwB); RESC(); ROT();
  }
  STEP(pB0,pB1,pA0,pA1,NT-1,false,false,false,mwB,mwA); RESC();
  { float sacc=pB0[0]+pB0[1]; _Pragma("unroll") for(int r=2;r<16;++r)sacc+=pB0[r]; _Pragma("unroll") for(int r=0;r<16;++r)sacc+=pB1[r]; l_reg+=sacc;
    pw0=(u32x4){PKW(pB0,0),PKW(pB0,2),PKW(pB0,4),PKW(pB0,6)};pw1=(u32x4){PKW(pB0,8),PKW(pB0,10),PKW(pB0,12),PKW(pB0,14)};pw2=(u32x4){PKW(pB1,0),PKW(pB1,2),PKW(pB1,4),PKW(pB1,6)};pw3=(u32x4){PKW(pB1,8),PKW(pB1,10),PKW(pB1,12),PKW(pB1,14)};
    SBAR(); pv(o,vb0+sl_cur,PAF(0),PAF(1),PAF(2),PAF(3)); }
  #undef PKW
  #undef PAF
  #undef VFR
  #undef PIN
  #undef MX3
  #undef GAPA
  #undef GAPB
  #undef EX
  #undef VRD
  #undef KRD
  #undef STEP
  #undef ENDW
  {auto rr=__builtin_amdgcn_permlane32_swap(__float_as_uint(l_reg),__float_as_uint(l_reg),false,false);l_reg=__uint_as_float(rr[0])+__uint_as_float(rr[1]);}
  if(hi==0)wsf[32+r32]=l_reg;asm volatile("s_waitcnt lgkmcnt(0)":::"memory");
  float rli[16];
  #pragma unroll
  for(int r=0;r<16;++r)rli[r]=__builtin_amdgcn_rcpf(wsf[32+crow(r,hi)]);
  bf16*Ow=O+(rowbase+q0+wid*QBLK)*DM+h*D;
  { bf16*stg=(bf16*)(shm+LDS_OST)+wid*2048;
    #pragma unroll
    for(int r=0;r<16;++r){const int orow=crow(r,hi);
      #pragma unroll
      for(int d0=0;d0<2;++d0)stg[orow*64+d0*32+r32]=__float2bfloat16(o[d0][r]*rli[r]);}
    asm volatile("s_waitcnt lgkmcnt(0)":::"memory");
    #pragma unroll
    for(int i=0;i<4;++i){const int row=i*8+(lane>>3),ch=lane&7; const u32x4 v=*(const u32x4*)(stg+row*64+ch*8); ATTN_STORE16(Ow+(long)row*DM+ch*8,v);} }
  asm volatile("s_waitcnt lgkmcnt(0)\n\ts_barrier":::"memory");
  #undef DMA_K
  #undef MLOAD
  #undef MPIN
  #undef DMA_V
  #undef CMASK
  #undef START
  #undef RESC
  #undef ROT
}
constexpr int ATTN_LDS_BYTES=LDS_BYTES;
#undef SBAR
#undef WAIT_BAR
}
namespace mk {
using pg8::bf16_t; using pg8::f32x4; using pg8::u32x4; using pg8::bf16x8; using pg8::Unit; using pg8::Gemm;
#define LAS __attribute__((address_space(3)))
constexpr int T = 65536, SEQ = 4096, NBATCH = 16, DM = 1024;
constexpr int NTHREADS = 512, NWAVES = 8;
constexpr size_t MiB = 1u << 20;
constexpr size_t WS_CTL = 0;
constexpr size_t WS_EID = 1 * MiB, WS_GATE = 2 * MiB, WS_SLOT = 3 * MiB;
constexpr size_t WS_WTIN = 4 * MiB;
constexpr size_t WS_WTA = 16 * MiB, WS_WTB = 17 * MiB, WS_WTOUT = 18 * MiB, WS_WTLORA = 20 * MiB;
constexpr size_t WS_WTGU = 21 * MiB;
constexpr size_t WS_WTDN = 85 * MiB;
constexpr size_t WS_KN = 117 * MiB;
constexpr size_t WS_MISC = 125 * MiB;
constexpr size_t WS_AP = 145 * MiB;
constexpr size_t WS_MASK = 177 * MiB;
constexpr size_t WS_YB = 209 * MiB;
constexpr size_t WS_RW = 273 * MiB;
constexpr size_t WS_Q = 497 * MiB, WS_K = 561 * MiB, WS_V = 625 * MiB, WS_QI = 689 * MiB;
constexpr size_t WS_SGA = 753 * MiB, WS_SGB = 881 * MiB;
constexpr size_t WS_END = 1009 * MiB;
constexpr size_t WS_H1B = WS_RW;
constexpr size_t WS_XS = WS_Q;
constexpr size_t WS_ACT = 769 * MiB;
constexpr int NROWS_PAD = 131072 + 32 * 256;
static_assert(WS_XS + (size_t)NROWS_PAD * 2048 <= WS_ACT && WS_ACT + (size_t)NROWS_PAD * 1024 <= WS_END, "overlay map");
constexpr size_t DO_XBF = 0;
constexpr size_t DO_OMW = 0, DO_ASIG = 64 * MiB, DO_G = 128 * MiB, DO_YA = 192 * MiB;

constexpr int LDS_TOTAL = 155648;
constexpr int LDS_TAB = 131072;

struct Params { const float* in[30]; float* out; char* ws; };

__device__ __forceinline__ float wave_sum(float v) {
#pragma unroll
    for (int o = 1; o < 64; o <<= 1) v += __shfl_xor(v, o);
    return v;
}
__device__ __forceinline__ unsigned f2bf(float f) { unsigned u = __builtin_bit_cast(unsigned, f); return (u + 0x7fffu + ((u >> 16) & 1u)) >> 16; }
__device__ __forceinline__ unsigned pk2(float lo, float hi) { return f2bf(lo) | (f2bf(hi) << 16); }
__device__ __forceinline__ float bf2f(bf16_t v) { return __builtin_bit_cast(float, (unsigned)v << 16); }
__device__ __forceinline__ float bflo(unsigned w) { return __builtin_bit_cast(float, w << 16); }
__device__ __forceinline__ float bfhi(unsigned w) { return __builtin_bit_cast(float, w & 0xffff0000u); }
__device__ __forceinline__ float sigmoidf_(float x) { return 1.f / (1.f + __expf(-x)); }

template <class Src>
__device__ __forceinline__ void transpose_item(const Src& S, int K, bf16_t* dst, LAS float* scr, int k0, int n0, int lane) {
#pragma unroll 8
    for (int i = 0; i < 32; ++i) { const int kk = 2 * i + (lane >> 5); scr[kk * 33 + (lane & 31)] = S(k0 + kk, n0 + (lane & 31)); }
    asm volatile("s_waitcnt lgkmcnt(0)" ::: "memory");
    const int c = lane & 7;
#pragma unroll
    for (int j = 0; j < 4; ++j) { const int n = (lane >> 3) + 8 * j; const LAS float* s = scr + (8 * c) * 33 + n;
        u32x4 o; o.x = pk2(s[0 * 33], s[1 * 33]); o.y = pk2(s[2 * 33], s[3 * 33]); o.z = pk2(s[4 * 33], s[5 * 33]); o.w = pk2(s[6 * 33], s[7 * 33]);
        *(u32x4*)(dst + (size_t)(n0 + n) * K + k0 + 8 * c) = o; }
    asm volatile("s_waitcnt lgkmcnt(0)" ::: "memory");
}
struct SrcWin { const float* w; __device__ __forceinline__ float operator()(int k, int n) const {
    int c; if (n < 3840) c = n; else if (n < 5888) c = n + 72; else if (n < 5960) c = n - 5888 + 3840; else return 0.f;
    return w[(size_t)k * 5960 + c]; } };
struct SrcPlain { const float* w; int N; __device__ __forceinline__ float operator()(int k, int n) const { return w[(size_t)k * N + n]; } };
struct SrcGU { const float* g; long ud; __device__ __forceinline__ float operator()(int k, int n) const {
    const int pn = n >> 8, c = n & 255, bj = c >> 7, wc = (c & 127) >> 5, fq = (c & 31) >> 3, nn = (c & 7) >> 2, i = c & 3;
    const int hj = 128 * pn + 64 * bj + 16 * wc + 4 * fq + i; return g[(long)k * 512 + hj + (nn ? ud : 0l)]; } };

__device__ __forceinline__ void phase_prologue(const Params& p, LAS unsigned char* lds) {
    const int tid = mk_tid(), lane = tid & 63, wave = tid >> 6;
    const int gw = blockIdx.x * NWAVES + wave, NGW = gridDim.x * NWAVES;
    LAS float* scr = (LAS float*)(lds + wave * 16384);
    char* ws = p.ws;
    if (blockIdx.x == 0 && tid < 64) ((unsigned*)(ws + WS_CTL))[tid] = 0u;
    constexpr int I_IN = 16 * 192, I_A = 8 * 32, I_B = 8 * 32, I_O = 16 * 32, I_GU = 32 * 16 * 32, I_DN = 32 * 8 * 32;
    constexpr int NITEMS = I_IN + I_A + I_B + I_O + I_GU + I_DN;
    for (int it = gw; it < NITEMS; it += NGW) {
        int r = it;
        if (r < I_IN) { SrcWin S{p.in[1]}; transpose_item(S, 1024, (bf16_t*)(ws + WS_WTIN), scr, (r / 192) * 64, (r % 192) * 32, lane); continue; } r -= I_IN;
        if (r < I_A) { SrcPlain S{p.in[13], 1024}; transpose_item(S, 512, (bf16_t*)(ws + WS_WTA), scr, (r / 32) * 64, (r % 32) * 32, lane); continue; } r -= I_A;
        if (r < I_B) { SrcPlain S{p.in[17], 1024}; transpose_item(S, 512, (bf16_t*)(ws + WS_WTB), scr, (r / 32) * 64, (r % 32) * 32, lane); continue; } r -= I_B;
        if (r < I_O) { SrcPlain S{p.in[18], 1024}; transpose_item(S, 1024, (bf16_t*)(ws + WS_WTOUT), scr, (r / 32) * 64, (r % 32) * 32, lane); continue; } r -= I_O;
        if (r < I_GU) { const int e = r / 512, q = r % 512; SrcGU S{p.in[25] + (size_t)e * 1024 * 512, (long)(p.in[26] - p.in[25])};
            transpose_item(S, 1024, (bf16_t*)(ws + WS_WTGU) + (size_t)e * 1024 * 1024, scr, (q / 32) * 64, (q % 32) * 32, lane); continue; } r -= I_GU;
        { const int e = r / 256, q = r % 256; SrcPlain S{p.in[27] + (size_t)e * 512 * 1024, 1024};
            transpose_item(S, 512, (bf16_t*)(ws + WS_WTDN) + (size_t)e * 1024 * 512, scr, (q / 32) * 64, (q % 32) * 32, lane); }
    }
    { bf16_t* wl = (bf16_t*)(ws + WS_WTLORA); const int gt = blockIdx.x * NTHREADS + tid, NGT = gridDim.x * NTHREADS;
      for (int i = gt; i < 1536 * 256; i += NGT) { const int n = i >> 8, k = i & 255; float v = 0.f;
          if (n < 512) { if (k < 64) v = p.in[4][k * 512 + n]; }
          else if (n < 1024) { if (k >= 64 && k < 128) v = p.in[6][(k - 64) * 512 + (n - 512)]; }
          else { if (k >= 128) v = p.in[7][(k - 128) * 512 + (n - 1024)]; }
          wl[i] = (bf16_t)f2bf(v); } }
    { const f32x4* x4 = (const f32x4*)p.in[0]; unsigned long long* o8 = (unsigned long long*)((char*)p.out + DO_XBF);
      const size_t gt = (size_t)blockIdx.x * NTHREADS + tid, NGT = (size_t)gridDim.x * NTHREADS;
      for (size_t i = gt; i < (size_t)T * DM / 4; i += NGT) { const f32x4 v = x4[i]; o8[i] = (unsigned long long)pk2(v.x, v.y) | ((unsigned long long)pk2(v.z, v.w) << 32); } }
}

struct EpiIn {
    static constexpr bool PERM = true, AFTER_DRAIN = false;
    char* ws;
    __device__ __forceinline__ void operator()(const f32x4 (&acc)[2][2][4][2], const Unit& u, int wr, int wc, int fr, int fq) const {
        const int pn = u.pn, row0 = u.pm * 256 + wr * 64 + fr, cl = wc * 32 + 8 * fq;
        if (pn == 23) {
            if (cl < 72) { float* dst = (float*)(ws + WS_MISC);
#pragma unroll
                for (int ai = 0; ai < 2; ++ai)
#pragma unroll
                    for (int m = 0; m < 4; ++m) { float* d = dst + (size_t)(row0 + ai * 128 + m * 16) * 80 + cl; *(f32x4*)d = acc[ai][0][m][0]; *(f32x4*)(d + 4) = acc[ai][0][m][1]; } }
            return;
        }
        bf16_t* base; int ld, colt, mode = 0;
        if (pn < 7) { base = (bf16_t*)(ws + WS_RW); ld = 1792; colt = pn * 256; }
        else if (pn < 9) { base = (bf16_t*)(ws + WS_Q); ld = 512; colt = (pn - 7) * 256; mode = 2; }
        else if (pn < 11) { base = (bf16_t*)(ws + WS_K); ld = 512; colt = (pn - 9) * 256; }
        else if (pn < 13) { base = (bf16_t*)(ws + WS_V); ld = 512; colt = (pn - 11) * 256; }
        else if (pn < 15) { base = (bf16_t*)(ws + WS_QI); ld = 512; colt = (pn - 13) * 256; }
        else if (pn < 19) { base = (bf16_t*)(ws + WS_SGA); ld = 1024; colt = (pn - 15) * 256; mode = 1; }
        else { base = (bf16_t*)(ws + WS_SGB); ld = 1024; colt = (pn - 19) * 256; mode = 1; }
#pragma unroll
        for (int ai = 0; ai < 2; ++ai)
#pragma unroll
            for (int m = 0; m < 4; ++m) { bf16_t* rowp = base + (size_t)(row0 + ai * 128 + m * 16) * ld + colt + cl;
#pragma unroll
                for (int bj = 0; bj < 2; ++bj) { f32x4 v0 = acc[ai][bj][m][0], v1 = acc[ai][bj][m][1];
                    if (mode == 1) {
#pragma unroll
                        for (int i = 0; i < 4; ++i) { v0[i] = sigmoidf_(v0[i]); v1[i] = sigmoidf_(v1[i]); } }
                    else if (mode == 2) { v0 = v0 * attn_body::C2; v1 = v1 * attn_body::C2; }
                    u32x4 w; w.x = pk2(v0[0], v0[1]); w.y = pk2(v0[2], v0[3]); w.z = pk2(v1[0], v1[1]); w.w = pk2(v1[2], v1[3]);
                    *(u32x4*)(rowp + bj * 128) = w; } }
    }
};
struct EpiLora {
    static constexpr bool PERM = true, AFTER_DRAIN = false;
    char* dout;
    __device__ __forceinline__ void operator()(const f32x4 (&acc)[2][2][4][2], const Unit& u, int wr, int wc, int fr, int fq) const {
        const int pn = u.pn, seg = pn >> 1, row0 = u.pm * 256 + wr * 64 + fr, col0 = (pn & 1) * 256 + wc * 32 + 8 * fq;
        bf16_t* base = (bf16_t*)(dout + (size_t)seg * (64 * MiB));
#pragma unroll
        for (int ai = 0; ai < 2; ++ai)
#pragma unroll
            for (int m = 0; m < 4; ++m)
#pragma unroll
                for (int bj = 0; bj < 2; ++bj) { const f32x4 v0 = acc[ai][bj][m][0], v1 = acc[ai][bj][m][1]; u32x4 w;
                    w.x = pk2(v0[0], v0[1]); w.y = pk2(v0[2], v0[3]); w.z = pk2(v1[0], v1[1]); w.w = pk2(v1[2], v1[3]);
                    *(u32x4*)(base + (size_t)(row0 + ai * 128 + m * 16) * 512 + col0 + bj * 128) = w; }
    }
};
struct EpiGateMul {
    static constexpr bool PERM = true, AFTER_DRAIN = false;
    const bf16_t* gate; bf16_t* dst; int add;
    __device__ __forceinline__ void operator()(const f32x4 (&acc)[2][2][4][2], const Unit& u, int wr, int wc, int fr, int fq) const {
        const int row0 = u.pm * 256 + wr * 64 + fr, col0 = u.pn * 256 + wc * 32 + 8 * fq;
#pragma unroll
        for (int ai = 0; ai < 2; ++ai)
#pragma unroll
            for (int m = 0; m < 4; ++m)
#pragma unroll
                for (int bj = 0; bj < 2; ++bj) { const size_t off = (size_t)(row0 + ai * 128 + m * 16) * 1024 + col0 + bj * 128;
                    const u32x4 g = *(const u32x4*)(gate + off); u32x4 d = {0u, 0u, 0u, 0u}; if (add) d = *(const u32x4*)(dst + off);
                    const f32x4 v0 = acc[ai][bj][m][0], v1 = acc[ai][bj][m][1]; u32x4 w;
                    w.x = pk2(bflo(d.x) + bflo(g.x) * v0[0], bfhi(d.x) + bfhi(g.x) * v0[1]); w.y = pk2(bflo(d.y) + bflo(g.y) * v0[2], bfhi(d.y) + bfhi(g.y) * v0[3]);
                    w.z = pk2(bflo(d.z) + bflo(g.z) * v1[0], bfhi(d.z) + bfhi(g.z) * v1[1]); w.w = pk2(bflo(d.w) + bflo(g.w) * v1[2], bfhi(d.w) + bfhi(g.w) * v1[3]);
                    *(u32x4*)(dst + off) = w; }
    }
};
struct EpiResid {
    static constexpr bool PERM = true, AFTER_DRAIN = false;
    const float* x; float* out; float alpha;
    __device__ __forceinline__ void operator()(const f32x4 (&acc)[2][2][4][2], const Unit& u, int wr, int wc, int fr, int fq) const {
        const int row0 = u.pm * 256 + wr * 64 + fr, col0 = u.pn * 256 + wc * 32 + 8 * fq;
#pragma unroll
        for (int ai = 0; ai < 2; ++ai)
#pragma unroll
            for (int m = 0; m < 4; ++m)
#pragma unroll
                for (int bj = 0; bj < 2; ++bj) { const size_t off = (size_t)(row0 + ai * 128 + m * 16) * 1024 + col0 + bj * 128;
                    const f32x4 x0 = *(const f32x4*)(x + off), x1 = *(const f32x4*)(x + off + 4);
                    *(f32x4*)(out + off) = x0 * alpha + acc[ai][bj][m][0]; *(f32x4*)(out + off + 4) = x1 * alpha + acc[ai][bj][m][1]; }
    }
};
struct EpiSwiglu {
    static constexpr bool PERM = true, AFTER_DRAIN = false;
    bf16_t* act;
    __device__ __forceinline__ void operator()(const f32x4 (&acc)[2][2][4][2], const Unit& u, int wr, int wc, int fr, int fq) const {
        const int row0 = u.pm * 256 + wr * 64 + fr, col0 = (u.pn & 3) * 128 + 16 * wc + 4 * fq;
#pragma unroll
        for (int ai = 0; ai < 2; ++ai)
#pragma unroll
            for (int m = 0; m < 4; ++m)
#pragma unroll
                for (int bj = 0; bj < 2; ++bj) { const f32x4 g = acc[ai][bj][m][0], up = acc[ai][bj][m][1]; float a[4];
#pragma unroll
                    for (int i = 0; i < 4; ++i) a[i] = g[i] * sigmoidf_(g[i]) * up[i];
                    *(unsigned long long*)(act + (size_t)(row0 + ai * 128 + m * 16) * 512 + col0 + bj * 64) = (unsigned long long)pk2(a[0], a[1]) | ((unsigned long long)pk2(a[2], a[3]) << 32); }
    }
};
struct EpiDown {
    static constexpr bool PERM = true, AFTER_DRAIN = false;
    bf16_t* ys;
    __device__ __forceinline__ void operator()(const f32x4 (&acc)[2][2][4][2], const Unit& u, int wr, int wc, int fr, int fq) const {
        const int row0 = u.pm * 256 + wr * 64 + fr, col0 = (u.pn & 3) * 256 + wc * 32 + 8 * fq;
#pragma unroll
        for (int ai = 0; ai < 2; ++ai)
#pragma unroll
            for (int m = 0; m < 4; ++m)
#pragma unroll
                for (int bj = 0; bj < 2; ++bj) { const f32x4 v0 = acc[ai][bj][m][0], v1 = acc[ai][bj][m][1]; u32x4 w;
                    w.x = pk2(v0[0], v0[1]); w.y = pk2(v0[2], v0[3]); w.z = pk2(v1[0], v1[1]); w.w = pk2(v1[2], v1[3]);
                    *(u32x4*)(ys + (size_t)(row0 + ai * 128 + m * 16) * 1024 + col0 + bj * 128) = w; }
    }
};
struct MoeOrder {
    const LAS int* tab;
    int G, c;
    __device__ __forceinline__ bool next(int i, Unit& u) const {
        const int L = i * G + c; const int nt = tab[0]; if (L >= nt * 4) return false;
        const int ti = L >> 2; u.pm = ti; u.pn = tab[1 + ti] * 4 + (L & 3); return true; }
    __device__ __forceinline__ void a_ready(const Unit&) const {}
    __device__ __forceinline__ void done(const Unit&) const {}
};
__device__ __forceinline__ void moe_tables(const Params& p, LAS int* tab) {
    const int tid = mk_tid(); const unsigned* cnt = (const unsigned*)(p.ws + WS_CTL);
    __syncthreads();
    if (tid == 0) { int ts = 0; for (int e = 0; e < 32; ++e) { const int c = (int)cnt[e]; tab[1024 + e] = ts * 256; const int nt = (c + 255) >> 8; for (int j = 0; j < nt; ++j) tab[1 + ts + j] = e; ts += nt; } tab[0] = ts; tab[1024 + 32] = ts * 256; }
    __syncthreads();
}

__device__ __forceinline__ void phase_prep(const Params& p) {
    const int tid = mk_tid(), lane = tid & 63, wave = tid >> 6;
    const int gw = blockIdx.x * NWAVES + wave, NGW = gridDim.x * NWAVES;
    const bf16_t* RW = (const bf16_t*)(p.ws + WS_RW); const float* MISC = (const float*)(p.ws + WS_MISC);
    bf16_t* AP = (bf16_t*)(p.ws + WS_AP); bf16_t* KN = (bf16_t*)(p.ws + WS_KN);
    const float* mu = p.in[2];
    const float mu_wd = mu[512 + lane], mu_ad = mu[1600 + lane], mu_g0 = mu[1664 + lane], mu_g1 = mu[1728 + lane];
    const float lg = p.in[14][lane], lb = p.in[15][lane];
    for (int tok = gw; tok < T; tok += NGW) {
        const bf16_t* cur = RW + (size_t)tok * 1792; const bool hp = (tok & (SEQ - 1)) != 0; const bf16_t* prv = cur - 1792;
        float wd = bf2f(cur[512 + lane]), ad = bf2f(cur[1600 + lane]), g0 = bf2f(cur[1664 + lane]), g1 = bf2f(cur[1728 + lane]);
        const float wdp = hp ? bf2f(prv[512 + lane]) : 0.f, adp = hp ? bf2f(prv[1600 + lane]) : 0.f, g0p = hp ? bf2f(prv[1664 + lane]) : 0.f, g1p = hp ? bf2f(prv[1728 + lane]) : 0.f;
        wd += (wdp - wd) * mu_wd; ad += (adp - ad) * mu_ad; g0 += (g0p - g0) * mu_g0; g1 += (g1p - g1) * mu_g1;
        bf16_t* ap = AP + (size_t)tok * 256;
        ap[lane] = (bf16_t)f2bf(tanhf(wd)); ap[64 + lane] = (bf16_t)f2bf(ad); ap[128 + lane] = (bf16_t)f2bf(sigmoidf_(g0)); ap[192 + lane] = (bf16_t)f2bf(sigmoidf_(g1));
        const float kx = MISC[(size_t)tok * 80 + lane]; const float mean = wave_sum(kx) * (1.f / 64.f); const float d = kx - mean;
        const float var = wave_sum(d * d) * (1.f / 64.f);
        KN[(size_t)tok * 64 + lane] = (bf16_t)f2bf(d * rsqrtf(var + 1e-5f) * lg + lb);
    }
}

typedef _Float16 h8 __attribute__((ext_vector_type(8)));
__device__ __forceinline__ float dpp_sum8(float x) {
    x += __builtin_bit_cast(float, __builtin_amdgcn_mov_dpp(__builtin_bit_cast(int, x), 0xB1, 0xF, 0xF, true));
    x += __builtin_bit_cast(float, __builtin_amdgcn_mov_dpp(__builtin_bit_cast(int, x), 0x4E, 0xF, 0xF, true));
    x += __builtin_bit_cast(float, __builtin_amdgcn_mov_dpp(__builtin_bit_cast(int, x), 0x141, 0xF, 0xF, true));
    return x;
}
constexpr int SC = 32;
__device__ __forceinline__ void scan_item(const Params& p, LAS unsigned char* lds, int bh) {
    const int b = bh >> 3, h = bh & 7;
    const int tid = mk_tid(), lane = tid & 63, wave = tid >> 6;
    LAS _Float16* vec = (LAS _Float16*)lds;
    LAS float* vbuf = (LAS float*)(lds + SC * 640);
    LAS float* ybuf = (LAS float*)(lds + SC * 640 + SC * 256);
    const bf16_t* RW = (const bf16_t*)(p.ws + WS_RW);
    const bf16_t* OMW = (const bf16_t*)((char*)p.out + DO_OMW); const bf16_t* ASIG = (const bf16_t*)((char*)p.out + DO_ASIG); const bf16_t* GG = (const bf16_t*)((char*)p.out + DO_G);
    bf16_t* YA = (bf16_t*)((char*)p.out + DO_YA);
    const int col = h * 64 + lane;
    const float mu_r = p.in[2][col], mu_k = p.in[2][576 + col], mu_v = p.in[2][1088 + col];
    const float w0c = p.in[3][col], a0c = p.in[5][col];
    const float kkc = p.in[8][col], kac = p.in[9][col], rkc = p.in[10][col], lxg = p.in[11][col], lxb = p.in[12][col];
    const int rl = lane >> 3, jg = lane & 7, irow = wave * 8 + rl;
    float st[8];
#pragma unroll
    for (int j = 0; j < 8; ++j) st[j] = 0.f;
    float sv[SC / 8], sg[SC / 8], sb[SC / 8];
#pragma unroll
    for (int q = 0; q < SC / 8; ++q) { sv[q] = 0.f; sg[q] = 0.f; sb[q] = 0.f; }
    const size_t row0 = (size_t)b * SEQ;
    for (int c = 0; c <= SEQ / SC; ++c) {
#pragma unroll
        for (int q = 0; q < SC / 8; ++q) {
            const int tk = wave + 8 * q;
            if (c > 0) {
                const float y = ybuf[tk * 64 + lane]; const float mean = wave_sum(y) * (1.f / 64.f); const float d = y - mean; const float var = wave_sum(d * d) * (1.f / 64.f);
                const float o = (d * rsqrtf(var + 64e-5f) * lxg + lxb + sb[q] * sv[q]) * sg[q];
                YA[(row0 + (size_t)(c - 1) * SC + tk) * 512 + col] = (bf16_t)f2bf(o);
            }
            if (c < SEQ / SC) {
                const int t = c * SC + tk; const size_t row = row0 + t; const bf16_t* cur = RW + row * 1792; const bf16_t* prv = cur - 1792; const bool hp = t > 0;
                float r = bf2f(cur[col]), k = bf2f(cur[576 + col]), v = bf2f(cur[1088 + col]);
                const float rp = hp ? bf2f(prv[col]) : 0.f, kp = hp ? bf2f(prv[576 + col]) : 0.f, vp = hp ? bf2f(prv[1088 + col]) : 0.f;
                r += (rp - r) * mu_r; k += (kp - k) * mu_k; v += (vp - v) * mu_v;
                const float g = bf2f(GG[row * 512 + col]); const float a = sigmoidf_(a0c + bf2f(ASIG[row * 512 + col]));
                float omw; { const float z = -(w0c + bf2f(OMW[row * 512 + col])); const float sp = z > 20.f ? z : __logf(1.f + __expf(z)); const float e = __expf(-sp - 0.5f);
                    omw = e < 0.1f ? e * (1.f - e * (0.5f - e * ((1.f / 6.f) - e * ((1.f / 24.f) - e * (1.f / 120.f))))) : 1.f - __expf(-e); }
                const float kkr = k * kkc; const float n2 = wave_sum(kkr * kkr); const float kk = kkr / fmaxf(sqrtf(n2), 1e-12f);
                const float k2 = k * (1.f + (a - 1.f) * kac);
                const float bonus = wave_sum(r * k2 * rkc);
                LAS _Float16* vp_ = vec + tk * 320 + lane;
                vp_[0] = (_Float16)omw; vp_[64] = (_Float16)(-kk); vp_[128] = (_Float16)(kk * a); vp_[192] = (_Float16)k2; vp_[256] = (_Float16)r;
                vbuf[tk * 64 + lane] = v;
                sv[q] = v; sg[q] = g; sb[q] = bonus;
            }
        }
        __syncthreads();
        if (c < SEQ / SC) {
#pragma unroll 4
            for (int tk = 0; tk < SC; ++tk) {
                const LAS h8* vv = (const LAS h8*)(vec + tk * 320) + jg;
                const h8 vo = vv[0], va = vv[8], vb = vv[16], vk = vv[24], vr = vv[32];
                const float v = vbuf[tk * 64 + irow];
                float sa = 0.f;
#pragma unroll
                for (int j = 0; j < 8; ++j) sa = __builtin_fmaf(st[j], (float)va[j], sa);
                sa = dpp_sum8(sa);
                float y = 0.f;
#pragma unroll
                for (int j = 0; j < 8; ++j) { float s = __builtin_fmaf(-(float)vo[j], st[j], st[j]); s = __builtin_fmaf(sa, (float)vb[j], s); s = __builtin_fmaf(v, (float)vk[j], s); st[j] = s; y = __builtin_fmaf(s, (float)vr[j], y); }
                y = dpp_sum8(y);
                if (jg == 0) ybuf[tk * 64 + irow] = y;
            }
        }
        __syncthreads();
    }
}

constexpr int IX_HIST = 0, IX_MASK = 65536, IX_CAND = IX_MASK + 8192, IX_MISC = IX_CAND + 16384, IX_CAP = 128;
__device__ __forceinline__ void indexer_unit(const Params& p, LAS unsigned char* lds, int b, int qg) {
    const int tid = mk_tid(), lane = tid & 63, wave = tid >> 6;
    LAS unsigned* hist = (LAS unsigned*)(lds + IX_HIST);
    LAS unsigned* mrow = (LAS unsigned*)(lds + IX_MASK);
    LAS float* candv = (LAS float*)(lds + IX_CAND);
    LAS int* cands = (LAS int*)(lds + IX_CAND + 8192);
    LAS int* ccnt = (LAS int*)(lds + IX_MISC);
    LAS int* thrB = ccnt + 16; LAS int* thrG = ccnt + 32;
    LAS int* segsum = ccnt + 64;
    unsigned* MASK = (unsigned*)(p.ws + WS_MASK);
    const int t0 = qg * 16; const size_t rowb = (size_t)b * SEQ;
    if (qg < 16) {
        for (int i = tid; i < 2048; i += NTHREADS) { const int n = i >> 7, w = i & 127, tq = t0 + n; const int s0 = 32 * w;
            const unsigned m = tq >= s0 + 31 ? 0xffffffffu : (tq < s0 ? 0u : ((2u << (tq - s0)) - 1u));
            MASK[(rowb + t0) * 128 + i] = m; }
        return;
    }
    for (int i = tid; i < 16384 + 2048; i += NTHREADS) hist[i] = 0u;
    if (tid < 16) ccnt[tid] = 0;
    const bf16_t* QI = (const bf16_t*)(p.ws + WS_QI); const bf16_t* KN = (const bf16_t*)(p.ws + WS_KN); const float* MISC = (const float*)(p.ws + WS_MISC);
    const int n = lane & 15, quad = lane >> 4, tq = t0 + n;
    bf16x8 qf[8][2];
#pragma unroll
    for (int h = 0; h < 8; ++h)
#pragma unroll
        for (int ks = 0; ks < 2; ++ks) qf[h][ks] = *(const bf16x8*)(QI + (rowb + tq) * 512 + h * 64 + ks * 32 + quad * 8);
    float wq[8];
#pragma unroll
    for (int h = 0; h < 8; ++h) wq[h] = MISC[(rowb + tq) * 80 + 64 + h] * (0.125f * 0.35355339059327373f);
    __syncthreads();
    int myB = 0;
#pragma unroll 1
    for (int pass = 0; pass < 2; ++pass) {
#pragma unroll 1
        for (int kb = wave; kb <= qg; kb += NWAVES) {
            const int s0 = kb * 16; const bf16_t* kp = KN + (rowb + s0 + n) * 64 + quad * 8;
            const bf16x8 a0 = *(const bf16x8*)kp, a1 = *(const bf16x8*)(kp + 32);
            float idx[4] = {0.f, 0.f, 0.f, 0.f};
#pragma unroll
            for (int h = 0; h < 8; ++h) { f32x4 acc = {0.f, 0.f, 0.f, 0.f};
                acc = __builtin_amdgcn_mfma_f32_16x16x32_bf16(a0, qf[h][0], acc, 0, 0, 0);
                acc = __builtin_amdgcn_mfma_f32_16x16x32_bf16(a1, qf[h][1], acc, 0, 0, 0);
#pragma unroll
                for (int j = 0; j < 4; ++j) idx[j] = __builtin_fmaf(wq[h], fmaxf(acc[j], 0.f), idx[j]); }
#pragma unroll
            for (int j = 0; j < 4; ++j) { const int s = s0 + quad * 4 + j;
                if (s <= tq) { int bin = (int)floorf((idx[j] + 8.f) * 128.f); bin = bin < 0 ? 0 : (bin > 2047 ? 2047 : bin);
                    if (pass == 0) __hip_atomic_fetch_add(&hist[n * 1024 + (bin >> 1)], 1u << (16 * (bin & 1)), __ATOMIC_RELAXED, __HIP_MEMORY_SCOPE_WORKGROUP);
                    else if (bin > myB) __hip_atomic_fetch_or(&mrow[n * 128 + (s >> 5)], 1u << (s & 31), __ATOMIC_RELAXED, __HIP_MEMORY_SCOPE_WORKGROUP);
                    else if (bin == myB) { const int sl = __hip_atomic_fetch_add(&ccnt[n], 1, __ATOMIC_RELAXED, __HIP_MEMORY_SCOPE_WORKGROUP); if (sl < IX_CAP) { candv[n * IX_CAP + sl] = idx[j]; cands[n * IX_CAP + sl] = s; } } } }
        }
        __syncthreads();
        if (pass == 0) {
            const int qn = tid >> 5, seg = tid & 31;
            { int sum = 0; for (int w = 0; w < 32; ++w) { const unsigned v = hist[qn * 1024 + seg * 32 + w]; sum += (int)(v & 0xffffu) + (int)(v >> 16); } segsum[qn * 32 + seg] = sum; }
            __syncthreads();
            { int above = 0; for (int s2 = seg + 1; s2 < 32; ++s2) above += segsum[qn * 32 + s2]; const int mine = segsum[qn * 32 + seg];
              if (above < 256 && above + mine >= 256) { int cum = above;
                  for (int bin = seg * 64 + 63; bin >= seg * 64; --bin) { const unsigned v = hist[qn * 1024 + (bin >> 1)]; const int cnt = (int)((v >> (16 * (bin & 1))) & 0xffffu);
                      if (cum + cnt >= 256) { thrB[qn] = bin; thrG[qn] = cum; break; } cum += cnt; } } }
            __syncthreads();
            myB = thrB[n];
        }
    }
    { const int qn = tid >> 5, sub = tid & 31; const int nc = min(ccnt[qn], IX_CAP), need = 256 - thrG[qn];
      for (int c = sub; c < nc; c += 32) { const float v = candv[qn * IX_CAP + c]; const int s = cands[qn * IX_CAP + c]; int rank = 0;
          for (int c2 = 0; c2 < nc; ++c2) { const float v2 = candv[qn * IX_CAP + c2]; const int s2 = cands[qn * IX_CAP + c2]; rank += (v2 > v || (v2 == v && s2 < s)) ? 1 : 0; }
          if (rank < need) __hip_atomic_fetch_or(&mrow[qn * 128 + (s >> 5)], 1u << (s & 31), __ATOMIC_RELAXED, __HIP_MEMORY_SCOPE_WORKGROUP); } }
    __syncthreads();
    for (int i = tid; i < 2048; i += NTHREADS) MASK[(rowb + t0) * 128 + i] = mrow[i];
    __syncthreads();
}

__device__ __forceinline__ void phase_ln_router(const Params& p, LAS unsigned char* lds) {
    const int tid = mk_tid(), lane = tid & 63, wave = tid >> 6;
    LAS float* WR = (LAS float*)lds;
    LAS int* lcnt = (LAS int*)(lds + 147456);
    LAS int* lbase = lcnt + 32;
    LAS int* tke = lcnt + 64;
    LAS int* tks = lcnt + 64 + 512;
    for (int i = tid; i < 36 * 1024; i += NTHREADS) { const int o = i >> 10, k = i & 1023; WR[i] = o < 4 ? p.in[21][k * 4 + o] : p.in[23][k * 32 + (o - 4)]; }
    float* H = p.out; bf16_t* H1B = (bf16_t*)(p.ws + WS_H1B);
    int* EID = (int*)(p.ws + WS_EID); float* GATE = (float*)(p.ws + WS_GATE); int* SLOT = (int*)(p.ws + WS_SLOT); unsigned* gcnt = (unsigned*)(p.ws + WS_CTL);
    const float* g1 = p.in[19]; const float* b1 = p.in[20];
    for (int tile = blockIdx.x; tile < T / 256; tile += gridDim.x) {
        if (tid < 32) lcnt[tid] = 0;
        __syncthreads();
        for (int it = 0; it < 32; ++it) {
            const int tl = wave * 32 + it, tok = tile * 256 + tl;
            f32x4* hr = (f32x4*)(H + (size_t)tok * DM) + lane;
            f32x4 v[4]; float s = 0.f;
#pragma unroll
            for (int j = 0; j < 4; ++j) { v[j] = hr[64 * j]; s += (v[j].x + v[j].y) + (v[j].z + v[j].w); }
            const float mean = wave_sum(s) * (1.f / DM); float s2 = 0.f;
#pragma unroll
            for (int j = 0; j < 4; ++j) { v[j] = v[j] - mean; s2 += (v[j].x * v[j].x + v[j].y * v[j].y) + (v[j].z * v[j].z + v[j].w * v[j].w); }
            const float rstd = rsqrtf(wave_sum(s2) * (1.f / DM) + 1e-5f);
#pragma unroll
            for (int j = 0; j < 4; ++j) { const f32x4 g = ((const f32x4*)g1)[lane + 64 * j], bb = ((const f32x4*)b1)[lane + 64 * j]; v[j] = v[j] * rstd * g + bb; hr[64 * j] = v[j];
                ((unsigned long long*)(H1B + (size_t)tok * DM))[lane + 64 * j] = (unsigned long long)pk2(v[j].x, v[j].y) | ((unsigned long long)pk2(v[j].z, v[j].w) << 32); }
            float lg[36];
#pragma unroll
            for (int o = 0; o < 36; ++o) { float a = 0.f;
#pragma unroll
                for (int j = 0; j < 4; ++j) { const f32x4 w = ((const LAS f32x4*)(WR + o * 1024))[lane + 64 * j]; a += (v[j].x * w.x + v[j].y * w.y) + (v[j].z * w.z + v[j].w * w.w); }
                lg[o] = wave_sum(a); }
            float gl[4];
#pragma unroll
            for (int o = 0; o < 4; ++o) gl[o] = lg[o] + p.in[22][o];
            float gm = gl[0]; int gs = 0;
#pragma unroll
            for (int o = 1; o < 4; ++o) if (gl[o] > gm) { gm = gl[o]; gs = o; }
            float gden = 0.f;
#pragma unroll
            for (int o = 0; o < 4; ++o) gden += __expf(gl[o] - gm);
            const float pg = 1.f / gden;
            float el[8];
#pragma unroll
            for (int o = 0; o < 8; ++o) { float x = 0.f;
#pragma unroll
                for (int g = 0; g < 4; ++g) if (g == gs) x = lg[4 + g * 8 + o] + p.in[24][g * 8 + o];
                el[o] = x; }
            float m1 = el[0]; int i1 = 0;
#pragma unroll
            for (int o = 1; o < 8; ++o) if (el[o] > m1) { m1 = el[o]; i1 = o; }
            float m2 = -INFINITY; int i2 = 0;
#pragma unroll
            for (int o = 0; o < 8; ++o) if (o != i1 && el[o] > m2) { m2 = el[o]; i2 = o; }
            const float e2 = __expf(m2 - m1); const float ga = pg / (1.f + e2), gb = pg * e2 / (1.f + e2);
            if (lane == 0) { const int ea = gs * 8 + i1, eb = gs * 8 + i2;
                EID[tok * 2] = ea; EID[tok * 2 + 1] = eb; GATE[tok * 2] = ga; GATE[tok * 2 + 1] = gb;
                tke[tl * 2] = ea; tke[tl * 2 + 1] = eb; tks[tl * 2] = __hip_atomic_fetch_add(&lcnt[ea], 1, __ATOMIC_RELAXED, __HIP_MEMORY_SCOPE_WORKGROUP); tks[tl * 2 + 1] = __hip_atomic_fetch_add(&lcnt[eb], 1, __ATOMIC_RELAXED, __HIP_MEMORY_SCOPE_WORKGROUP); }
        }
        __syncthreads();
        if (tid < 32) lbase[tid] = (int)__hip_atomic_fetch_add(&gcnt[tid], (unsigned)lcnt[tid], __ATOMIC_RELAXED, __HIP_MEMORY_SCOPE_AGENT);
        __syncthreads();
        SLOT[tile * 512 + tid] = lbase[tke[tid]] + tks[tid];
        __syncthreads();
    }
}

__device__ __forceinline__ void phase_permute(const Params& p, LAS int* tab) {
    const int tid = mk_tid(), lane = tid & 63, wave = tid >> 6;
    const int gw = blockIdx.x * NWAVES + wave, NGW = gridDim.x * NWAVES;
    const int* EID = (const int*)(p.ws + WS_EID); const int* SLOT = (const int*)(p.ws + WS_SLOT);
    const u32x4* H1B = (const u32x4*)(p.ws + WS_H1B); u32x4* XS = (u32x4*)(p.ws + WS_XS);
    for (int i = gw; i < T * 2; i += NGW) { const int tok = i >> 1; const int dst = tab[1024 + EID[i]] + SLOT[i];
        const u32x4 a = H1B[(size_t)tok * 128 + lane], b2 = H1B[(size_t)tok * 128 + 64 + lane];
        XS[(size_t)dst * 128 + lane] = a; XS[(size_t)dst * 128 + 64 + lane] = b2; }
}

__device__ __forceinline__ void phase_final(const Params& p, LAS int* tab) {
    const int tid = mk_tid(), lane = tid & 63, wave = tid >> 6;
    const int gw = blockIdx.x * NWAVES + wave, NGW = gridDim.x * NWAVES;
    const int* EID = (const int*)(p.ws + WS_EID); const int* SLOT = (const int*)(p.ws + WS_SLOT); const float* GATE = (const float*)(p.ws + WS_GATE);
    const bf16_t* YS = (const bf16_t*)(p.ws + WS_XS); const float alpha = 1.189207115002721f;
    const float* g2 = p.in[28]; const float* b2 = p.in[29];
    for (int tok = gw; tok < T; tok += NGW) {
        const int r0 = tab[1024 + EID[tok * 2]] + SLOT[tok * 2], r1 = tab[1024 + EID[tok * 2 + 1]] + SLOT[tok * 2 + 1]; const float ga = GATE[tok * 2], gb = GATE[tok * 2 + 1];
        f32x4* hr = (f32x4*)(p.out + (size_t)tok * DM) + lane; f32x4 v[4]; float s = 0.f;
#pragma unroll
        for (int j = 0; j < 4; ++j) { const f32x4 hv = hr[64 * j];
            const unsigned long long ya = ((const unsigned long long*)(YS + (size_t)r0 * DM))[lane + 64 * j], yb = ((const unsigned long long*)(YS + (size_t)r1 * DM))[lane + 64 * j];
            const unsigned a0 = (unsigned)ya, a1 = (unsigned)(ya >> 32), c0 = (unsigned)yb, c1 = (unsigned)(yb >> 32);
            v[j].x = alpha * hv.x + ga * bflo(a0) + gb * bflo(c0); v[j].y = alpha * hv.y + ga * bfhi(a0) + gb * bfhi(c0);
            v[j].z = alpha * hv.z + ga * bflo(a1) + gb * bflo(c1); v[j].w = alpha * hv.w + ga * bfhi(a1) + gb * bfhi(c1);
            s += (v[j].x + v[j].y) + (v[j].z + v[j].w); }
        const float mean = wave_sum(s) * (1.f / DM); float s2 = 0.f;
#pragma unroll
        for (int j = 0; j < 4; ++j) { v[j] = v[j] - mean; s2 += (v[j].x * v[j].x + v[j].y * v[j].y) + (v[j].z * v[j].z + v[j].w * v[j].w); }
        const float rstd = rsqrtf(wave_sum(s2) * (1.f / DM) + 1e-5f);
#pragma unroll
        for (int j = 0; j < 4; ++j) { const f32x4 g = ((const f32x4*)g2)[lane + 64 * j], bb = ((const f32x4*)b2)[lane + 64 * j]; hr[64 * j] = v[j] * rstd * g + bb; }
    }
}

constexpr int NPHASE = 14;
template <int PH> __device__ __forceinline__ void run_phase(const Params& p, unsigned char* lds_g) {
    LAS unsigned char* lds = (LAS unsigned char*)lds_g;
    const int G = gridDim.x, c = blockIdx.x;
    if constexpr (PH == 0) phase_prologue(p, lds);
    if constexpr (PH == 1) { Gemm g{(const bf16_t*)((char*)p.out + DO_XBF), (const bf16_t*)(p.ws + WS_WTIN), T, 6144, 1024}; pg8::StaticOrder S; S.init(T, 6144, G, c);
        EpiIn E{p.ws}; pg8::gemm_phase<EpiIn, pg8::StaticOrder, true, true>(lds, g, S, E); }
    if constexpr (PH == 2) phase_prep(p);
    if constexpr (PH == 3) { Gemm g{(const bf16_t*)(p.ws + WS_AP), (const bf16_t*)(p.ws + WS_WTLORA), T, 1536, 256}; pg8::StaticOrder S; S.init(T, 1536, G, c);
        EpiLora E{(char*)p.out}; pg8::gemm_phase<EpiLora, pg8::StaticOrder, true, true>(lds, g, S, E); }
    if constexpr (PH == 4) { for (int bh = c; bh < 128; bh += G) scan_item(p, lds, bh); }
    if constexpr (PH == 5) { for (int u = c; u < 4096; u += G) indexer_unit(p, lds, u & 15, 255 - (u >> 4)); }
    if constexpr (PH == 6) {
        LAS float* bd = (LAS float*)(lds + attn_body::LDS_BIAS);
        for (int i = mk_tid(); i < 8 * 128; i += NTHREADS) { const int h = i >> 7, d = i & 127; int bk = d;
            if (d >= 16) { bk = 16 + (int)(log2f((float)d * 0.0625f) * (16.f / 3.f)); bk = bk > 31 ? 31 : bk; }
            bd[i] = (p.in[16][bk * 8 + h] - p.in[16][31 * 8 + h]) * 1.4426950408889634f; }
        __syncthreads();
        for (int v = c; v < 256; v += G) { const int bh = v >> 1, od = v & 1;
            for (int i = 0; i < 8; ++i) { const int pr = 2 * (i >> 1) + od; const int qb = (i & 1) ? 15 - pr : pr;
                attn_body::attn_unit<8>(bh >> 3, bh & 7, qb, (const attn_body::bf16*)(p.ws + WS_Q), (const attn_body::bf16*)(p.ws + WS_K), (const attn_body::bf16*)(p.ws + WS_V),
                                        (attn_body::bf16*)(p.ws + WS_YB), (const unsigned long long*)(p.ws + WS_MASK), (char*)lds_g); } }
    }
    if constexpr (PH == 7) { Gemm g{(const bf16_t*)((char*)p.out + DO_YA), (const bf16_t*)(p.ws + WS_WTA), T, 1024, 512}; pg8::StaticOrder S; S.init(T, 1024, G, c);
        EpiGateMul E{(const bf16_t*)(p.ws + WS_SGA), (bf16_t*)(p.ws + WS_SGA), 0}; pg8::gemm_phase<EpiGateMul, pg8::StaticOrder, true, true>(lds, g, S, E); }
    if constexpr (PH == 8) { Gemm g{(const bf16_t*)(p.ws + WS_YB), (const bf16_t*)(p.ws + WS_WTB), T, 1024, 512}; pg8::StaticOrder S; S.init(T, 1024, G, c);
        EpiGateMul E{(const bf16_t*)(p.ws + WS_SGB), (bf16_t*)(p.ws + WS_SGA), 1}; pg8::gemm_phase<EpiGateMul, pg8::StaticOrder, true, true>(lds, g, S, E); }
    if constexpr (PH == 9) { Gemm g{(const bf16_t*)(p.ws + WS_SGA), (const bf16_t*)(p.ws + WS_WTOUT), T, 1024, 1024}; pg8::StaticOrder S; S.init(T, 1024, G, c);
        EpiResid E{p.in[0], p.out, 1.189207115002721f}; pg8::gemm_phase<EpiResid, pg8::StaticOrder, true, true>(lds, g, S, E); }
    if constexpr (PH == 10) phase_ln_router(p, lds);
    if constexpr (PH == 11) { LAS int* tab = (LAS int*)(lds + LDS_TAB); moe_tables(p, tab); phase_permute(p, tab); }
    if constexpr (PH == 12) { LAS int* tab = (LAS int*)(lds + LDS_TAB); moe_tables(p, tab);
        { Gemm g{(const bf16_t*)(p.ws + WS_XS), (const bf16_t*)(p.ws + WS_WTGU), NROWS_PAD, 32 * 1024, 1024}; MoeOrder S{tab, G, c};
          EpiSwiglu E{(bf16_t*)(p.ws + WS_ACT)}; pg8::gemm_phase<EpiSwiglu, MoeOrder, true, true>(lds, g, S, E); } }
    if constexpr (PH == 13) { LAS int* tab = (LAS int*)(lds + LDS_TAB); moe_tables(p, tab);
        { Gemm g{(const bf16_t*)(p.ws + WS_ACT), (const bf16_t*)(p.ws + WS_WTDN), NROWS_PAD, 32 * 1024, 512}; MoeOrder S{tab, G, c};
          EpiDown E{(bf16_t*)(p.ws + WS_XS)}; pg8::gemm_phase<EpiDown, MoeOrder, true, true>(lds, g, S, E); } }
    if constexpr (PH == 14) { LAS int* tab = (LAS int*)(lds + LDS_TAB); moe_tables(p, tab); phase_final(p, tab); }
}

template <int PH> __global__ void __launch_bounds__(NTHREADS, 2) k_phase(Params p) {
    extern __shared__ __attribute__((aligned(16))) unsigned char lds[];
    run_phase<PH>(p, lds);
}
__global__ void __launch_bounds__(NTHREADS, 2) k_all(Params p) {
    extern __shared__ __attribute__((aligned(16))) unsigned char lds[];
    cooperative_groups::grid_group grid = cooperative_groups::this_grid();
    run_phase<0>(p, lds); grid.sync();
    run_phase<1>(p, lds); grid.sync();
    run_phase<2>(p, lds); grid.sync();
    run_phase<3>(p, lds); grid.sync();
    run_phase<4>(p, lds); grid.sync();
    run_phase<5>(p, lds); grid.sync();
    run_phase<6>(p, lds); grid.sync();
    run_phase<7>(p, lds); grid.sync();
    run_phase<8>(p, lds); grid.sync();
    run_phase<9>(p, lds); grid.sync();
    run_phase<10>(p, lds); grid.sync();
    run_phase<11>(p, lds); grid.sync();
    run_phase<12>(p, lds); grid.sync();
    run_phase<13>(p, lds); grid.sync();
    run_phase<14>(p, lds);
}
}

extern "C" void kernel_launch(void* const* d_in, const int* in_sizes, int n_in, void* d_out, int out_size,
                              void* d_ws, size_t ws_size, hipStream_t stream) {
    mk::Params p{};
    for (int i = 0; i < 30; ++i) p.in[i] = (const float*)d_in[i];
    p.out = (float*)d_out; p.ws = (char*)d_ws;
    if (ws_size < mk::WS_END) { fprintf(stderr, "workspace too small: %zu\n", ws_size); return; }
    static int grid_blocks = 0;
    if (!grid_blocks) {
        int dev = 0, cus = 0, per_cu = 0;
        (void)hipGetDevice(&dev);
        (void)hipDeviceGetAttribute(&cus, hipDeviceAttributeMultiprocessorCount, dev);
        (void)hipFuncSetAttribute((const void*)mk::k_all, hipFuncAttributeMaxDynamicSharedMemorySize, mk::LDS_TOTAL);
        (void)hipOccupancyMaxActiveBlocksPerMultiprocessor(&per_cu, mk::k_all, mk::NTHREADS, mk::LDS_TOTAL);
        grid_blocks = cus * (per_cu > 1 ? 1 : per_cu);
    }
    void* args[] = {&p};
    hipError_t e = hipLaunchCooperativeKernel((void*)mk::k_all, dim3(grid_blocks), dim3(mk::NTHREADS), args, mk::LDS_TOTAL, stream);
    if (e != hipSuccess) fprintf(stderr, "cooperative launch failed: %s (grid %d)\n", hipGetErrorString(e), grid_blocks);
}
```

```cpp
#include <hip/hip_runtime.h>
#include <hip/hip_bf16.h>
#include <hip/hip_cooperative_groups.h>
#include <cstdio>
#include <cstdint>
#include <cmath>
__device__ __forceinline__ int mk_tid() { int t = threadIdx.x; asm volatile("" : "+v"(t)); return t; }
#define LAS __attribute__((address_space(3)))
#define XB_TMO      128
#define XB_XCNT(j)  (256  + 64 * (j))
#define XB_XSUB(j)  (1280 + 64 * (j))
#define XB_XGEN(j)  (2304 + 64 * (j))
#define XB_TOP      3328
#define XB_TOPGEN   3392
#define XCD_BAR_WORDS 3456
#define XB_SPIN_CAP (1u << 18)

__device__ __forceinline__ unsigned xb_ld(unsigned* p)              { return __hip_atomic_load(p, __ATOMIC_RELAXED, __HIP_MEMORY_SCOPE_AGENT); }
__device__ __forceinline__ unsigned xb_add(unsigned* p, unsigned v) { return __hip_atomic_fetch_add(p, v, __ATOMIC_RELAXED, __HIP_MEMORY_SCOPE_AGENT); }
__device__ __forceinline__ unsigned xb_xcc_id() { return (unsigned)__builtin_amdgcn_s_getreg((3 << 11) | 20) & 0xFu; }
#define XB_SPIN(cond, bar) do { unsigned _sp = 0; while (cond) { __builtin_amdgcn_s_sleep(1); \
    if ((++_sp & 255u) == 0u) { if (xb_ld(&(bar)[XB_TMO])) break; if (_sp > XB_SPIN_CAP) { atomicAdd(&(bar)[XB_TMO], 1u); break; } } } } while (0)

struct XcdBarrier {
    unsigned* bar; unsigned x;
    volatile LAS unsigned* st;
};

__device__ __forceinline__ XcdBarrier xcd_barrier_post(unsigned* bar, volatile LAS unsigned* st) {
    XcdBarrier b; b.bar = bar; b.x = xb_xcc_id(); b.st = st;
    if (mk_tid() == 0) (void)xb_add(&bar[XB_XCNT(b.x)], 1u);
    return b;
}
__device__ __forceinline__ void xcd_barrier_complete(unsigned* bar, unsigned x, unsigned& nloc, unsigned& nx) {
    const unsigned G = gridDim.x * gridDim.y * gridDim.z;
    unsigned sum, cnt, mine, sp = 0u;
    for (;;) {
        sum = 0u; cnt = 0u; mine = 0u;
#pragma unroll
        for (unsigned j = 0; j < 16; ++j) { const unsigned c = xb_ld(&bar[XB_XCNT(j)]); sum += c; cnt += (c > 0u) ? 1u : 0u; mine = (j == x) ? c : mine; }
        if (sum == G) break;
        __builtin_amdgcn_s_sleep(1);
        if ((++sp & 255u) == 0u) { if (xb_ld(&bar[XB_TMO])) break; if (sp > XB_SPIN_CAP) { atomicAdd(&bar[XB_TMO], 1u); break; } }
    }
    nloc = mine > 0u ? mine : 1u; nx = cnt > 0u ? cnt : 1u;
}

__device__ __forceinline__ void xcd_barrier(const XcdBarrier& b) {
    asm volatile("s_waitcnt vmcnt(0)" ::: "memory");
    __syncthreads();
    if (mk_tid() == 0) {
        unsigned* bar = b.bar;
        __builtin_amdgcn_s_waitcnt(0);
        unsigned nloc = b.st[0], nx = b.st[1];
        if (nloc == 0u) { xcd_barrier_complete(bar, b.x, nloc, nx); b.st[0] = nloc; b.st[1] = nx; }
        const unsigned old = xb_add(&bar[XB_XSUB(b.x)], 1u);
        const unsigned gen = old / nloc;
        if (old + 1u == (gen + 1u) * nloc) {
            __builtin_amdgcn_fence(__ATOMIC_RELEASE, "agent");
            asm volatile("s_waitcnt vmcnt(0)" ::: "memory");
            const unsigned og = xb_add(&bar[XB_TOP], 1u);
            const unsigned tg = og / nx;
            if (og + 1u == (tg + 1u) * nx) xb_add(&bar[XB_TOPGEN], 1u);
            else XB_SPIN(xb_ld(&bar[XB_TOPGEN]) == tg, bar);
            __builtin_amdgcn_fence(__ATOMIC_ACQUIRE, "agent");
            xb_add(&bar[XB_XGEN(b.x)], 1u);
            asm volatile("s_waitcnt vmcnt(0)" ::: "memory");
        } else {
            XB_SPIN(xb_ld(&bar[XB_XGEN(b.x)]) == gen, bar);
            __builtin_amdgcn_fence(__ATOMIC_ACQUIRE, "agent");
            asm volatile("s_waitcnt vmcnt(0)" ::: "memory");
        }
    }
    __syncthreads();
}

namespace pg8 {
#define PG8_LAS __attribute__((address_space(3)))
typedef unsigned short bf16_t;
typedef short bf16x8 __attribute__((ext_vector_type(8)));
typedef float f32x4 __attribute__((ext_vector_type(4)));
typedef unsigned u32x4 __attribute__((ext_vector_type(4)));
constexpr int BM = 256, BK = 64, HALF = 128, HTB = HALF * BK * 2  , STAGE_BYTES = 8 * HTB, NXCD = 8, WGM = 8;

__host__ __device__ __forceinline__ int lds_byte(int r, int c) { const int st = (r >> 4) * 2 + (c >> 5), rr = r & 15, cc = c & 31, ob = rr * 64 + cc * 2; return st * 1024 + (ob ^ (((ob >> 9) & 1) << 5)); }
__host__ __device__ __forceinline__ void stage_rc(int b, int& R, int& C) { const int st = b / 1024, sb = b % 1024, swz = sb ^ (((sb >> 9) & 1) << 5); R = (st >> 1) * 16 + swz / 64; C = (st & 1) * 32 + (swz % 64) / 2; }
__host__ __device__ __forceinline__ int perm32(int rho) { const int n = rho >> 4, i = rho & 15; return 8 * (i >> 2) + 4 * n + (i & 3); }

struct Unit { int pm, pn; };
struct Gemm { const bf16_t* A; const bf16_t* Bt; int M, N, K; };

struct StaticOrder {
    int nM, nN, nwg, G, c;
    __host__ __device__ void init(int M, int N, int G_, int c_) { nM = M / BM; nN = N / BM; nwg = nM * nN; G = G_; c = c_; }
    __host__ __device__ bool next(int i, Unit& u) const {
        const long L = (long)i * G + c; if (L >= nwg) return false;
        int wgid = (int)L; { const int q = nwg / NXCD, r = nwg % NXCD, xcd = wgid % NXCD, off = wgid / NXCD; wgid = (xcd < r ? xcd * (q + 1) : r * (q + 1) + (xcd - r) * q) + off; }
        const int nig = WGM * nN, gid = wgid / nig, fm = gid * WGM, gsz = (nM - fm) < WGM ? (nM - fm) : WGM;
        u.pm = fm + ((wgid % nig) % gsz); u.pn = (wgid % nig) / gsz; return true;
    }
    __device__ __forceinline__ void a_ready(const Unit&) const {}
    __device__ __forceinline__ void done(const Unit&) const {}
};

__device__ __forceinline__ unsigned cvt_pk_bf16(float lo, float hi) { unsigned r; asm volatile("v_cvt_pk_bf16_f32 %0, %1, %2" : "=v"(r) : "v"(lo), "v"(hi)); return r; }

template <class Epi, class Sched, bool ALIGN_EPI = false, bool SP2 = false>
__device__ __forceinline__ void gemm_phase(PG8_LAS unsigned char* lds, const Gemm g, const Sched& S, const Epi& E) {
    const int tid = mk_tid(), wid = __builtin_amdgcn_readfirstlane(tid >> 6), lane = tid & 63, wr = wid >> 2, wc = wid & 3, fr = lane & 15, fq = lane >> 4;
    const int K = g.K, nt = K / BK;
    unsigned voffA[2], voffB[2];
#pragma unroll
    for (int i = 0; i < 2; ++i) { int R, C; stage_rc(tid * 16 + i * 8192, R, C); const int Rb = Epi::PERM ? ((R & ~31) + perm32(R & 31)) : R;
        voffA[i] = (unsigned)(R * K + C) * 2u; voffB[i] = (unsigned)(Rb * K + C) * 2u; }
    const size_t kstep = (size_t)(BK * 2);
    const size_t hstep = (size_t)HALF * K * 2;
    const size_t tstep = 2 * hstep;
    const unsigned ldsw = (unsigned)wid * 1024u;
    const int aoff = lds_byte(wr * 64 + fr, fq * 8), boff = lds_byte(wc * 32 + fr, fq * 8);
#define PG8_SA(b, h) (((b) * 2 + (h)) * HTB)
#define PG8_SB(b, h) ((4 + (b) * 2 + (h)) * HTB)
#define PG8_STAGE(bufoff, gbase, voff) do { _Pragma("unroll") for (int _i = 0; _i < 2; ++_i) \
        __builtin_amdgcn_global_load_lds((const unsigned*)((const char*)(gbase) + (voff)[_i]), (PG8_LAS unsigned*)(lds + (bufoff) + ldsw + _i * 8192), 16, 0, 0); } while (0)
#define PG8_LDA(dst, b, h) do { _Pragma("unroll") for (int m = 0; m < 4; ++m) _Pragma("unroll") for (int k = 0; k < 2; ++k) dst[m][k] = *(const PG8_LAS bf16x8*)(lds + PG8_SA(b, h) + aoff + m * 2048 + k * 1024); } while (0)
#define PG8_LDB(dst, b, h) do { _Pragma("unroll") for (int n = 0; n < 2; ++n) _Pragma("unroll") for (int k = 0; k < 2; ++k) dst[n][k] = *(const PG8_LAS bf16x8*)(lds + PG8_SB(b, h) + boff + n * 2048 + k * 1024); } while (0)
#define PG8_MMA(ai, bj, At, Bt) do { __builtin_amdgcn_s_setprio(1); _Pragma("unroll") for (int m = 0; m < 4; ++m) _Pragma("unroll") for (int n = 0; n < 2; ++n) _Pragma("unroll") for (int k = 0; k < 2; ++k) \
        acc[ai][bj][m][n] = __builtin_amdgcn_mfma_f32_16x16x32_bf16(Bt[n][k], At[m][k], acc[ai][bj][m][n], 0, 0, 0); __builtin_amdgcn_s_setprio(0); } while (0)
#define PG8_WAIT_V(n) asm volatile("s_waitcnt vmcnt(" #n ")" ::: "memory")
#define PG8_WAIT_L(n) asm volatile("s_waitcnt lgkmcnt(" #n ")" ::: "memory")
#define PG8_BAR __builtin_amdgcn_s_barrier()
#define PG8_SCHED __builtin_amdgcn_sched_barrier(0)
    Unit cur, nxt; int ui = 0;
    if (!S.next(0, cur)) return;
    f32x4 acc[2][2][4][2];
#pragma unroll
    for (int a = 0; a < 2; ++a)
#pragma unroll
        for (int b = 0; b < 2; ++b)
#pragma unroll
            for (int m = 0; m < 4; ++m)
#pragma unroll
                for (int n = 0; n < 2; ++n) acc[a][b][m][n] = (f32x4){0.f, 0.f, 0.f, 0.f};
    bf16x8 At[4][2], B0[2][2], B1[2][2];
    const char* cA = (const char*)g.A + (size_t)cur.pm * tstep; const char* cB = (const char*)g.Bt + (size_t)cur.pn * tstep;
    S.a_ready(cur);
    if constexpr (SP2) {
        PG8_STAGE(PG8_SB(0, 0), cB, voffB); PG8_STAGE(PG8_SB(0, 1), cB + hstep, voffB); PG8_STAGE(PG8_SA(0, 0), cA, voffA); PG8_STAGE(PG8_SA(0, 1), cA + hstep, voffA);
        if (wr == 1) PG8_BAR;
        PG8_WAIT_V(2); PG8_BAR;
        PG8_STAGE(PG8_SB(1, 0), cB + kstep, voffB); PG8_STAGE(PG8_SA(1, 0), cA + kstep, voffA); PG8_STAGE(PG8_SB(1, 1), cB + hstep + kstep, voffB);
        PG8_WAIT_V(6); PG8_BAR;
    } else {
        PG8_STAGE(PG8_SB(0, 0), cB, voffB); PG8_STAGE(PG8_SA(0, 0), cA, voffA); PG8_STAGE(PG8_SB(0, 1), cB + hstep, voffB); PG8_STAGE(PG8_SA(0, 1), cA + hstep, voffA);
        if (wr == 1) PG8_BAR;
        PG8_WAIT_V(4); PG8_BAR;
        PG8_STAGE(PG8_SB(1, 0), cB + kstep, voffB); PG8_STAGE(PG8_SA(1, 0), cA + kstep, voffA); PG8_STAGE(PG8_SB(1, 1), cB + hstep + kstep, voffB);
        PG8_WAIT_V(6); PG8_BAR;
    }
    for (;;) {
        const bool has_next = S.next(ui + 1, nxt);
        const char* nA = has_next ? (const char*)g.A + (size_t)nxt.pm * tstep : cA; const char* nB = has_next ? (const char*)g.Bt + (size_t)nxt.pn * tstep : cB;
        for (int t = 0; t < nt; t += 2) {
            const bool last = (t == nt - 2);
            const char* a1 = cA + (size_t)(t + 1) * kstep;
            const char* a2 = last ? nA : cA + (size_t)(t + 2) * kstep; const char* b2 = last ? nB : cB + (size_t)(t + 2) * kstep;
            const char* a3 = a2 + kstep; const char* b3 = b2 + kstep;
            if (last && has_next) S.a_ready(nxt);
            if constexpr (SP2) {
            PG8_LDB(B0, 0, 0); PG8_LDB(B1, 0, 1); PG8_SCHED; PG8_LDA(At, 0, 0); PG8_STAGE(PG8_SA(1, 1), a1 + hstep, voffA);
            PG8_WAIT_V(8); PG8_WAIT_L(0); PG8_BAR; PG8_MMA(0, 0, At, B0); PG8_MMA(0, 1, At, B1); PG8_BAR; PG8_SCHED;
            PG8_LDA(At, 0, 1); PG8_STAGE(PG8_SB(0, 0), b2, voffB); PG8_STAGE(PG8_SB(0, 1), b2 + hstep, voffB); PG8_STAGE(PG8_SA(0, 0), a2, voffA);
            PG8_WAIT_V(8); PG8_WAIT_L(0); PG8_BAR; PG8_MMA(1, 0, At, B0); PG8_MMA(1, 1, At, B1); PG8_BAR; PG8_SCHED;
            PG8_LDB(B0, 1, 0); PG8_LDB(B1, 1, 1); PG8_SCHED; PG8_LDA(At, 1, 0); PG8_STAGE(PG8_SA(0, 1), a2 + hstep, voffA);
            PG8_WAIT_V(8); PG8_WAIT_L(0); PG8_BAR; PG8_MMA(0, 0, At, B0); PG8_MMA(0, 1, At, B1); PG8_BAR; PG8_SCHED;
            PG8_LDA(At, 1, 1); PG8_STAGE(PG8_SB(1, 0), b3, voffB); PG8_STAGE(PG8_SB(1, 1), b3 + hstep, voffB); PG8_STAGE(PG8_SA(1, 0), a3, voffA);
            PG8_WAIT_V(8); PG8_WAIT_L(0); PG8_BAR; PG8_MMA(1, 0, At, B0); PG8_MMA(1, 1, At, B1); PG8_BAR; PG8_SCHED;
            } else {
            PG8_LDB(B0, 0, 0); PG8_SCHED; PG8_LDA(At, 0, 0); PG8_STAGE(PG8_SA(1, 1), a1 + hstep, voffA);
            PG8_WAIT_L(8); PG8_BAR; PG8_WAIT_L(0); PG8_MMA(0, 0, At, B0); PG8_BAR; PG8_SCHED;
            PG8_LDB(B1, 0, 1); PG8_STAGE(PG8_SB(0, 0), b2, voffB);
            PG8_BAR; PG8_WAIT_L(0); PG8_MMA(0, 1, At, B1); PG8_BAR;
            PG8_LDA(At, 0, 1); PG8_STAGE(PG8_SA(0, 0), a2, voffA);
            PG8_BAR; PG8_WAIT_L(0); PG8_MMA(1, 0, At, B0); PG8_BAR; PG8_SCHED;
            PG8_STAGE(PG8_SB(0, 1), b2 + hstep, voffB);
            PG8_WAIT_V(6); PG8_BAR; PG8_MMA(1, 1, At, B1); PG8_BAR;
            PG8_LDB(B0, 1, 0); PG8_SCHED; PG8_LDA(At, 1, 0); PG8_STAGE(PG8_SA(0, 1), a2 + hstep, voffA);
            PG8_WAIT_L(8); PG8_BAR; PG8_WAIT_L(0); PG8_MMA(0, 0, At, B0); PG8_BAR; PG8_SCHED;
            PG8_LDB(B1, 1, 1); PG8_STAGE(PG8_SB(1, 0), b3, voffB);
            PG8_BAR; PG8_WAIT_L(0); PG8_MMA(0, 1, At, B1); PG8_BAR;
            PG8_LDA(At, 1, 1); PG8_STAGE(PG8_SA(1, 0), a3, voffA);
            PG8_BAR; PG8_WAIT_L(0); PG8_MMA(1, 0, At, B0); PG8_BAR; PG8_SCHED;
            PG8_STAGE(PG8_SB(1, 1), b3 + hstep, voffB);
            PG8_WAIT_V(6); PG8_BAR; PG8_MMA(1, 1, At, B1); PG8_BAR;
            }
        }
        if constexpr (ALIGN_EPI) { if (wr == 0) PG8_BAR; }
        if constexpr (!Epi::AFTER_DRAIN) { E(acc, cur, wr, wc, fr, fq); S.done(cur); }
        if (!has_next) break;
#pragma unroll
        for (int a = 0; a < 2; ++a)
#pragma unroll
            for (int b = 0; b < 2; ++b)
#pragma unroll
                for (int m = 0; m < 4; ++m)
#pragma unroll
                    for (int n = 0; n < 2; ++n) acc[a][b][m][n] = (f32x4){0.f, 0.f, 0.f, 0.f};
        cur = nxt; cA = nA; cB = nB; ++ui;
        if constexpr (ALIGN_EPI) { if (wr == 1) PG8_BAR; }
    }
    PG8_WAIT_V(0);
    if constexpr (!ALIGN_EPI) { if (wr == 0) PG8_BAR; }
    PG8_BAR;
    if constexpr (Epi::AFTER_DRAIN) { E.fused(acc, cur, wr, wc, fr, fq, lds, wid, lane); S.done(cur); }
#undef PG8_SA
#undef PG8_SB
#undef PG8_STAGE
#undef PG8_LDA
#undef PG8_LDB
#undef PG8_MMA
#undef PG8_WAIT_V
#undef PG8_WAIT_L
#undef PG8_BAR
#undef PG8_SCHED
}
}
namespace attn_body {
using bf16=__hip_bfloat16;
using bf16x8=__attribute__((ext_vector_type(8)))short;
using s16x4=__attribute__((ext_vector_type(4)))short;
using f32x16=__attribute__((ext_vector_type(16)))float;
using u32x4=__attribute__((ext_vector_type(4)))unsigned;
constexpr int BATCH=16,NHEAD=8,SEQ=4096,D=64,DM=NHEAD*D;
constexpr int NW=8,QBLK=32,QB=QBLK*NW,KVBLK=64,NQB=SEQ/QB;
constexpr int ATTN_PITCH=DM, ATTN_UNIT_ROWS=QB;
__device__ __forceinline__ int crow(int r,int hi){return (r&3)+8*(r>>2)+4*hi;}
#define SBAR() __builtin_amdgcn_sched_barrier(0)
__device__ __forceinline__ void biasw(f32x16&p0,f32x16&p1,int dbase,const __attribute__((address_space(3))) float*bdl){
  #pragma unroll
  for(int r=0;r<16;++r){const int pos=(r&3)+8*(r>>2);
    int d0=dbase-pos, d1=d0-32; d0=d0<0?0:(d0>127?127:d0); d1=d1<0?0:(d1>127?127:d1); p0[r]+=bdl[d0]; p1[r]+=bdl[d1]; }
}
#define MPOS(r) (((r)&3)+8*((r)>>2))
__device__ __forceinline__ float mand(float p,unsigned w,int pos){ return __builtin_bit_cast(float,__builtin_bit_cast(unsigned,p)&(unsigned)__builtin_amdgcn_sbfe((int)w,pos,1)); }

constexpr int NSLOT=3, SLOTB=8192;
constexpr int LDS_K=0, LDS_V=NSLOT*SLOTB, LDS_WS=2*NSLOT*SLOTB, LDS_OST=LDS_WS+NW*64*4, LDS_BIAS=LDS_OST+NW*4096, LDS_BYTES=LDS_BIAS+NHEAD*128*4;
constexpr float C2=0.125f*1.4426950408889634f;
__device__ __forceinline__ void glds16(const void*gsrc,unsigned lds_dst){unsigned keep;
  asm volatile("s_mov_b32 %0, m0\n\ts_mov_b32 m0, %2\n\ts_nop 0\n\tglobal_load_lds_dwordx4 %1, off\n\ts_mov_b32 m0, %0":"=&s"(keep):"v"(gsrc),"s"(lds_dst):"memory");}
__device__ __forceinline__ float max3f(float a,float b,float c){float r;asm("v_max3_f32 %0, %1, %2, %3":"=v"(r):"v"(a),"v"(b),"v"(c));return r;}
__device__ __forceinline__ float max2f(float a,float b){float r;asm("v_max_f32_e32 %0, %1, %2":"=v"(r):"v"(a),"v"(b));return r;}
__device__ __forceinline__ float fadd_s(float a,float b){float r;asm("v_add_f32_e32 %0, %1, %2":"=v"(r):"v"(a),"v"(b));return r;}
__device__ __forceinline__ float fsub_s(float a,float b){float r;asm("v_sub_f32_e32 %0, %1, %2":"=v"(r):"v"(a),"v"(b));return r;}
typedef float f32x2_t __attribute__((ext_vector_type(2))); typedef __bf16 bf16x2_t __attribute__((ext_vector_type(2)));
__device__ __forceinline__ unsigned cvtpk_s(float lo,float hi){f32x2_t v={lo,hi};bf16x2_t b=__builtin_convertvector(v,bf16x2_t);return __builtin_bit_cast(unsigned,b);}
#define WAIT_BAR(N) asm volatile("s_waitcnt vmcnt(" #N ") lgkmcnt(0)\n\ts_barrier":::"memory")

__device__ __forceinline__ void qkt(f32x16&p0,f32x16&p1,const char*Kslot,const bf16x8*qr,const f32x16&negm,int r32,int hi){
  const char*kb=Kslot+hi*1024+r32*16;
  #pragma unroll
  for(int d0=0;d0<4;++d0){
    const bf16x8 b0=*reinterpret_cast<const bf16x8*>(kb+d0*2048);
    const bf16x8 b1=*reinterpret_cast<const bf16x8*>(kb+d0*2048+512);
    if(d0==0){p0=__builtin_amdgcn_mfma_f32_32x32x16_bf16(b0,qr[0],negm,0,0,0);p1=__builtin_amdgcn_mfma_f32_32x32x16_bf16(b1,qr[0],negm,0,0,0);}
    else{p0=__builtin_amdgcn_mfma_f32_32x32x16_bf16(b0,qr[d0],p0,0,0,0);p1=__builtin_amdgcn_mfma_f32_32x32x16_bf16(b1,qr[d0],p1,0,0,0);}}
}
typedef __attribute__((address_space(3))) const char* lds_cptr;
typedef short v4i16_t __attribute__((ext_vector_type(4)));
__device__ __forceinline__ void kload8(bf16x8*kf,lds_cptr kp){
  kf[0]=*(const __attribute__((address_space(3))) bf16x8*)(kp);      kf[1]=*(const __attribute__((address_space(3))) bf16x8*)(kp+512);
  kf[2]=*(const __attribute__((address_space(3))) bf16x8*)(kp+2048); kf[3]=*(const __attribute__((address_space(3))) bf16x8*)(kp+2560);
  kf[4]=*(const __attribute__((address_space(3))) bf16x8*)(kp+4096); kf[5]=*(const __attribute__((address_space(3))) bf16x8*)(kp+4608);
  kf[6]=*(const __attribute__((address_space(3))) bf16x8*)(kp+6144); kf[7]=*(const __attribute__((address_space(3))) bf16x8*)(kp+6656);
}
__device__ __forceinline__ void kload2(bf16x8*kf,lds_cptr kp,int j){ kf[2*j]=*(const __attribute__((address_space(3))) bf16x8*)(kp+j*2048); kf[2*j+1]=*(const __attribute__((address_space(3))) bf16x8*)(kp+j*2048+512); }
__device__ __forceinline__ s16x4 vtr(lds_cptr p){ return __builtin_bit_cast(s16x4,__builtin_amdgcn_ds_read_tr16_b64_v4i16((__attribute__((address_space(3))) v4i16_t*)p)); }
__device__ __forceinline__ float rowmax(const f32x16&p0,const f32x16&p1){
  float a=max3f(p0[0],p0[1],p1[0]),b=max3f(p0[2],p0[3],p1[1]);a=max3f(a,p1[2],p1[3]);
  #pragma unroll
  for(int r=4;r<16;r+=4){a=max3f(a,p0[r],p0[r+1]);b=max3f(b,p0[r+2],p0[r+3]);a=max3f(a,p1[r],p1[r+1]);b=max3f(b,p1[r+2],p1[r+3]);}
  const float m=max2f(a,b);
  auto rr=__builtin_amdgcn_permlane32_swap(__float_as_uint(m),__float_as_uint(m),false,false);
  return max2f(__uint_as_float(rr[0]),__uint_as_float(rr[1]));
}
__device__ __forceinline__ void pv(f32x16*o,int vb,bf16x8 pa0,bf16x8 pa1,bf16x8 pa2,bf16x8 pa3){
  #pragma unroll
  for(int d0=0;d0<2;++d0){s16x4 lo[4],hi[4];
    #pragma unroll
    for(int ks=0;ks<4;++ks){
      asm volatile("ds_read_b64_tr_b16 %0,%1 offset:%c2":"=&v"(lo[ks]):"v"(vb),"i"(d0*4096+ks*1024):"memory");
      asm volatile("ds_read_b64_tr_b16 %0,%1 offset:%c2":"=&v"(hi[ks]):"v"(vb),"i"(d0*4096+ks*1024+512):"memory");}
    asm volatile("s_waitcnt lgkmcnt(0)":::"memory");SBAR();
    #define PK(k) (bf16x8){lo[k][0],lo[k][1],lo[k][2],lo[k][3],hi[k][0],hi[k][1],hi[k][2],hi[k][3]}
    o[d0]=__builtin_amdgcn_mfma_f32_32x32x16_bf16(pa0,PK(0),o[d0],0,0,0);
    o[d0]=__builtin_amdgcn_mfma_f32_32x32x16_bf16(pa1,PK(1),o[d0],0,0,0);
    o[d0]=__builtin_amdgcn_mfma_f32_32x32x16_bf16(pa2,PK(2),o[d0],0,0,0);
    o[d0]=__builtin_amdgcn_mfma_f32_32x32x16_bf16(pa3,PK(3),o[d0],0,0,0);
    #undef PK
  }
}

#ifndef ATTN_STORE16
#define ATTN_STORE16(p,v) (*(u32x4*)(p)=(v))
#endif
template<int THRL> __device__ __forceinline__ void attn_unit(int b,int h,int qb,const bf16*Q,const bf16*__restrict__ K,const bf16*__restrict__ V,bf16*O,const unsigned long long*MK,char*shm){
  const int tid=mk_tid(),lane=tid&63,r32=lane&31,hi=lane>>5; const int wid=__builtin_amdgcn_readfirstlane(tid>>6);
  const long rowbase=(long)b*SEQ; const int q0=qb*QB;
  const bf16*Qw=Q+(rowbase+q0+wid*QBLK)*DM+h*D;
  const bf16*Kh=K+rowbase*DM+h*D,*Vh=V+rowbase*DM+h*D;
  const lds_cptr shm3=(lds_cptr)shm;
  const unsigned lds0=(unsigned)(uintptr_t)shm;
  float*wsf=(float*)(shm+LDS_WS)+wid*64;
  const bf16*ksrc=Kh+(long)lane*DM+wid*8;
  const bf16*vsrc=Vh+(long)(16*(wid&3)+(lane>>2))*DM+(wid>>2)*32+(lane&3)*8;
  const unsigned kdst=lds0+LDS_K+wid*1024, vdst=lds0+LDS_V+wid*1024;
  #define DMA_K(t,slot) glds16(ksrc+(long)(t)*KVBLK*DM,(unsigned)__builtin_amdgcn_readfirstlane(kdst+(slot)))
  #define DMA_V(t,slot) glds16(vsrc+(long)(t)*KVBLK*DM,(unsigned)__builtin_amdgcn_readfirstlane(vdst+(slot)))
  const int vb0=(int)(lds0+LDS_V)+((lane>>4)&1)*32+(lane&3)*8+(4*hi+((lane&15)>>2))*64;
  const char*Kbase=shm+LDS_K; bf16x8 kf[8];
  const lds_cptr kp0=shm3+LDS_K+hi*1024+r32*16; const lds_cptr vp0=shm3+LDS_V+((lane>>4)&1)*32+(lane&3)*8+(4*hi+((lane&15)>>2))*64;
  const int NT=(q0+QB)/KVBLK;
  const int qrel=wid*QBLK+r32;
  const unsigned long long*mkp=MK+(rowbase+q0+qrel)*64;
  const __attribute__((address_space(3))) float*bdl=(const __attribute__((address_space(3))) float*)(shm3+LDS_BIAS)+h*128;
  unsigned long long mwA,mwB;
  #define MLOAD(M,t) asm volatile("global_load_dwordx2 %0, %1, off":"=&v"(M):"v"(mkp+(t)):"memory")
  #define MPIN(M) asm volatile("":"+v"(M))
  MLOAD(mwA,0);MLOAD(mwB,1);
  DMA_K(0,0);DMA_V(0,0);DMA_K(1,SLOTB);
  bf16x8 qr[4];
  #pragma unroll
  for(int d0=0;d0<4;++d0)qr[d0]=*reinterpret_cast<const bf16x8*>(&Qw[(long)r32*DM+d0*16+hi*8]);
  float mhat=0.f,l_reg=0.f;f32x16 o[2];o[0]=f32x16{};o[1]=f32x16{};const f32x16 negm=f32x16{};
  #define CMASK(P0,P1,t,M) do{ if((t)>=NT-6)biasw(P0,P1,q0+qrel-64*(t)-4*hi,bdl); }while(0)
  bool resc=false;
  #define START(P0,P1) do{ const float rm=rowmax(P0,P1); resc=false; mhat=__builtin_fmaxf(rm,0.f); \
    _Pragma("unroll") for(int r=0;r<16;++r)P0[r]=mand(__builtin_amdgcn_exp2f(P0[r]-mhat),((unsigned)mwA)>>(4*hi),MPOS(r)); }while(0)
  #define RESC() do{ if(resc){ asm volatile("s_waitcnt lgkmcnt(0)":::"memory"); \
      _Pragma("unroll") for(int d_=0;d_<2;++d_) _Pragma("unroll") for(int r=0;r<16;++r)o[d_][r]*=wsf[crow(r,hi)]; } }while(0)
  f32x16 pA0,pA1,pB0,pB1;
  int sl_prev=0,sl_cur=0,sl_next=SLOTB;
  #define ROT() do{sl_prev=sl_cur;sl_cur=sl_next;sl_next=(sl_next==(NSLOT-1)*SLOTB)?0:sl_next+SLOTB;}while(0)
  DMA_K(2,2*SLOTB);
  WAIT_BAR(3); MPIN(mwA); MPIN(mwB);
  qkt(pA0,pA1,Kbase,qr,negm,r32,hi);asm volatile("s_nop 15\n\ts_nop 7":"+v"(pA0),"+v"(pA1));CMASK(pA0,pA1,0,mwA);
  START(pA0,pA1);
  _Pragma("unroll") for(int r=0;r<16;++r)pA1[r]=mand(__builtin_amdgcn_exp2f(pA1[r]-mhat),((unsigned)(mwA>>32))>>(4*hi),MPOS(r));
  WAIT_BAR(0);
  DMA_K(3,0);DMA_V(1,SLOTB);
  ROT();
  kload8(kf,kp0+sl_cur);
  WAIT_BAR(2);
  s16x4 vlo[8],vhi[8]; u32x4 pw0,pw1,pw2,pw3;
  #define PKW(P,B) cvtpk_s(P[B],P[B+1])
  #define PAF(k) __builtin_bit_cast(bf16x8,pw##k)
  #define VFR(i) (bf16x8){vlo[i][0],vlo[i][1],vlo[i][2],vlo[i][3],vhi[i][0],vhi[i][1],vhi[i][2],vhi[i][3]}
  #define PIN(x) asm volatile("":"+v"(x))
  #define MX3(a,b,c) __builtin_fmaxf(__builtin_fmaxf((a),(b)),(c))
  #define GAPA(MF,A0,A1,A2,A3,W0,W1,PW) do{ MF; sacc+=A0; sacc+=A1; sacc+=A2; sacc+=A3; PIN(sacc); W0; W1; PIN(PW); SBAR(); }while(0)
  #define EX(v) __builtin_amdgcn_exp2f(v)
  #define GAPB(MF,X,B,W) do{ MF; X[B]=mand(EX(X[B]-mhat),W,MPOS(B)); X[B+1]=mand(EX(X[B+1]-mhat),W,MPOS(B+1)); X[B+2]=mand(EX(X[B+2]-mhat),W,MPOS(B+2)); X[B+3]=mand(EX(X[B+3]-mhat),W,MPOS(B+3)); PIN(X); SBAR(); }while(0)
  #define VRD(i) do{ vlo[i]=vtr(vp_+(((i)>>2)*4096+((i)&3)*1024)); vhi[i]=vtr(vp_+(((i)>>2)*4096+((i)&3)*1024+512)); }while(0)
  #define KRD(G,j) do{ if(G){ kload2(kf,kp0+sl_next,j); SBAR(); } }while(0)
  #define STEP(C0,C1,P0,P1,t,GK,GV,GL,MC,MN) do{ SBAR(); if(GV){MLOAD(MN,(t)+1);} \
    const lds_cptr vp_=vp0+sl_prev; \
    VRD(0); SBAR(); float sacc=(P0[0]+P0[1]); \
    GAPA(C0=__builtin_amdgcn_mfma_f32_32x32x16_bf16(kf[0],qr[0],negm,0,0,0), P0[2],P0[3],P0[4],P0[5],     pw0[0]=PKW(P0,0), pw0[1]=PKW(P0,2), pw0); \
    VRD(4); SBAR(); GAPA(C1=__builtin_amdgcn_mfma_f32_32x32x16_bf16(kf[1],qr[0],negm,0,0,0), P0[6],P0[7],P0[8],P0[9],     pw0[2]=PKW(P0,4), pw0[3]=PKW(P0,6), pw0); \
    VRD(1); SBAR(); GAPA(C0=__builtin_amdgcn_mfma_f32_32x32x16_bf16(kf[2],qr[1],C0,0,0,0),   P0[10],P0[11],P0[12],P0[13], pw1[0]=PKW(P0,8), pw1[1]=PKW(P0,10), pw1); \
    VRD(5); SBAR(); GAPA(C1=__builtin_amdgcn_mfma_f32_32x32x16_bf16(kf[3],qr[1],C1,0,0,0),   P0[14],P0[15],P1[0],P1[1],   pw1[2]=PKW(P0,12),pw1[3]=PKW(P0,14), pw1); \
    VRD(2); SBAR(); GAPA(C0=__builtin_amdgcn_mfma_f32_32x32x16_bf16(kf[4],qr[2],C0,0,0,0),   P1[2],P1[3],P1[4],P1[5],     pw2[0]=PKW(P1,0), pw2[1]=PKW(P1,2), pw2); \
    VRD(6); SBAR(); GAPA(C1=__builtin_amdgcn_mfma_f32_32x32x16_bf16(kf[5],qr[2],C1,0,0,0),   P1[6],P1[7],P1[8],P1[9],     pw2[2]=PKW(P1,4), pw2[3]=PKW(P1,6), pw2); \
    VRD(3); SBAR(); GAPA(C0=__builtin_amdgcn_mfma_f32_32x32x16_bf16(kf[6],qr[3],C0,0,0,0),   P1[10],P1[11],P1[12],P1[13], pw3[0]=PKW(P1,8), pw3[1]=PKW(P1,10), pw3); \
    VRD(7); SBAR(); GAPA(C1=__builtin_amdgcn_mfma_f32_32x32x16_bf16(kf[7],qr[3],C1,0,0,0),   P1[14],P1[15],0.f,0.f,       pw3[2]=PKW(P1,12),pw3[3]=PKW(P1,14), pw3); \
    l_reg+=sacc; \
    if(GK){DMA_K((t)+3,sl_cur);} if(GV){DMA_V((t)+1,sl_next);} \
    CMASK(C0,C1,t,MC); const unsigned mlo_=((unsigned)(MC))>>(4*hi), mhi_=((unsigned)((MC)>>32))>>(4*hi); \
    { float a=MX3(C0[0],C0[1],C1[0]),b=MX3(C0[2],C0[3],C1[1]); a=MX3(a,C1[2],C1[3]); \
      _Pragma("unroll") for(int r=4;r<16;r+=4){a=MX3(a,C0[r],C0[r+1]);b=MX3(b,C0[r+2],C0[r+3]);a=MX3(a,C1[r],C1[r+1]);b=MX3(b,C1[r+2],C1[r+3]);} \
      float rm=__builtin_fmaxf(a,b); { auto rr=__builtin_amdgcn_permlane32_swap(__float_as_uint(rm),__float_as_uint(rm),false,false); rm=__builtin_fmaxf(__uint_as_float(rr[0]),__uint_as_float(rr[1])); } \
      resc=false; const float rd=rm-mhat; \
      if(__builtin_expect(__any(rd>(float)THRL),0)){ const float dl=__builtin_fmaxf(rd,0.f); mhat+=dl; \
        const float f=__builtin_amdgcn_exp2f(-dl); l_reg*=f; if(hi==0)wsf[r32]=f; resc=true; } } \
    SBAR(); \
    GAPB(o[0]=__builtin_amdgcn_mfma_f32_32x32x16_bf16(PAF(0),VFR(0),o[0],0,0,0), C0,0,mlo_); \
    GAPB(o[1]=__builtin_amdgcn_mfma_f32_32x32x16_bf16(PAF(0),VFR(4),o[1],0,0,0), C0,4,mlo_); \
    KRD(GL,0); GAPB(o[0]=__builtin_amdgcn_mfma_f32_32x32x16_bf16(PAF(1),VFR(1),o[0],0,0,0), C0,8,mlo_); \
    KRD(GL,1); GAPB(o[1]=__builtin_amdgcn_mfma_f32_32x32x16_bf16(PAF(1),VFR(5),o[1],0,0,0), C0,12,mlo_); \
    KRD(GL,2); GAPB(o[0]=__builtin_amdgcn_mfma_f32_32x32x16_bf16(PAF(2),VFR(2),o[0],0,0,0), C1,0,mhi_); \
    KRD(GL,3); GAPB(o[1]=__builtin_amdgcn_mfma_f32_32x32x16_bf16(PAF(2),VFR(6),o[1],0,0,0), C1,4,mhi_); \
    GAPB(o[0]=__builtin_amdgcn_mfma_f32_32x32x16_bf16(PAF(3),VFR(3),o[0],0,0,0), C1,8,mhi_); \
    GAPB(o[1]=__builtin_amdgcn_mfma_f32_32x32x16_bf16(PAF(3),VFR(7),o[1],0,0,0), C1,12,mhi_); \
    }while(0)
  int t=1;
  #undef CMASK
  #define CMASK(P0,P1,t,M) do{}while(0)
  for(;t+7<NT;t+=2){
    STEP(pB0,pB1,pA0,pA1,t,true,true,true,mwB,mwA);     WAIT_BAR(2); MPIN(mwA); RESC(); ROT();
    STEP(pA0,pA1,pB0,pB1,t+1,true,true,true,mwA,mwB);   WAIT_BAR(2); MPIN(mwB); RESC(); ROT();
  }
  #undef CMASK
  #define CMASK(P0,P1,t,M) do{ if((t)>=NT-6)biasw(P0,P1,q0+qrel-64*(t)-4*hi,bdl); }while(0)
  #define ENDW(tt) do{ if((tt)+3<NT){WAIT_BAR(2);} else if((tt)+2<NT){WAIT_BAR(1);} else {WAIT_BAR(0);} }while(0)
  for(;t+1<NT;t+=2){
    STEP(pB0,pB1,pA0,pA1,t,(t+3<NT),(t+1<NT),(t+1<NT),mwB,mwA);       ENDW(t);   MPIN(mwA); RESC(); ROT();
    STEP(pA0,pA1,pB0,pB1,t+1,(t+4<NT),(t+2<NT),(t+2<NT),mwA,mwB);     ENDW(t+1); MPIN(mwB); RESC(); ROT();
  }
  STEP(pB0,pB1,pA0,pA1,NT-1,false,false,false,mwB,mwA); RESC();
  { float sacc=pB0[0]+pB0[1]; _Pragma("unroll") for(int r=2;r<16;++r)sacc+=pB0[r]; _Pragma("unroll") for(int r=0;r<16;++r)sacc+=pB1[r]; l_reg+=sacc;
    pw0=(u32x4){PKW(pB0,0),PKW(pB0,2),PKW(pB0,4),PKW(pB0,6)};pw1=(u32x4){PKW(pB0,8),PKW(pB0,10),PKW(pB0,12),PKW(pB0,14)};pw2=(u32x4){PKW(pB1,0),PKW(pB1,2),PKW(pB1,4),PKW(pB1,6)};pw3=(u32x4){PKW(pB1,8),PKW(pB1,10),PKW(pB1,12),PKW(pB1,14)};
    SBAR(); pv(o,vb0+sl_cur,PAF(0),PAF(1),PAF(2),PAF(3)); }
  #undef PKW
  #undef PAF
  #undef VFR
  #undef PIN
  #undef MX3
  #undef GAPA
  #undef GAPB
  #undef EX
  #undef VRD
  #undef KRD
  #undef STEP
  #undef ENDW
  {auto rr=__builtin_amdgcn_permlane32_swap(__float_as_uint(l_reg),__float_as_uint(l_reg),false,false);l_reg=__uint_as_float(rr[0])+__uint_as_float(rr[1]);}
  if(hi==0)wsf[32+r32]=l_reg;asm volatile("s_waitcnt lgkmcnt(0)":::"memory");
  float rli[16];
  #pragma unroll
  for(int r=0;r<16;++r)rli[r]=__builtin_amdgcn_rcpf(wsf[32+crow(r,hi)]);
  bf16*Ow=O+(rowbase+q0+wid*QBLK)*DM+h*D;
  { bf16*stg=(bf16*)(shm+LDS_OST)+wid*2048;
    #pragma unroll
    for(int r=0;r<16;++r){const int orow=crow(r,hi);
      #pragma unroll
      for(int d0=0;d0<2;++d0)stg[orow*64+d0*32+r32]=__float2bfloat16(o[d0][r]*rli[r]);}
    asm volatile("s_waitcnt lgkmcnt(0)":::"memory");
    #pragma unroll
    for(int i=0;i<4;++i){const int row=i*8+(lane>>3),ch=lane&7; const u32x4 v=*(const u32x4*)(stg+row*64+ch*8); ATTN_STORE16(Ow+(long)row*DM+ch*8,v);} }
  asm volatile("s_waitcnt lgkmcnt(0)\n\ts_barrier":::"memory");
  #undef DMA_K
  #undef MLOAD
  #undef MPIN
  #undef DMA_V
  #undef CMASK
  #undef START
  #undef RESC
  #undef ROT
}
constexpr int ATTN_LDS_BYTES=LDS_BYTES;
#undef SBAR
#undef WAIT_BAR
}
namespace mk {
using pg8::bf16_t; using pg8::f32x4; using pg8::u32x4; using pg8::bf16x8; using pg8::Unit; using pg8::Gemm;
constexpr int T = 65536, SEQ = 4096, NBATCH = 16, DM = 1024;
constexpr int NTHREADS = 512, NWAVES = 8;
constexpr size_t MiB = 1u << 20;
constexpr size_t WS_CTL = 0;
constexpr size_t WS_EID = 1 * MiB, WS_GATE = 2 * MiB, WS_SLOT = 3 * MiB;
constexpr size_t WS_WTIN = 4 * MiB;
constexpr size_t WS_WTA = 16 * MiB, WS_WTB = 17 * MiB, WS_WTOUT = 18 * MiB, WS_WTLORA = 20 * MiB;
constexpr size_t WS_WTGU = 21 * MiB;
constexpr size_t WS_WTDN = 85 * MiB;
constexpr size_t WS_KN = 117 * MiB;
constexpr size_t WS_MISC = 125 * MiB;
constexpr size_t WS_AP = 145 * MiB;
constexpr size_t WS_MASK = 177 * MiB;
constexpr size_t WS_YB = 209 * MiB;
constexpr size_t WS_RW = 273 * MiB;
constexpr size_t WS_Q = 497 * MiB, WS_K = 561 * MiB, WS_V = 625 * MiB, WS_QI = 689 * MiB;
constexpr size_t WS_SGA = 753 * MiB, WS_SGB = 881 * MiB;
constexpr size_t WS_END = 1009 * MiB;
constexpr size_t WS_H1B = WS_RW;
constexpr size_t WS_XS = WS_Q;
constexpr size_t WS_ACT = 769 * MiB;
constexpr int NROWS_PAD = 131072 + 32 * 256;
static_assert(WS_XS + (size_t)NROWS_PAD * 2048 <= WS_ACT && WS_ACT + (size_t)NROWS_PAD * 1024 <= WS_END, "overlay map");
constexpr size_t DO_XBF = 0;
constexpr size_t DO_OMW = 0, DO_ASIG = 64 * MiB, DO_G = 128 * MiB, DO_YA = 192 * MiB;

constexpr int LDS_TOTAL = 155648;
constexpr int LDS_TAB = 131072;

struct Params { const float* in[30]; float* out; char* ws; };

__device__ __forceinline__ float wave_sum(float v) {
#pragma unroll
    for (int o = 1; o < 64; o <<= 1) v += __shfl_xor(v, o);
    return v;
}
__device__ __forceinline__ unsigned f2bf(float f) { unsigned u = __builtin_bit_cast(unsigned, f); return (u + 0x7fffu + ((u >> 16) & 1u)) >> 16; }
__device__ __forceinline__ unsigned pk2(float lo, float hi) { return f2bf(lo) | (f2bf(hi) << 16); }
__device__ __forceinline__ float bf2f(bf16_t v) { return __builtin_bit_cast(float, (unsigned)v << 16); }
__device__ __forceinline__ float bflo(unsigned w) { return __builtin_bit_cast(float, w << 16); }
__device__ __forceinline__ float bfhi(unsigned w) { return __builtin_bit_cast(float, w & 0xffff0000u); }
__device__ __forceinline__ float sigmoidf_(float x) { return 1.f / (1.f + __expf(-x)); }

template <class Src>
__device__ __forceinline__ void transpose_item(const Src& S, int K, bf16_t* dst, LAS float* scr, int k0, int n0, int lane) {
#pragma unroll 8
    for (int i = 0; i < 32; ++i) { const int kk = 2 * i + (lane >> 5); scr[kk * 33 + (lane & 31)] = S(k0 + kk, n0 + (lane & 31)); }
    asm volatile("s_waitcnt lgkmcnt(0)" ::: "memory");
    const int c = lane & 7;
#pragma unroll
    for (int j = 0; j < 4; ++j) { const int n = (lane >> 3) + 8 * j; const LAS float* s = scr + (8 * c) * 33 + n;
        u32x4 o; o.x = pk2(s[0 * 33], s[1 * 33]); o.y = pk2(s[2 * 33], s[3 * 33]); o.z = pk2(s[4 * 33], s[5 * 33]); o.w = pk2(s[6 * 33], s[7 * 33]);
        *(u32x4*)(dst + (size_t)(n0 + n) * K + k0 + 8 * c) = o; }
    asm volatile("s_waitcnt lgkmcnt(0)" ::: "memory");
}
struct SrcWin { const float* w; __device__ __forceinline__ float operator()(int k, int n) const {
    int c; if (n < 3840) c = n; else if (n < 5888) c = n + 72; else if (n < 5960) c = n - 5888 + 3840; else return 0.f;
    return w[(size_t)k * 5960 + c]; } };
struct SrcPlain { const float* w; int N; __device__ __forceinline__ float operator()(int k, int n) const { return w[(size_t)k * N + n]; } };
struct SrcGU { const float* g; long ud; __device__ __forceinline__ float operator()(int k, int n) const {
    const int pn = n >> 8, c = n & 255, bj = c >> 7, wc = (c & 127) >> 5, fq = (c & 31) >> 3, nn = (c & 7) >> 2, i = c & 3;
    const int hj = 128 * pn + 64 * bj + 16 * wc + 4 * fq + i; return g[(long)k * 512 + hj + (nn ? ud : 0l)]; } };

__device__ __forceinline__ void phase_prologue(const Params& p, LAS unsigned char* lds) {
    const int tid = mk_tid(), lane = tid & 63, wave = tid >> 6;
    const int gw = blockIdx.x * NWAVES + wave, NGW = gridDim.x * NWAVES;
    LAS float* scr = (LAS float*)(lds + wave * 16384);
    char* ws = p.ws;
    if (blockIdx.x == 0 && tid < 64) ((unsigned*)(ws + WS_CTL))[tid] = 0u;
    constexpr int I_IN = 16 * 192, I_A = 8 * 32, I_B = 8 * 32, I_O = 16 * 32, I_GU = 32 * 16 * 32, I_DN = 32 * 8 * 32;
    constexpr int NITEMS = I_IN + I_A + I_B + I_O + I_GU + I_DN;
    for (int it = gw; it < NITEMS; it += NGW) {
        int r = it;
        if (r < I_IN) { SrcWin S{p.in[1]}; transpose_item(S, 1024, (bf16_t*)(ws + WS_WTIN), scr, (r / 192) * 64, (r % 192) * 32, lane); continue; } r -= I_IN;
        if (r < I_A) { SrcPlain S{p.in[13], 1024}; transpose_item(S, 512, (bf16_t*)(ws + WS_WTA), scr, (r / 32) * 64, (r % 32) * 32, lane); continue; } r -= I_A;
        if (r < I_B) { SrcPlain S{p.in[17], 1024}; transpose_item(S, 512, (bf16_t*)(ws + WS_WTB), scr, (r / 32) * 64, (r % 32) * 32, lane); continue; } r -= I_B;
        if (r < I_O) { SrcPlain S{p.in[18], 1024}; transpose_item(S, 1024, (bf16_t*)(ws + WS_WTOUT), scr, (r / 32) * 64, (r % 32) * 32, lane); continue; } r -= I_O;
        if (r < I_GU) { const int e = r / 512, q = r % 512; SrcGU S{p.in[25] + (size_t)e * 1024 * 512, (long)(p.in[26] - p.in[25])};
            transpose_item(S, 1024, (bf16_t*)(ws + WS_WTGU) + (size_t)e * 1024 * 1024, scr, (q / 32) * 64, (q % 32) * 32, lane); continue; } r -= I_GU;
        { const int e = r / 256, q = r % 256; SrcPlain S{p.in[27] + (size_t)e * 512 * 1024, 1024};
            transpose_item(S, 512, (bf16_t*)(ws + WS_WTDN) + (size_t)e * 1024 * 512, scr, (q / 32) * 64, (q % 32) * 32, lane); }
    }
    { bf16_t* wl = (bf16_t*)(ws + WS_WTLORA); const int gt = blockIdx.x * NTHREADS + tid, NGT = gridDim.x * NTHREADS;
      for (int i = gt; i < 1536 * 256; i += NGT) { const int n = i >> 8, k = i & 255; float v = 0.f;
          if (n < 512) { if (k < 64) v = p.in[4][k * 512 + n]; }
          else if (n < 1024) { if (k >= 64 && k < 128) v = p.in[6][(k - 64) * 512 + (n - 512)]; }
          else { if (k >= 128) v = p.in[7][(k - 128) * 512 + (n - 1024)]; }
          wl[i] = (bf16_t)f2bf(v); } }
    { const f32x4* x4 = (const f32x4*)p.in[0]; unsigned long long* o8 = (unsigned long long*)((char*)p.out + DO_XBF);
      const size_t gt = (size_t)blockIdx.x * NTHREADS + tid, NGT = (size_t)gridDim.x * NTHREADS;
      for (size_t i = gt; i < (size_t)T * DM / 4; i += NGT) { const f32x4 v = x4[i]; o8[i] = (unsigned long long)pk2(v.x, v.y) | ((unsigned long long)pk2(v.z, v.w) << 32); } }
}

struct EpiIn {
    static constexpr bool PERM = true, AFTER_DRAIN = false;
    char* ws;
    __device__ __forceinline__ void operator()(const f32x4 (&acc)[2][2][4][2], const Unit& u, int wr, int wc, int fr, int fq) const {
        const int pn = u.pn, row0 = u.pm * 256 + wr * 64 + fr, cl = wc * 32 + 8 * fq;
        if (pn == 23) {
            if (cl < 72) { float* dst = (float*)(ws + WS_MISC);
#pragma unroll
                for (int ai = 0; ai < 2; ++ai)
#pragma unroll
                    for (int m = 0; m < 4; ++m) { float* d = dst + (size_t)(row0 + ai * 128 + m * 16) * 80 + cl; *(f32x4*)d = acc[ai][0][m][0]; *(f32x4*)(d + 4) = acc[ai][0][m][1]; } }
            return;
        }
        bf16_t* base; int ld, colt, mode = 0;
        if (pn < 7) { base = (bf16_t*)(ws + WS_RW); ld = 1792; colt = pn * 256; }
        else if (pn < 9) { base = (bf16_t*)(ws + WS_Q); ld = 512; colt = (pn - 7) * 256; mode = 2; }
        else if (pn < 11) { base = (bf16_t*)(ws + WS_K); ld = 512; colt = (pn - 9) * 256; }
        else if (pn < 13) { base = (bf16_t*)(ws + WS_V); ld = 512; colt = (pn - 11) * 256; }
        else if (pn < 15) { base = (bf16_t*)(ws + WS_QI); ld = 512; colt = (pn - 13) * 256; }
        else if (pn < 19) { base = (bf16_t*)(ws + WS_SGA); ld = 1024; colt = (pn - 15) * 256; mode = 1; }
        else { base = (bf16_t*)(ws + WS_SGB); ld = 1024; colt = (pn - 19) * 256; mode = 1; }
#pragma unroll
        for (int ai = 0; ai < 2; ++ai)
#pragma unroll
            for (int m = 0; m < 4; ++m) { bf16_t* rowp = base + (size_t)(row0 + ai * 128 + m * 16) * ld + colt + cl;
#pragma unroll
                for (int bj = 0; bj < 2; ++bj) { f32x4 v0 = acc[ai][bj][m][0], v1 = acc[ai][bj][m][1];
                    if (mode == 1) {
#pragma unroll
                        for (int i = 0; i < 4; ++i) { v0[i] = sigmoidf_(v0[i]); v1[i] = sigmoidf_(v1[i]); } }
                    else if (mode == 2) { v0 = v0 * attn_body::C2; v1 = v1 * attn_body::C2; }
                    u32x4 w; w.x = pk2(v0[0], v0[1]); w.y = pk2(v0[2], v0[3]); w.z = pk2(v1[0], v1[1]); w.w = pk2(v1[2], v1[3]);
                    *(u32x4*)(rowp + bj * 128) = w; } }
    }
};
struct EpiLora {
    static constexpr bool PERM = true, AFTER_DRAIN = false;
    char* dout;
    __device__ __forceinline__ void operator()(const f32x4 (&acc)[2][2][4][2], const Unit& u, int wr, int wc, int fr, int fq) const {
        const int pn = u.pn, seg = pn >> 1, row0 = u.pm * 256 + wr * 64 + fr, col0 = (pn & 1) * 256 + wc * 32 + 8 * fq;
        bf16_t* base = (bf16_t*)(dout + (size_t)seg * (64 * MiB));
#pragma unroll
        for (int ai = 0; ai < 2; ++ai)
#pragma unroll
            for (int m = 0; m < 4; ++m)
#pragma unroll
                for (int bj = 0; bj < 2; ++bj) { const f32x4 v0 = acc[ai][bj][m][0], v1 = acc[ai][bj][m][1]; u32x4 w;
                    w.x = pk2(v0[0], v0[1]); w.y = pk2(v0[2], v0[3]); w.z = pk2(v1[0], v1[1]); w.w = pk2(v1[2], v1[3]);
                    *(u32x4*)(base + (size_t)(row0 + ai * 128 + m * 16) * 512 + col0 + bj * 128) = w; }
    }
};
struct EpiGateMul {
    static constexpr bool PERM = true, AFTER_DRAIN = false;
    const bf16_t* gate; bf16_t* dst; int add;
    __device__ __forceinline__ void operator()(const f32x4 (&acc)[2][2][4][2], const Unit& u, int wr, int wc, int fr, int fq) const {
        const int row0 = u.pm * 256 + wr * 64 + fr, col0 = u.pn * 256 + wc * 32 + 8 * fq;
#pragma unroll
        for (int ai = 0; ai < 2; ++ai)
#pragma unroll
            for (int m = 0; m < 4; ++m)
#pragma unroll
                for (int bj = 0; bj < 2; ++bj) { const size_t off = (size_t)(row0 + ai * 128 + m * 16) * 1024 + col0 + bj * 128;
                    const u32x4 g = *(const u32x4*)(gate + off); u32x4 d = {0u, 0u, 0u, 0u}; if (add) d = *(const u32x4*)(dst + off);
                    const f32x4 v0 = acc[ai][bj][m][0], v1 = acc[ai][bj][m][1]; u32x4 w;
                    w.x = pk2(bflo(d.x) + bflo(g.x) * v0[0], bfhi(d.x) + bfhi(g.x) * v0[1]); w.y = pk2(bflo(d.y) + bflo(g.y) * v0[2], bfhi(d.y) + bfhi(g.y) * v0[3]);
                    w.z = pk2(bflo(d.z) + bflo(g.z) * v1[0], bfhi(d.z) + bfhi(g.z) * v1[1]); w.w = pk2(bflo(d.w) + bflo(g.w) * v1[2], bfhi(d.w) + bfhi(g.w) * v1[3]);
                    *(u32x4*)(dst + off) = w; }
    }
};
struct EpiResid {
    static constexpr bool PERM = true, AFTER_DRAIN = false;
    const float* x; float* out; float alpha;
    __device__ __forceinline__ void operator()(const f32x4 (&acc)[2][2][4][2], const Unit& u, int wr, int wc, int fr, int fq) const {
        const int row0 = u.pm * 256 + wr * 64 + fr, col0 = u.pn * 256 + wc * 32 + 8 * fq;
#pragma unroll
        for (int ai = 0; ai < 2; ++ai)
#pragma unroll
            for (int m = 0; m < 4; ++m)
#pragma unroll
                for (int bj = 0; bj < 2; ++bj) { const size_t off = (size_t)(row0 + ai * 128 + m * 16) * 1024 + col0 + bj * 128;
                    const f32x4 x0 = *(const f32x4*)(x + off), x1 = *(const f32x4*)(x + off + 4);
                    *(f32x4*)(out + off) = x0 * alpha + acc[ai][bj][m][0]; *(f32x4*)(out + off + 4) = x1 * alpha + acc[ai][bj][m][1]; }
    }
};
struct EpiSwiglu {
    static constexpr bool PERM = true, AFTER_DRAIN = false;
    bf16_t* act;
    __device__ __forceinline__ void operator()(const f32x4 (&acc)[2][2][4][2], const Unit& u, int wr, int wc, int fr, int fq) const {
        const int row0 = u.pm * 256 + wr * 64 + fr, col0 = (u.pn & 3) * 128 + 16 * wc + 4 * fq;
#pragma unroll
        for (int ai = 0; ai < 2; ++ai)
#pragma unroll
            for (int m = 0; m < 4; ++m)
#pragma unroll
                for (int bj = 0; bj < 2; ++bj) { const f32x4 g = acc[ai][bj][m][0], up = acc[ai][bj][m][1]; float a[4];
#pragma unroll
                    for (int i = 0; i < 4; ++i) a[i] = g[i] * sigmoidf_(g[i]) * up[i];
                    *(unsigned long long*)(act + (size_t)(row0 + ai * 128 + m * 16) * 512 + col0 + bj * 64) = (unsigned long long)pk2(a[0], a[1]) | ((unsigned long long)pk2(a[2], a[3]) << 32); }
    }
};
struct EpiDown {
    static constexpr bool PERM = true, AFTER_DRAIN = false;
    bf16_t* ys;
    __device__ __forceinline__ void operator()(const f32x4 (&acc)[2][2][4][2], const Unit& u, int wr, int wc, int fr, int fq) const {
        const int row0 = u.pm * 256 + wr * 64 + fr, col0 = (u.pn & 3) * 256 + wc * 32 + 8 * fq;
#pragma unroll
        for (int ai = 0; ai < 2; ++ai)
#pragma unroll
            for (int m = 0; m < 4; ++m)
#pragma unroll
                for (int bj = 0; bj < 2; ++bj) { const f32x4 v0 = acc[ai][bj][m][0], v1 = acc[ai][bj][m][1]; u32x4 w;
                    w.x = pk2(v0[0], v0[1]); w.y = pk2(v0[2], v0[3]); w.z = pk2(v1[0], v1[1]); w.w = pk2(v1[2], v1[3]);
                    *(u32x4*)(ys + (size_t)(row0 + ai * 128 + m * 16) * 1024 + col0 + bj * 128) = w; }
    }
};
struct MoeOrder {
    const LAS int* tab;
    int G, c;
    __device__ __forceinline__ bool next(int i, Unit& u) const {
        const int L = i * G + c; const int nt = tab[0]; if (L >= nt * 4) return false;
        const int ti = L >> 2; u.pm = ti; u.pn = tab[1 + ti] * 4 + (L & 3); return true; }
    __device__ __forceinline__ void a_ready(const Unit&) const {}
    __device__ __forceinline__ void done(const Unit&) const {}
};
__device__ __forceinline__ void moe_tables(const Params& p, LAS int* tab) {
    const int tid = mk_tid(); const unsigned* cnt = (const unsigned*)(p.ws + WS_CTL);
    __syncthreads();
    if (tid == 0) { int ts = 0; for (int e = 0; e < 32; ++e) { const int c = (int)cnt[e]; tab[1024 + e] = ts * 256; const int nt = (c + 255) >> 8; for (int j = 0; j < nt; ++j) tab[1 + ts + j] = e; ts += nt; } tab[0] = ts; tab[1024 + 32] = ts * 256; }
    __syncthreads();
}

__device__ __forceinline__ void phase_prep(const Params& p) {
    const int tid = mk_tid(), lane = tid & 63, wave = tid >> 6;
    const int gw = blockIdx.x * NWAVES + wave, NGW = gridDim.x * NWAVES;
    const bf16_t* RW = (const bf16_t*)(p.ws + WS_RW); const float* MISC = (const float*)(p.ws + WS_MISC);
    bf16_t* AP = (bf16_t*)(p.ws + WS_AP); bf16_t* KN = (bf16_t*)(p.ws + WS_KN);
    const float* mu = p.in[2];
    const float mu_wd = mu[512 + lane], mu_ad = mu[1600 + lane], mu_g0 = mu[1664 + lane], mu_g1 = mu[1728 + lane];
    const float lg = p.in[14][lane], lb = p.in[15][lane];
    for (int tok = gw; tok < T; tok += NGW) {
        const bf16_t* cur = RW + (size_t)tok * 1792; const bool hp = (tok & (SEQ - 1)) != 0; const bf16_t* prv = cur - 1792;
        float wd = bf2f(cur[512 + lane]), ad = bf2f(cur[1600 + lane]), g0 = bf2f(cur[1664 + lane]), g1 = bf2f(cur[1728 + lane]);
        const float wdp = hp ? bf2f(prv[512 + lane]) : 0.f, adp = hp ? bf2f(prv[1600 + lane]) : 0.f, g0p = hp ? bf2f(prv[1664 + lane]) : 0.f, g1p = hp ? bf2f(prv[1728 + lane]) : 0.f;
        wd += (wdp - wd) * mu_wd; ad += (adp - ad) * mu_ad; g0 += (g0p - g0) * mu_g0; g1 += (g1p - g1) * mu_g1;
        bf16_t* ap = AP + (size_t)tok * 256;
        ap[lane] = (bf16_t)f2bf(tanhf(wd)); ap[64 + lane] = (bf16_t)f2bf(ad); ap[128 + lane] = (bf16_t)f2bf(sigmoidf_(g0)); ap[192 + lane] = (bf16_t)f2bf(sigmoidf_(g1));
        const float kx = MISC[(size_t)tok * 80 + lane]; const float mean = wave_sum(kx) * (1.f / 64.f); const float d = kx - mean;
        const float var = wave_sum(d * d) * (1.f / 64.f);
        KN[(size_t)tok * 64 + lane] = (bf16_t)f2bf(d * rsqrtf(var + 1e-5f) * lg + lb);
    }
}

typedef _Float16 h8 __attribute__((ext_vector_type(8)));
__device__ __forceinline__ float dpp_sum8(float x) {
    x += __builtin_bit_cast(float, __builtin_amdgcn_mov_dpp(__builtin_bit_cast(int, x), 0xB1, 0xF, 0xF, true));
    x += __builtin_bit_cast(float, __builtin_amdgcn_mov_dpp(__builtin_bit_cast(int, x), 0x4E, 0xF, 0xF, true));
    x += __builtin_bit_cast(float, __builtin_amdgcn_mov_dpp(__builtin_bit_cast(int, x), 0x141, 0xF, 0xF, true));
    return x;
}
__device__ __forceinline__ float dpp_sum16(float x) {
    x += __builtin_bit_cast(float, __builtin_amdgcn_mov_dpp(__builtin_bit_cast(int, x), 0xB1, 0xF, 0xF, true));
    x += __builtin_bit_cast(float, __builtin_amdgcn_mov_dpp(__builtin_bit_cast(int, x), 0x4E, 0xF, 0xF, true));
    x += __builtin_bit_cast(float, __builtin_amdgcn_mov_dpp(__builtin_bit_cast(int, x), 0x141, 0xF, 0xF, true));
    x += __builtin_bit_cast(float, __builtin_amdgcn_mov_dpp(__builtin_bit_cast(int, x), 0x140, 0xF, 0xF, true));
    return x;
}
constexpr int SC = 32;
typedef _Float16 h4 __attribute__((ext_vector_type(4)));
typedef unsigned u32x2 __attribute__((ext_vector_type(2)));
struct ScanRaw { u32x2 r, k, v, rp, kp, vp, w, a, g; };
__device__ __forceinline__ void scan_item(const Params& p, LAS unsigned char* lds, int bh) {
    const int b = bh >> 3, h = bh & 7;
    const int tid = mk_tid(), lane = tid & 63, wave = tid >> 6;
    LAS _Float16* vec = (LAS _Float16*)lds;
    LAS float* vbuf = (LAS float*)(lds + SC * 640);
    LAS float* ybuf = (LAS float*)(lds + SC * 640 + SC * 256);
    const bf16_t* RW = (const bf16_t*)(p.ws + WS_RW);
    const bf16_t* OMW = (const bf16_t*)((char*)p.out + DO_OMW); const bf16_t* ASIG = (const bf16_t*)((char*)p.out + DO_ASIG); const bf16_t* GG = (const bf16_t*)((char*)p.out + DO_G);
    bf16_t* YA = (bf16_t*)((char*)p.out + DO_YA);
    const int tokl = lane >> 4, cg = lane & 15, tkA = wave * 4 + tokl, col = h * 64 + 4 * cg;
    f32x4 mu_r = *(const f32x4*)(p.in[2] + col), mu_k = *(const f32x4*)(p.in[2] + 576 + col), mu_v = *(const f32x4*)(p.in[2] + 1088 + col);
    f32x4 w0c = *(const f32x4*)(p.in[3] + col), a0c = *(const f32x4*)(p.in[5] + col), kkc = *(const f32x4*)(p.in[8] + col), kac = *(const f32x4*)(p.in[9] + col);
    f32x4 rkc = *(const f32x4*)(p.in[10] + col), lxg = *(const f32x4*)(p.in[11] + col), lxb = *(const f32x4*)(p.in[12] + col);
    const int rl = lane >> 3, jg = lane & 7, irow = wave * 8 + rl;
    float st[8];
#pragma unroll
    for (int j = 0; j < 8; ++j) st[j] = 0.f;
    f32x4 sv = {0.f, 0.f, 0.f, 0.f}, sg = sv; float sbn = 0.f;
    const size_t row0 = (size_t)b * SEQ;
    ScanRaw R;
#define SCAN_LOAD(c_) do { const int t_ = (c_) * SC + tkA; const size_t rw_ = row0 + t_; const bf16_t* cur_ = RW + rw_ * 1792 + col; const bf16_t* prv_ = cur_ - 1792; \
        R.r = *(const u32x2*)cur_; R.k = *(const u32x2*)(cur_ + 576); R.v = *(const u32x2*)(cur_ + 1088); \
        if (t_ > 0) { R.rp = *(const u32x2*)prv_; R.kp = *(const u32x2*)(prv_ + 576); R.vp = *(const u32x2*)(prv_ + 1088); } else { R.rp = (u32x2){0u, 0u}; R.kp = R.rp; R.vp = R.rp; } \
        R.w = *(const u32x2*)(OMW + rw_ * 512 + col); R.a = *(const u32x2*)(ASIG + rw_ * 512 + col); R.g = *(const u32x2*)(GG + rw_ * 512 + col); } while (0)
#define UNPK(u_) (f32x4){bflo((u_).x), bfhi((u_).x), bflo((u_).y), bfhi((u_).y)}
    SCAN_LOAD(0);
    for (int c = 0; c <= SEQ / SC; ++c) {
        if (c > 0) {
            const f32x4 y = *(const LAS f32x4*)(ybuf + tkA * 64 + 4 * cg);
            const float mean = dpp_sum16((y.x + y.y) + (y.z + y.w)) * (1.f / 64.f); const f32x4 d = y - mean;
            const float var = dpp_sum16((d.x * d.x + d.y * d.y) + (d.z * d.z + d.w * d.w)) * (1.f / 64.f); const float rs = rsqrtf(var + 64e-5f);
            const f32x4 o = (d * rs * lxg + lxb + sv * sbn) * sg;
            *(u32x2*)(YA + (row0 + (size_t)(c - 1) * SC + tkA) * 512 + col) = (u32x2){pk2(o.x, o.y), pk2(o.z, o.w)};
        }
        if (c < SEQ / SC) {
            f32x4 r = UNPK(R.r), k = UNPK(R.k), v = UNPK(R.v); const f32x4 rp = UNPK(R.rp), kp = UNPK(R.kp), vp = UNPK(R.vp);
            r += (rp - r) * mu_r; k += (kp - k) * mu_k; v += (vp - v) * mu_v;
            const f32x4 wr = UNPK(R.w) + w0c, ar = UNPK(R.a) + a0c, g = UNPK(R.g);
            f32x4 a, omw;
#pragma unroll
            for (int i = 0; i < 4; ++i) { a[i] = sigmoidf_(ar[i]);
                const float z = -wr[i]; const float sp = z > 20.f ? z : __logf(1.f + __expf(z)); const float e = __expf(-sp - 0.5f);
                omw[i] = e < 0.1f ? e * (1.f - e * (0.5f - e * ((1.f / 6.f) - e * ((1.f / 24.f) - e * (1.f / 120.f))))) : 1.f - __expf(-e); }
            const f32x4 kkr = k * kkc; const float n2 = dpp_sum16((kkr.x * kkr.x + kkr.y * kkr.y) + (kkr.z * kkr.z + kkr.w * kkr.w));
            const f32x4 kk = kkr * (1.f / fmaxf(sqrtf(n2), 1e-12f));
            const f32x4 k2 = k * ((a - 1.f) * kac + 1.f);
            const f32x4 rb = r * k2 * rkc; sbn = dpp_sum16((rb.x + rb.y) + (rb.z + rb.w));
            const f32x4 nk = -kk, kb = kk * a;
            LAS _Float16* vp_ = vec + tkA * 320 + 4 * cg;
            *(LAS h4*)(vp_) = (h4){(_Float16)omw.x, (_Float16)omw.y, (_Float16)omw.z, (_Float16)omw.w};
            *(LAS h4*)(vp_ + 64) = (h4){(_Float16)nk.x, (_Float16)nk.y, (_Float16)nk.z, (_Float16)nk.w};
            *(LAS h4*)(vp_ + 128) = (h4){(_Float16)kb.x, (_Float16)kb.y, (_Float16)kb.z, (_Float16)kb.w};
            *(LAS h4*)(vp_ + 192) = (h4){(_Float16)k2.x, (_Float16)k2.y, (_Float16)k2.z, (_Float16)k2.w};
            *(LAS h4*)(vp_ + 256) = (h4){(_Float16)r.x, (_Float16)r.y, (_Float16)r.z, (_Float16)r.w};
            *(LAS f32x4*)(vbuf + tkA * 64 + 4 * cg) = v;
            sv = v; sg = g;
        }
        __syncthreads();
        if (c < SEQ / SC) {
            if (c + 1 < SEQ / SC) SCAN_LOAD(c + 1);
#pragma unroll 4
            for (int tk = 0; tk < SC; ++tk) {
                const LAS h8* vv = (const LAS h8*)(vec + tk * 320) + jg;
                const h8 vo = vv[0], va = vv[8], vb = vv[16], vk = vv[24], vr = vv[32];
                const float v = vbuf[tk * 64 + irow];
                float sa0 = 0.f, sa1 = 0.f;
#pragma unroll
                for (int j = 0; j < 8; j += 2) { sa0 = __builtin_fmaf(st[j], (float)va[j], sa0); sa1 = __builtin_fmaf(st[j + 1], (float)va[j + 1], sa1); }
                const float sa = dpp_sum8(sa0 + sa1);
                float y0 = 0.f, y1 = 0.f;
#pragma unroll
                for (int j = 0; j < 8; j += 2) {
                    float s = __builtin_fmaf(-(float)vo[j], st[j], st[j]); s = __builtin_fmaf(sa, (float)vb[j], s); s = __builtin_fmaf(v, (float)vk[j], s); st[j] = s; y0 = __builtin_fmaf(s, (float)vr[j], y0);
                    float s1 = __builtin_fmaf(-(float)vo[j + 1], st[j + 1], st[j + 1]); s1 = __builtin_fmaf(sa, (float)vb[j + 1], s1); s1 = __builtin_fmaf(v, (float)vk[j + 1], s1); st[j + 1] = s1; y1 = __builtin_fmaf(s1, (float)vr[j + 1], y1); }
                const float y = dpp_sum8(y0 + y1);
                if (jg == 0) ybuf[tk * 64 + irow] = y;
            }
        }
        __syncthreads();
    }
#undef SCAN_LOAD
#undef UNPK
}

constexpr int IX_HIST = 0, IX_MASK = 65536, IX_CAND = IX_MASK + 8192, IX_MISC = IX_CAND + 16384, IX_CAP = 128;
__device__ __forceinline__ void indexer_unit(const Params& p, LAS unsigned char* lds, int b, int qg) {
    const int tid = mk_tid(), lane = tid & 63, wave = tid >> 6;
    LAS unsigned* hist = (LAS unsigned*)(lds + IX_HIST);
    LAS unsigned* mrow = (LAS unsigned*)(lds + IX_MASK);
    LAS float* candv = (LAS float*)(lds + IX_CAND);
    LAS int* cands = (LAS int*)(lds + IX_CAND + 8192);
    LAS int* ccnt = (LAS int*)(lds + IX_MISC);
    LAS int* thrB = ccnt + 16; LAS int* thrG = ccnt + 32;
    LAS int* segsum = ccnt + 64;
    unsigned* MASK = (unsigned*)(p.ws + WS_MASK);
    const int t0 = qg * 16; const size_t rowb = (size_t)b * SEQ;
    if (qg < 16) {
        for (int i = tid; i < 2048; i += NTHREADS) { const int n = i >> 7, w = i & 127, tq = t0 + n; const int s0 = 32 * w;
            const unsigned m = tq >= s0 + 31 ? 0xffffffffu : (tq < s0 ? 0u : ((2u << (tq - s0)) - 1u));
            MASK[(rowb + t0) * 128 + i] = m; }
        return;
    }
    for (int i = tid; i < 16384 + 2048; i += NTHREADS) hist[i] = 0u;
    if (tid < 16) ccnt[tid] = 0;
    const bf16_t* QI = (const bf16_t*)(p.ws + WS_QI); const bf16_t* KN = (const bf16_t*)(p.ws + WS_KN); const float* MISC = (const float*)(p.ws + WS_MISC);
    const int n = lane & 15, quad = lane >> 4, tq = t0 + n;
    bf16x8 qf[8][2];
#pragma unroll
    for (int h = 0; h < 8; ++h)
#pragma unroll
        for (int ks = 0; ks < 2; ++ks) qf[h][ks] = *(const bf16x8*)(QI + (rowb + tq) * 512 + h * 64 + ks * 32 + quad * 8);
    float wq[8];
#pragma unroll
    for (int h = 0; h < 8; ++h) wq[h] = MISC[(rowb + tq) * 80 + 64 + h] * (0.125f * 0.35355339059327373f);
    __syncthreads();
    int myB = 0;
#pragma unroll 1
    for (int pass = 0; pass < 2; ++pass) {
        bf16x8 c0 = {0, 0, 0, 0, 0, 0, 0, 0}, c1 = c0;
        if (wave <= qg) { const bf16_t* kp = KN + (rowb + wave * 16 + n) * 64 + quad * 8; c0 = *(const bf16x8*)kp; c1 = *(const bf16x8*)(kp + 32); }
#pragma unroll 1
        for (int kb = wave; kb <= qg; kb += NWAVES) {
            const int s0 = kb * 16; const bf16x8 a0 = c0, a1 = c1;
            { const int kn = kb + NWAVES; if (kn <= qg) { const bf16_t* kp = KN + (rowb + kn * 16 + n) * 64 + quad * 8; c0 = *(const bf16x8*)kp; c1 = *(const bf16x8*)(kp + 32); } }
            float idx[4] = {0.f, 0.f, 0.f, 0.f};
#pragma unroll
            for (int h = 0; h < 8; ++h) { f32x4 acc = {0.f, 0.f, 0.f, 0.f};
                acc = __builtin_amdgcn_mfma_f32_16x16x32_bf16(a0, qf[h][0], acc, 0, 0, 0);
                acc = __builtin_amdgcn_mfma_f32_16x16x32_bf16(a1, qf[h][1], acc, 0, 0, 0);
#pragma unroll
                for (int j = 0; j < 4; ++j) idx[j] = __builtin_fmaf(wq[h], fmaxf(acc[j], 0.f), idx[j]); }
#pragma unroll
            for (int j = 0; j < 4; ++j) { const int s = s0 + quad * 4 + j;
                if (s <= tq) { int bin = (int)floorf((idx[j] + 8.f) * 128.f); bin = bin < 0 ? 0 : (bin > 2047 ? 2047 : bin);
                    if (pass == 0) __hip_atomic_fetch_add(&hist[n * 1024 + (bin >> 1)], 1u << (16 * (bin & 1)), __ATOMIC_RELAXED, __HIP_MEMORY_SCOPE_WORKGROUP);
                    else if (bin > myB) __hip_atomic_fetch_or(&mrow[n * 128 + (s >> 5)], 1u << (s & 31), __ATOMIC_RELAXED, __HIP_MEMORY_SCOPE_WORKGROUP);
                    else if (bin == myB) { const int sl = __hip_atomic_fetch_add(&ccnt[n], 1, __ATOMIC_RELAXED, __HIP_MEMORY_SCOPE_WORKGROUP); if (sl < IX_CAP) { candv[n * IX_CAP + sl] = idx[j]; cands[n * IX_CAP + sl] = s; } } } }
        }
        __syncthreads();
        if (pass == 0) {
            const int qn = tid >> 5, seg = tid & 31;
            { int sum = 0; for (int w = 0; w < 32; ++w) { const unsigned v = hist[qn * 1024 + seg * 32 + w]; sum += (int)(v & 0xffffu) + (int)(v >> 16); } segsum[qn * 32 + seg] = sum; }
            __syncthreads();
            { int above = 0; for (int s2 = seg + 1; s2 < 32; ++s2) above += segsum[qn * 32 + s2]; const int mine = segsum[qn * 32 + seg];
              if (above < 256 && above + mine >= 256) { int cum = above;
                  for (int bin = seg * 64 + 63; bin >= seg * 64; --bin) { const unsigned v = hist[qn * 1024 + (bin >> 1)]; const int cnt = (int)((v >> (16 * (bin & 1))) & 0xffffu);
                      if (cum + cnt >= 256) { thrB[qn] = bin; thrG[qn] = cum; break; } cum += cnt; } } }
            __syncthreads();
            myB = thrB[n];
        }
    }
    { const int qn = tid >> 5, sub = tid & 31; const int nc = min(ccnt[qn], IX_CAP), need = 256 - thrG[qn];
      for (int c = sub; c < nc; c += 32) { const float v = candv[qn * IX_CAP + c]; const int s = cands[qn * IX_CAP + c]; int rank = 0;
          for (int c2 = 0; c2 < nc; ++c2) { const float v2 = candv[qn * IX_CAP + c2]; const int s2 = cands[qn * IX_CAP + c2]; rank += (v2 > v || (v2 == v && s2 < s)) ? 1 : 0; }
          if (rank < need) __hip_atomic_fetch_or(&mrow[qn * 128 + (s >> 5)], 1u << (s & 31), __ATOMIC_RELAXED, __HIP_MEMORY_SCOPE_WORKGROUP); } }
    __syncthreads();
    for (int i = tid; i < 2048; i += NTHREADS) MASK[(rowb + t0) * 128 + i] = mrow[i];
    __syncthreads();
}

__device__ __forceinline__ void phase_ln_router(const Params& p, LAS unsigned char* lds, bool dry = false) {
    const int tid = mk_tid(), lane = tid & 63, wave = tid >> 6;
    LAS float* WR = (LAS float*)lds;
    LAS int* lcnt = (LAS int*)(lds + 147456);
    LAS int* lbase = lcnt + 32;
    LAS int* tke = lcnt + 64;
    LAS int* tks = lcnt + 64 + 512;
    for (int i = tid; i < 36 * 1024; i += NTHREADS) { const int o = i >> 10, k = i & 1023; WR[i] = o < 4 ? p.in[21][k * 4 + o] : p.in[23][k * 32 + (o - 4)]; }
    float* H = p.out; bf16_t* H1B = (bf16_t*)(p.ws + WS_H1B);
    int* EID = (int*)(p.ws + WS_EID); float* GATE = (float*)(p.ws + WS_GATE); int* SLOT = (int*)(p.ws + WS_SLOT); unsigned* gcnt = (unsigned*)(p.ws + WS_CTL);
    const float* g1 = p.in[19]; const float* b1 = p.in[20];
    for (int tile = blockIdx.x; tile < T / 256; tile += gridDim.x) {
        if (tid < 32) lcnt[tid] = 0;
        __syncthreads();
        for (int it = 0; it < 32; ++it) {
            const int tl = wave * 32 + it, tok = tile * 256 + tl;
            f32x4* hr = (f32x4*)(H + (size_t)tok * DM) + lane;
            f32x4 v[4]; float s = 0.f;
#pragma unroll
            for (int j = 0; j < 4; ++j) { v[j] = hr[64 * j]; s += (v[j].x + v[j].y) + (v[j].z + v[j].w); }
            const float mean = wave_sum(s) * (1.f / DM); float s2 = 0.f;
#pragma unroll
            for (int j = 0; j < 4; ++j) { v[j] = v[j] - mean; s2 += (v[j].x * v[j].x + v[j].y * v[j].y) + (v[j].z * v[j].z + v[j].w * v[j].w); }
            const float rstd = rsqrtf(wave_sum(s2) * (1.f / DM) + 1e-5f);
#pragma unroll
            for (int j = 0; j < 4; ++j) { const f32x4 g = ((const f32x4*)g1)[lane + 64 * j], bb = ((const f32x4*)b1)[lane + 64 * j]; v[j] = v[j] * rstd * g + bb; if (!dry) hr[64 * j] = v[j];
                if (!dry) ((unsigned long long*)(H1B + (size_t)tok * DM))[lane + 64 * j] = (unsigned long long)pk2(v[j].x, v[j].y) | ((unsigned long long)pk2(v[j].z, v[j].w) << 32); }
            float lg[36];
#pragma unroll
            for (int o = 0; o < 36; ++o) { float a = 0.f;
#pragma unroll
                for (int j = 0; j < 4; ++j) { const f32x4 w = ((const LAS f32x4*)(WR + o * 1024))[lane + 64 * j]; a += (v[j].x * w.x + v[j].y * w.y) + (v[j].z * w.z + v[j].w * w.w); }
                lg[o] = wave_sum(a); }
            float gl[4];
#pragma unroll
            for (int o = 0; o < 4; ++o) gl[o] = lg[o] + p.in[22][o];
            float gm = gl[0]; int gs = 0;
#pragma unroll
            for (int o = 1; o < 4; ++o) if (gl[o] > gm) { gm = gl[o]; gs = o; }
            float gden = 0.f;
#pragma unroll
            for (int o = 0; o < 4; ++o) gden += __expf(gl[o] - gm);
            const float pg = 1.f / gden;
            float el[8];
#pragma unroll
            for (int o = 0; o < 8; ++o) { float x = 0.f;
#pragma unroll
                for (int g = 0; g < 4; ++g) if (g == gs) x = lg[4 + g * 8 + o] + p.in[24][g * 8 + o];
                el[o] = x; }
            float m1 = el[0]; int i1 = 0;
#pragma unroll
            for (int o = 1; o < 8; ++o) if (el[o] > m1) { m1 = el[o]; i1 = o; }
            float m2 = -INFINITY; int i2 = 0;
#pragma unroll
            for (int o = 0; o < 8; ++o) if (o != i1 && el[o] > m2) { m2 = el[o]; i2 = o; }
            const float e2 = __expf(m2 - m1); const float ga = pg / (1.f + e2), gb = pg * e2 / (1.f + e2);
            if (lane == 0 && !dry) { const int ea = gs * 8 + i1, eb = gs * 8 + i2;
                EID[tok * 2] = ea; EID[tok * 2 + 1] = eb; GATE[tok * 2] = ga; GATE[tok * 2 + 1] = gb;
                tke[tl * 2] = ea; tke[tl * 2 + 1] = eb; tks[tl * 2] = __hip_atomic_fetch_add(&lcnt[ea], 1, __ATOMIC_RELAXED, __HIP_MEMORY_SCOPE_WORKGROUP); tks[tl * 2 + 1] = __hip_atomic_fetch_add(&lcnt[eb], 1, __ATOMIC_RELAXED, __HIP_MEMORY_SCOPE_WORKGROUP); }
        }
        __syncthreads();
        if (tid < 32 && !dry) lbase[tid] = (int)__hip_atomic_fetch_add(&gcnt[tid], (unsigned)lcnt[tid], __ATOMIC_RELAXED, __HIP_MEMORY_SCOPE_AGENT);
        __syncthreads();
        if (!dry) SLOT[tile * 512 + tid] = lbase[tke[tid]] + tks[tid];
        __syncthreads();
    }
}

__device__ __forceinline__ void phase_permute(const Params& p, LAS int* tab) {
    const int tid = mk_tid(), lane = tid & 63, wave = tid >> 6;
    const int gw = blockIdx.x * NWAVES + wave, NGW = gridDim.x * NWAVES;
    const int* EID = (const int*)(p.ws + WS_EID); const int* SLOT = (const int*)(p.ws + WS_SLOT);
    const u32x4* H1B = (const u32x4*)(p.ws + WS_H1B); u32x4* XS = (u32x4*)(p.ws + WS_XS);
    for (int i = gw; i < T * 2; i += NGW) { const int tok = i >> 1; const int dst = tab[1024 + EID[i]] + SLOT[i];
        const u32x4 a = H1B[(size_t)tok * 128 + lane], b2 = H1B[(size_t)tok * 128 + 64 + lane];
        XS[(size_t)dst * 128 + lane] = a; XS[(size_t)dst * 128 + 64 + lane] = b2; }
}

__device__ __forceinline__ void phase_final(const Params& p, LAS int* tab, bool dry = false) {
    const int tid = mk_tid(), lane = tid & 63, wave = tid >> 6;
    const int gw = blockIdx.x * NWAVES + wave, NGW = gridDim.x * NWAVES;
    const int* EID = (const int*)(p.ws + WS_EID); const int* SLOT = (const int*)(p.ws + WS_SLOT); const float* GATE = (const float*)(p.ws + WS_GATE);
    const bf16_t* YS = (const bf16_t*)(p.ws + WS_XS); const float alpha = 1.189207115002721f;
    const float* g2 = p.in[28]; const float* b2 = p.in[29];
    for (int tok = gw; tok < T; tok += NGW) {
        const int r0 = tab[1024 + EID[tok * 2]] + SLOT[tok * 2], r1 = tab[1024 + EID[tok * 2 + 1]] + SLOT[tok * 2 + 1]; const float ga = GATE[tok * 2], gb = GATE[tok * 2 + 1];
        f32x4* hr = (f32x4*)(p.out + (size_t)tok * DM) + lane; f32x4 v[4]; float s = 0.f;
#pragma unroll
        for (int j = 0; j < 4; ++j) { const f32x4 hv = hr[64 * j];
            const unsigned long long ya = ((const unsigned long long*)(YS + (size_t)r0 * DM))[lane + 64 * j], yb = ((const unsigned long long*)(YS + (size_t)r1 * DM))[lane + 64 * j];
            const unsigned a0 = (unsigned)ya, a1 = (unsigned)(ya >> 32), c0 = (unsigned)yb, c1 = (unsigned)(yb >> 32);
            v[j].x = alpha * hv.x + ga * bflo(a0) + gb * bflo(c0); v[j].y = alpha * hv.y + ga * bfhi(a0) + gb * bfhi(c0);
            v[j].z = alpha * hv.z + ga * bflo(a1) + gb * bflo(c1); v[j].w = alpha * hv.w + ga * bfhi(a1) + gb * bfhi(c1);
            s += (v[j].x + v[j].y) + (v[j].z + v[j].w); }
        const float mean = wave_sum(s) * (1.f / DM); float s2 = 0.f;
#pragma unroll
        for (int j = 0; j < 4; ++j) { v[j] = v[j] - mean; s2 += (v[j].x * v[j].x + v[j].y * v[j].y) + (v[j].z * v[j].z + v[j].w * v[j].w); }
        const float rstd = rsqrtf(wave_sum(s2) * (1.f / DM) + 1e-5f);
#pragma unroll
        for (int j = 0; j < 4; ++j) { const f32x4 g = ((const f32x4*)g2)[lane + 64 * j], bb = ((const f32x4*)b2)[lane + 64 * j]; const f32x4 o = v[j] * rstd * g + bb; if (!dry) hr[64 * j] = o; }
    }
}

constexpr int NPHASE = 14;
template <int PH> __device__ __forceinline__ void run_phase(const Params& p, unsigned char* lds_g) {
    LAS unsigned char* lds = (LAS unsigned char*)lds_g;
    const int G = gridDim.x, c = blockIdx.x;
    if constexpr (PH == 0) phase_prologue(p, lds);
    if constexpr (PH == 1) { Gemm g{(const bf16_t*)((char*)p.out + DO_XBF), (const bf16_t*)(p.ws + WS_WTIN), T, 6144, 1024}; pg8::StaticOrder S; S.init(T, 6144, G, c);
        EpiIn E{p.ws}; pg8::gemm_phase<EpiIn, pg8::StaticOrder, true, true>(lds, g, S, E); }
    if constexpr (PH == 2) phase_prep(p);
    if constexpr (PH == 3) { Gemm g{(const bf16_t*)(p.ws + WS_AP), (const bf16_t*)(p.ws + WS_WTLORA), T, 1536, 256}; pg8::StaticOrder S; S.init(T, 1536, G, c);
        EpiLora E{(char*)p.out}; pg8::gemm_phase<EpiLora, pg8::StaticOrder, true, true>(lds, g, S, E); }
    if constexpr (PH == 4) {
        for (int bh = c; bh < 128; bh += G) scan_item(p, lds, bh);
        unsigned* qctr = (unsigned*)(p.ws + WS_CTL) + 40; LAS unsigned* qs = (LAS unsigned*)(lds + LDS_TOTAL - 32);
        for (;;) { __syncthreads(); if (mk_tid() == 0) qs[0] = __hip_atomic_fetch_add(qctr, 1u, __ATOMIC_RELAXED, __HIP_MEMORY_SCOPE_AGENT); __syncthreads();
            const unsigned u = qs[0]; if (u >= 4096u) break; indexer_unit(p, lds, (int)(u & 15u), 255 - (int)(u >> 4)); }
    }
    if constexpr (PH == 6) {
        LAS float* bd = (LAS float*)(lds + attn_body::LDS_BIAS);
        for (int i = mk_tid(); i < 8 * 128; i += NTHREADS) { const int h = i >> 7, d = i & 127; int bk = d;
            if (d >= 16) { bk = 16 + (int)(log2f((float)d * 0.0625f) * (16.f / 3.f)); bk = bk > 31 ? 31 : bk; }
            bd[i] = (p.in[16][bk * 8 + h] - p.in[16][31 * 8 + h]) * 1.4426950408889634f; }
        __syncthreads();
        for (int v = c; v < 256; v += G) { const int bh = v >> 1, od = v & 1;
            for (int i = 0; i < 8; ++i) { const int pr = 2 * (i >> 1) + od; const int qb = (i & 1) ? 15 - pr : pr;
                attn_body::attn_unit<8>(bh >> 3, bh & 7, qb, (const attn_body::bf16*)(p.ws + WS_Q), (const attn_body::bf16*)(p.ws + WS_K), (const attn_body::bf16*)(p.ws + WS_V),
                                        (attn_body::bf16*)(p.ws + WS_YB), (const unsigned long long*)(p.ws + WS_MASK), (char*)lds_g); } }
    }
    if constexpr (PH == 7) { Gemm g{(const bf16_t*)((char*)p.out + DO_YA), (const bf16_t*)(p.ws + WS_WTA), T, 1024, 512}; pg8::StaticOrder S; S.init(T, 1024, G, c);
        EpiGateMul E{(const bf16_t*)(p.ws + WS_SGA), (bf16_t*)(p.ws + WS_SGA), 0}; pg8::gemm_phase<EpiGateMul, pg8::StaticOrder, true, true>(lds, g, S, E); }
    if constexpr (PH == 8) { Gemm g{(const bf16_t*)(p.ws + WS_YB), (const bf16_t*)(p.ws + WS_WTB), T, 1024, 512}; pg8::StaticOrder S; S.init(T, 1024, G, c);
        EpiGateMul E{(const bf16_t*)(p.ws + WS_SGB), (bf16_t*)(p.ws + WS_SGA), 1}; pg8::gemm_phase<EpiGateMul, pg8::StaticOrder, true, true>(lds, g, S, E); }
    if constexpr (PH == 9) { Gemm g{(const bf16_t*)(p.ws + WS_SGA), (const bf16_t*)(p.ws + WS_WTOUT), T, 1024, 1024}; pg8::StaticOrder S; S.init(T, 1024, G, c);
        EpiResid E{p.in[0], p.out, 1.189207115002721f}; pg8::gemm_phase<EpiResid, pg8::StaticOrder, true, true>(lds, g, S, E); }
    if constexpr (PH == 10) phase_ln_router(p, lds);
    if constexpr (PH == 11) { LAS int* tab = (LAS int*)(lds + LDS_TAB); moe_tables(p, tab); phase_permute(p, tab); }
    if constexpr (PH == 12) { LAS int* tab = (LAS int*)(lds + LDS_TAB); moe_tables(p, tab);
        { Gemm g{(const bf16_t*)(p.ws + WS_XS), (const bf16_t*)(p.ws + WS_WTGU), NROWS_PAD, 32 * 1024, 1024}; MoeOrder S{tab, G, c};
          EpiSwiglu E{(bf16_t*)(p.ws + WS_ACT)}; pg8::gemm_phase<EpiSwiglu, MoeOrder, true, true>(lds, g, S, E); } }
    if constexpr (PH == 13) { LAS int* tab = (LAS int*)(lds + LDS_TAB); moe_tables(p, tab);
        { Gemm g{(const bf16_t*)(p.ws + WS_ACT), (const bf16_t*)(p.ws + WS_WTDN), NROWS_PAD, 32 * 1024, 512}; MoeOrder S{tab, G, c};
          EpiDown E{(bf16_t*)(p.ws + WS_XS)}; pg8::gemm_phase<EpiDown, MoeOrder, true, true>(lds, g, S, E); } }
    if constexpr (PH == 14) { LAS int* tab = (LAS int*)(lds + LDS_TAB); moe_tables(p, tab); phase_final(p, tab); }
}

template <int PH> __global__ void __launch_bounds__(NTHREADS, 2) k_phase(Params p) {
    extern __shared__ __attribute__((aligned(16))) unsigned char lds[];
    run_phase<PH>(p, lds);
}
__global__ void __launch_bounds__(NTHREADS, 2) k_all(Params p) {
    extern __shared__ __attribute__((aligned(16))) unsigned char lds[];
    cooperative_groups::grid_group grid = cooperative_groups::this_grid();
    unsigned* barw = (unsigned*)(p.ws + WS_CTL) + 16384;
    volatile LAS unsigned* bst = (volatile LAS unsigned*)((LAS unsigned char*)lds + LDS_TOTAL - 16);
    if (mk_tid() < 2) bst[mk_tid()] = 0u;
    if (blockIdx.x == 0) for (int i = mk_tid(); i < XCD_BAR_WORDS; i += NTHREADS) barw[i] = 0u;
    __syncthreads();
#ifndef MK_REP
#define MK_REP -1
#endif
#define MK_DRY() (((volatile unsigned*)(p.ws + WS_CTL))[62] == 0u)
#define MK_PH(n) do { run_phase<n>(p, lds); xcd_barrier(bar); if (MK_REP == (n)) { run_phase<n>(p, lds); xcd_barrier(bar); } } while (0)
    run_phase<0>(p, lds); grid.sync();
    const XcdBarrier bar = xcd_barrier_post(barw, bst);
    MK_PH(1); MK_PH(2); MK_PH(3); MK_PH(4); MK_PH(6);
    run_phase<7>(p, lds);
    MK_PH(8); MK_PH(9); MK_PH(10); MK_PH(11); MK_PH(12); MK_PH(13);
    if (MK_REP == 200) { for (int i = 0; i < 20; ++i) xcd_barrier(bar); }
    run_phase<14>(p, lds);
}
}

extern "C" void kernel_launch(void* const* d_in, const int* in_sizes, int n_in, void* d_out, int out_size,
                              void* d_ws, size_t ws_size, hipStream_t stream) {
    mk::Params p{};
    for (int i = 0; i < 30; ++i) p.in[i] = (const float*)d_in[i];
    p.out = (float*)d_out; p.ws = (char*)d_ws;
    if (ws_size < mk::WS_END) { fprintf(stderr, "workspace too small: %zu\n", ws_size); return; }
    static int grid_blocks = 0;
    if (!grid_blocks) {
        int dev = 0, cus = 0, per_cu = 0;
        (void)hipGetDevice(&dev);
        (void)hipDeviceGetAttribute(&cus, hipDeviceAttributeMultiprocessorCount, dev);
        (void)hipFuncSetAttribute((const void*)mk::k_all, hipFuncAttributeMaxDynamicSharedMemorySize, mk::LDS_TOTAL);
        (void)hipOccupancyMaxActiveBlocksPerMultiprocessor(&per_cu, mk::k_all, mk::NTHREADS, mk::LDS_TOTAL);
        grid_blocks = cus * (per_cu > 1 ? 1 : per_cu);
    }
    void* args[] = {&p};
    hipError_t e = hipLaunchCooperativeKernel((void*)mk::k_all, dim3(grid_blocks), dim3(mk::NTHREADS), args, mk::LDS_TOTAL, stream);
    if (e != hipSuccess) fprintf(stderr, "cooperative launch failed: %s (grid %d)\n", hipGetErrorString(e), grid_blocks);
}
```

```cpp
#include <hip/hip_runtime.h>
#include <hip/hip_bf16.h>
#include <hip/hip_cooperative_groups.h>
#include <cstdio>
#include <cstdint>
#include <cmath>
__device__ __forceinline__ int mk_tid() { int t = threadIdx.x; asm volatile("" : "+v"(t)); return t; }
#define LAS __attribute__((address_space(3)))
#define XB_TMO      128
#define XB_XCNT(j)  (256  + 64 * (j))
#define XB_XSUB(j)  (1280 + 64 * (j))
#define XB_XGEN(j)  (2304 + 64 * (j))
#define XB_TOP      3328
#define XB_TOPGEN   3392
#define XCD_BAR_WORDS 3456
#define XB_SPIN_CAP (1u << 18)

__device__ __forceinline__ unsigned xb_ld(unsigned* p)              { return __hip_atomic_load(p, __ATOMIC_RELAXED, __HIP_MEMORY_SCOPE_AGENT); }
__device__ __forceinline__ unsigned xb_add(unsigned* p, unsigned v) { return __hip_atomic_fetch_add(p, v, __ATOMIC_RELAXED, __HIP_MEMORY_SCOPE_AGENT); }
__device__ __forceinline__ unsigned xb_xcc_id() { return (unsigned)__builtin_amdgcn_s_getreg((3 << 11) | 20) & 0xFu; }
#define XB_SPIN(cond, bar) do { unsigned _sp = 0; while (cond) { __builtin_amdgcn_s_sleep(1); \
    if ((++_sp & 255u) == 0u) { if (xb_ld(&(bar)[XB_TMO])) break; if (_sp > XB_SPIN_CAP) { atomicAdd(&(bar)[XB_TMO], 1u); break; } } } } while (0)

struct XcdBarrier {
    unsigned* bar; unsigned x;
    volatile LAS unsigned* st;
};

__device__ __forceinline__ XcdBarrier xcd_barrier_post(unsigned* bar, volatile LAS unsigned* st) {
    XcdBarrier b; b.bar = bar; b.x = xb_xcc_id(); b.st = st;
    if (mk_tid() == 0) (void)xb_add(&bar[XB_XCNT(b.x)], 1u);
    return b;
}
__device__ __forceinline__ void xcd_barrier_complete(unsigned* bar, unsigned x, unsigned& nloc, unsigned& nx) {
    const unsigned G = gridDim.x * gridDim.y * gridDim.z;
    unsigned sum, cnt, mine, sp = 0u;
    for (;;) {
        sum = 0u; cnt = 0u; mine = 0u;
#pragma unroll
        for (unsigned j = 0; j < 16; ++j) { const unsigned c = xb_ld(&bar[XB_XCNT(j)]); sum += c; cnt += (c > 0u) ? 1u : 0u; mine = (j == x) ? c : mine; }
        if (sum == G) break;
        __builtin_amdgcn_s_sleep(1);
        if ((++sp & 255u) == 0u) { if (xb_ld(&bar[XB_TMO])) break; if (sp > XB_SPIN_CAP) { atomicAdd(&bar[XB_TMO], 1u); break; } }
    }
    nloc = mine > 0u ? mine : 1u; nx = cnt > 0u ? cnt : 1u;
}

__device__ __forceinline__ void xcd_barrier(const XcdBarrier& b) {
    asm volatile("s_waitcnt vmcnt(0)" ::: "memory");
    __syncthreads();
    if (mk_tid() == 0) {
        unsigned* bar = b.bar;
        __builtin_amdgcn_s_waitcnt(0);
        unsigned nloc = b.st[0], nx = b.st[1];
        if (nloc == 0u) { xcd_barrier_complete(bar, b.x, nloc, nx); b.st[0] = nloc; b.st[1] = nx; }
        const unsigned old = xb_add(&bar[XB_XSUB(b.x)], 1u);
        const unsigned gen = old / nloc;
        if (old + 1u == (gen + 1u) * nloc) {
            __builtin_amdgcn_fence(__ATOMIC_RELEASE, "agent");
            asm volatile("s_waitcnt vmcnt(0)" ::: "memory");
            const unsigned og = xb_add(&bar[XB_TOP], 1u);
            const unsigned tg = og / nx;
            if (og + 1u == (tg + 1u) * nx) xb_add(&bar[XB_TOPGEN], 1u);
            else XB_SPIN(xb_ld(&bar[XB_TOPGEN]) == tg, bar);
            __builtin_amdgcn_fence(__ATOMIC_ACQUIRE, "agent");
            xb_add(&bar[XB_XGEN(b.x)], 1u);
            asm volatile("s_waitcnt vmcnt(0)" ::: "memory");
        } else {
            XB_SPIN(xb_ld(&bar[XB_XGEN(b.x)]) == gen, bar);
            __builtin_amdgcn_fence(__ATOMIC_ACQUIRE, "agent");
            asm volatile("s_waitcnt vmcnt(0)" ::: "memory");
        }
    }
    __syncthreads();
}

namespace pg8 {
#define PG8_LAS __attribute__((address_space(3)))
typedef unsigned short bf16_t;
typedef short bf16x8 __attribute__((ext_vector_type(8)));
typedef float f32x4 __attribute__((ext_vector_type(4)));
typedef unsigned u32x4 __attribute__((ext_vector_type(4)));
constexpr int BM = 256, BK = 64, HALF = 128, HTB = HALF * BK * 2  , STAGE_BYTES = 8 * HTB, NXCD = 8, WGM = 8;

__host__ __device__ __forceinline__ int lds_byte(int r, int c) { const int st = (r >> 4) * 2 + (c >> 5), rr = r & 15, cc = c & 31, ob = rr * 64 + cc * 2; return st * 1024 + (ob ^ (((ob >> 9) & 1) << 5)); }
__host__ __device__ __forceinline__ void stage_rc(int b, int& R, int& C) { const int st = b / 1024, sb = b % 1024, swz = sb ^ (((sb >> 9) & 1) << 5); R = (st >> 1) * 16 + swz / 64; C = (st & 1) * 32 + (swz % 64) / 2; }
__host__ __device__ __forceinline__ int perm32(int rho) { const int n = rho >> 4, i = rho & 15; return 8 * (i >> 2) + 4 * n + (i & 3); }

struct Unit { int pm, pn; };
struct Gemm { const bf16_t* A; const bf16_t* Bt; int M, N, K; };

struct StaticOrder {
    int nM, nN, nwg, G, c;
    __host__ __device__ void init(int M, int N, int G_, int c_) { nM = M / BM; nN = N / BM; nwg = nM * nN; G = G_; c = c_; }
    __host__ __device__ bool next(int i, Unit& u) const {
        const long L = (long)i * G + c; if (L >= nwg) return false;
        int wgid = (int)L; { const int q = nwg / NXCD, r = nwg % NXCD, xcd = wgid % NXCD, off = wgid / NXCD; wgid = (xcd < r ? xcd * (q + 1) : r * (q + 1) + (xcd - r) * q) + off; }
        const int nig = WGM * nN, gid = wgid / nig, fm = gid * WGM, gsz = (nM - fm) < WGM ? (nM - fm) : WGM;
        u.pm = fm + ((wgid % nig) % gsz); u.pn = (wgid % nig) / gsz; return true;
    }
    __device__ __forceinline__ void a_ready(const Unit&) const {}
    __device__ __forceinline__ void done(const Unit&) const {}
};

__device__ __forceinline__ unsigned cvt_pk_bf16(float lo, float hi) { unsigned r; asm volatile("v_cvt_pk_bf16_f32 %0, %1, %2" : "=v"(r) : "v"(lo), "v"(hi)); return r; }

template <class Epi, class Sched, bool ALIGN_EPI = false, bool SP2 = false>
__device__ __forceinline__ void gemm_phase(PG8_LAS unsigned char* lds, const Gemm g, const Sched& S, const Epi& E) {
    const int tid = mk_tid(), wid = __builtin_amdgcn_readfirstlane(tid >> 6), lane = tid & 63, wr = wid >> 2, wc = wid & 3, fr = lane & 15, fq = lane >> 4;
    const int K = g.K, nt = K / BK;
    unsigned voffA[2], voffB[2];
#pragma unroll
    for (int i = 0; i < 2; ++i) { int R, C; stage_rc(tid * 16 + i * 8192, R, C); const int Rb = Epi::PERM ? ((R & ~31) + perm32(R & 31)) : R;
        voffA[i] = (unsigned)(R * K + C) * 2u; voffB[i] = (unsigned)(Rb * K + C) * 2u; }
    const size_t kstep = (size_t)(BK * 2);
    const size_t hstep = (size_t)HALF * K * 2;
    const size_t tstep = 2 * hstep;
    const unsigned ldsw = (unsigned)wid * 1024u;
    const int aoff = lds_byte(wr * 64 + fr, fq * 8), boff = lds_byte(wc * 32 + fr, fq * 8);
#define PG8_SA(b, h) (((b) * 2 + (h)) * HTB)
#define PG8_SB(b, h) ((4 + (b) * 2 + (h)) * HTB)
#define PG8_STAGE(bufoff, gbase, voff) do { _Pragma("unroll") for (int _i = 0; _i < 2; ++_i) \
        __builtin_amdgcn_global_load_lds((const unsigned*)((const char*)(gbase) + (voff)[_i]), (PG8_LAS unsigned*)(lds + (bufoff) + ldsw + _i * 8192), 16, 0, 0); } while (0)
#define PG8_LDA(dst, b, h) do { _Pragma("unroll") for (int m = 0; m < 4; ++m) _Pragma("unroll") for (int k = 0; k < 2; ++k) dst[m][k] = *(const PG8_LAS bf16x8*)(lds + PG8_SA(b, h) + aoff + m * 2048 + k * 1024); } while (0)
#define PG8_LDB(dst, b, h) do { _Pragma("unroll") for (int n = 0; n < 2; ++n) _Pragma("unroll") for (int k = 0; k < 2; ++k) dst[n][k] = *(const PG8_LAS bf16x8*)(lds + PG8_SB(b, h) + boff + n * 2048 + k * 1024); } while (0)
#define PG8_MMA(ai, bj, At, Bt) do { __builtin_amdgcn_s_setprio(1); _Pragma("unroll") for (int m = 0; m < 4; ++m) _Pragma("unroll") for (int n = 0; n < 2; ++n) _Pragma("unroll") for (int k = 0; k < 2; ++k) \
        acc[ai][bj][m][n] = __builtin_amdgcn_mfma_f32_16x16x32_bf16(Bt[n][k], At[m][k], acc[ai][bj][m][n], 0, 0, 0); __builtin_amdgcn_s_setprio(0); } while (0)
#define PG8_WAIT_V(n) asm volatile("s_waitcnt vmcnt(" #n ")" ::: "memory")
#define PG8_WAIT_L(n) asm volatile("s_waitcnt lgkmcnt(" #n ")" ::: "memory")
#define PG8_BAR __builtin_amdgcn_s_barrier()
#define PG8_SCHED __builtin_amdgcn_sched_barrier(0)
    Unit cur, nxt; int ui = 0;
    if (!S.next(0, cur)) return;
    f32x4 acc[2][2][4][2];
#pragma unroll
    for (int a = 0; a < 2; ++a)
#pragma unroll
        for (int b = 0; b < 2; ++b)
#pragma unroll
            for (int m = 0; m < 4; ++m)
#pragma unroll
                for (int n = 0; n < 2; ++n) acc[a][b][m][n] = (f32x4){0.f, 0.f, 0.f, 0.f};
    bf16x8 At[4][2], B0[2][2], B1[2][2];
    const char* cA = (const char*)g.A + (size_t)cur.pm * tstep; const char* cB = (const char*)g.Bt + (size_t)cur.pn * tstep;
    S.a_ready(cur);
    if constexpr (SP2) {
        PG8_STAGE(PG8_SB(0, 0), cB, voffB); PG8_STAGE(PG8_SB(0, 1), cB + hstep, voffB); PG8_STAGE(PG8_SA(0, 0), cA, voffA); PG8_STAGE(PG8_SA(0, 1), cA + hstep, voffA);
        if (wr == 1) PG8_BAR;
        PG8_WAIT_V(2); PG8_BAR;
        PG8_STAGE(PG8_SB(1, 0), cB + kstep, voffB); PG8_STAGE(PG8_SA(1, 0), cA + kstep, voffA); PG8_STAGE(PG8_SB(1, 1), cB + hstep + kstep, voffB);
        PG8_WAIT_V(6); PG8_BAR;
    } else {
        PG8_STAGE(PG8_SB(0, 0), cB, voffB); PG8_STAGE(PG8_SA(0, 0), cA, voffA); PG8_STAGE(PG8_SB(0, 1), cB + hstep, voffB); PG8_STAGE(PG8_SA(0, 1), cA + hstep, voffA);
        if (wr == 1) PG8_BAR;
        PG8_WAIT_V(4); PG8_BAR;
        PG8_STAGE(PG8_SB(1, 0), cB + kstep, voffB); PG8_STAGE(PG8_SA(1, 0), cA + kstep, voffA); PG8_STAGE(PG8_SB(1, 1), cB + hstep + kstep, voffB);
        PG8_WAIT_V(6); PG8_BAR;
    }
    for (;;) {
        const bool has_next = S.next(ui + 1, nxt);
        const char* nA = has_next ? (const char*)g.A + (size_t)nxt.pm * tstep : cA; const char* nB = has_next ? (const char*)g.Bt + (size_t)nxt.pn * tstep : cB;
        for (int t = 0; t < nt; t += 2) {
            const bool last = (t == nt - 2);
            const char* a1 = cA + (size_t)(t + 1) * kstep;
            const char* a2 = last ? nA : cA + (size_t)(t + 2) * kstep; const char* b2 = last ? nB : cB + (size_t)(t + 2) * kstep;
            const char* a3 = a2 + kstep; const char* b3 = b2 + kstep;
            if (last && has_next) S.a_ready(nxt);
            if constexpr (SP2) {
            PG8_LDB(B0, 0, 0); PG8_LDB(B1, 0, 1); PG8_SCHED; PG8_LDA(At, 0, 0); PG8_STAGE(PG8_SA(1, 1), a1 + hstep, voffA);
            PG8_WAIT_V(8); PG8_WAIT_L(0); PG8_BAR; PG8_MMA(0, 0, At, B0); PG8_MMA(0, 1, At, B1); PG8_BAR; PG8_SCHED;
            PG8_LDA(At, 0, 1); PG8_STAGE(PG8_SB(0, 0), b2, voffB); PG8_STAGE(PG8_SB(0, 1), b2 + hstep, voffB); PG8_STAGE(PG8_SA(0, 0), a2, voffA);
            PG8_WAIT_V(8); PG8_WAIT_L(0); PG8_BAR; PG8_MMA(1, 0, At, B0); PG8_MMA(1, 1, At, B1); PG8_BAR; PG8_SCHED;
            PG8_LDB(B0, 1, 0); PG8_LDB(B1, 1, 1); PG8_SCHED; PG8_LDA(At, 1, 0); PG8_STAGE(PG8_SA(0, 1), a2 + hstep, voffA);
            PG8_WAIT_V(8); PG8_WAIT_L(0); PG8_BAR; PG8_MMA(0, 0, At, B0); PG8_MMA(0, 1, At, B1); PG8_BAR; PG8_SCHED;
            PG8_LDA(At, 1, 1); PG8_STAGE(PG8_SB(1, 0), b3, voffB); PG8_STAGE(PG8_SB(1, 1), b3 + hstep, voffB); PG8_STAGE(PG8_SA(1, 0), a3, voffA);
            PG8_WAIT_V(8); PG8_WAIT_L(0); PG8_BAR; PG8_MMA(1, 0, At, B0); PG8_MMA(1, 1, At, B1); PG8_BAR; PG8_SCHED;
            } else {
            PG8_LDB(B0, 0, 0); PG8_SCHED; PG8_LDA(At, 0, 0); PG8_STAGE(PG8_SA(1, 1), a1 + hstep, voffA);
            PG8_WAIT_L(8); PG8_BAR; PG8_WAIT_L(0); PG8_MMA(0, 0, At, B0); PG8_BAR; PG8_SCHED;
            PG8_LDB(B1, 0, 1); PG8_STAGE(PG8_SB(0, 0), b2, voffB);
            PG8_BAR; PG8_WAIT_L(0); PG8_MMA(0, 1, At, B1); PG8_BAR;
            PG8_LDA(At, 0, 1); PG8_STAGE(PG8_SA(0, 0), a2, voffA);
            PG8_BAR; PG8_WAIT_L(0); PG8_MMA(1, 0, At, B0); PG8_BAR; PG8_SCHED;
            PG8_STAGE(PG8_SB(0, 1), b2 + hstep, voffB);
            PG8_WAIT_V(6); PG8_BAR; PG8_MMA(1, 1, At, B1); PG8_BAR;
            PG8_LDB(B0, 1, 0); PG8_SCHED; PG8_LDA(At, 1, 0); PG8_STAGE(PG8_SA(0, 1), a2 + hstep, voffA);
            PG8_WAIT_L(8); PG8_BAR; PG8_WAIT_L(0); PG8_MMA(0, 0, At, B0); PG8_BAR; PG8_SCHED;
            PG8_LDB(B1, 1, 1); PG8_STAGE(PG8_SB(1, 0), b3, voffB);
            PG8_BAR; PG8_WAIT_L(0); PG8_MMA(0, 1, At, B1); PG8_BAR;
            PG8_LDA(At, 1, 1); PG8_STAGE(PG8_SA(1, 0), a3, voffA);
            PG8_BAR; PG8_WAIT_L(0); PG8_MMA(1, 0, At, B0); PG8_BAR; PG8_SCHED;
            PG8_STAGE(PG8_SB(1, 1), b3 + hstep, voffB);
            PG8_WAIT_V(6); PG8_BAR; PG8_MMA(1, 1, At, B1); PG8_BAR;
            }
        }
        if constexpr (ALIGN_EPI) { if (wr == 0) PG8_BAR; }
        if constexpr (!Epi::AFTER_DRAIN) { E(acc, cur, wr, wc, fr, fq); S.done(cur); }
        if (!has_next) break;
#pragma unroll
        for (int a = 0; a < 2; ++a)
#pragma unroll
            for (int b = 0; b < 2; ++b)
#pragma unroll
                for (int m = 0; m < 4; ++m)
#pragma unroll
                    for (int n = 0; n < 2; ++n) acc[a][b][m][n] = (f32x4){0.f, 0.f, 0.f, 0.f};
        cur = nxt; cA = nA; cB = nB; ++ui;
        if constexpr (ALIGN_EPI) { if (wr == 1) PG8_BAR; }
    }
    PG8_WAIT_V(0);
    if constexpr (!ALIGN_EPI) { if (wr == 0) PG8_BAR; }
    PG8_BAR;
    if constexpr (Epi::AFTER_DRAIN) { E.fused(acc, cur, wr, wc, fr, fq, lds, wid, lane); S.done(cur); }
#undef PG8_SA
#undef PG8_SB
#undef PG8_STAGE
#undef PG8_LDA
#undef PG8_LDB
#undef PG8_MMA
#undef PG8_WAIT_V
#undef PG8_WAIT_L
#undef PG8_BAR
#undef PG8_SCHED
}
}
namespace attn_body {
using bf16=__hip_bfloat16;
using bf16x8=__attribute__((ext_vector_type(8)))short;
using s16x4=__attribute__((ext_vector_type(4)))short;
using f32x16=__attribute__((ext_vector_type(16)))float;
using u32x4=__attribute__((ext_vector_type(4)))unsigned;
constexpr int BATCH=16,NHEAD=8,SEQ=4096,D=64,DM=NHEAD*D;
constexpr int NW=8,QBLK=32,QB=QBLK*NW,KVBLK=64,NQB=SEQ/QB;
constexpr int ATTN_PITCH=DM, ATTN_UNIT_ROWS=QB;
__device__ __forceinline__ int crow(int r,int hi){return (r&3)+8*(r>>2)+4*hi;}
#define SBAR() __builtin_amdgcn_sched_barrier(0)
__device__ __forceinline__ void biasw(f32x16&p0,f32x16&p1,int dbase,const __attribute__((address_space(3))) float*bdl){
  #pragma unroll
  for(int r=0;r<16;++r){const int pos=(r&3)+8*(r>>2);
    int d0=dbase-pos, d1=d0-32; d0=d0<0?0:(d0>127?127:d0); d1=d1<0?0:(d1>127?127:d1); p0[r]+=bdl[d0]; p1[r]+=bdl[d1]; }
}
#define MPOS(r) (((r)&3)+8*((r)>>2))
__device__ __forceinline__ float mand(float p,unsigned w,int pos){ return __builtin_bit_cast(float,__builtin_bit_cast(unsigned,p)&(unsigned)__builtin_amdgcn_sbfe((int)w,pos,1)); }

constexpr int NSLOT=3, SLOTB=8192;
constexpr int LDS_K=0, LDS_V=NSLOT*SLOTB, LDS_WS=2*NSLOT*SLOTB, LDS_OST=LDS_WS+NW*64*4, LDS_BIAS=LDS_OST+NW*4096, LDS_BYTES=LDS_BIAS+NHEAD*128*4;
constexpr float C2=0.125f*1.4426950408889634f;
__device__ __forceinline__ void glds16(const void*gsrc,unsigned lds_dst){unsigned keep;
  asm volatile("s_mov_b32 %0, m0\n\ts_mov_b32 m0, %2\n\ts_nop 0\n\tglobal_load_lds_dwordx4 %1, off\n\ts_mov_b32 m0, %0":"=&s"(keep):"v"(gsrc),"s"(lds_dst):"memory");}
__device__ __forceinline__ float max3f(float a,float b,float c){float r;asm("v_max3_f32 %0, %1, %2, %3":"=v"(r):"v"(a),"v"(b),"v"(c));return r;}
__device__ __forceinline__ float max2f(float a,float b){float r;asm("v_max_f32_e32 %0, %1, %2":"=v"(r):"v"(a),"v"(b));return r;}
__device__ __forceinline__ float fadd_s(float a,float b){float r;asm("v_add_f32_e32 %0, %1, %2":"=v"(r):"v"(a),"v"(b));return r;}
__device__ __forceinline__ float fsub_s(float a,float b){float r;asm("v_sub_f32_e32 %0, %1, %2":"=v"(r):"v"(a),"v"(b));return r;}
typedef float f32x2_t __attribute__((ext_vector_type(2))); typedef __bf16 bf16x2_t __attribute__((ext_vector_type(2)));
__device__ __forceinline__ unsigned cvtpk_s(float lo,float hi){f32x2_t v={lo,hi};bf16x2_t b=__builtin_convertvector(v,bf16x2_t);return __builtin_bit_cast(unsigned,b);}
#define WAIT_BAR(N) asm volatile("s_waitcnt vmcnt(" #N ") lgkmcnt(0)\n\ts_barrier":::"memory")

__device__ __forceinline__ void qkt(f32x16&p0,f32x16&p1,const char*Kslot,const bf16x8*qr,const f32x16&negm,int r32,int hi){
  const char*kb=Kslot+hi*1024+r32*16;
  #pragma unroll
  for(int d0=0;d0<4;++d0){
    const bf16x8 b0=*reinterpret_cast<const bf16x8*>(kb+d0*2048);
    const bf16x8 b1=*reinterpret_cast<const bf16x8*>(kb+d0*2048+512);
    if(d0==0){p0=__builtin_amdgcn_mfma_f32_32x32x16_bf16(b0,qr[0],negm,0,0,0);p1=__builtin_amdgcn_mfma_f32_32x32x16_bf16(b1,qr[0],negm,0,0,0);}
    else{p0=__builtin_amdgcn_mfma_f32_32x32x16_bf16(b0,qr[d0],p0,0,0,0);p1=__builtin_amdgcn_mfma_f32_32x32x16_bf16(b1,qr[d0],p1,0,0,0);}}
}
typedef __attribute__((address_space(3))) const char* lds_cptr;
typedef short v4i16_t __attribute__((ext_vector_type(4)));
__device__ __forceinline__ void kload8(bf16x8*kf,lds_cptr kp){
  kf[0]=*(const __attribute__((address_space(3))) bf16x8*)(kp);      kf[1]=*(const __attribute__((address_space(3))) bf16x8*)(kp+512);
  kf[2]=*(const __attribute__((address_space(3))) bf16x8*)(kp+2048); kf[3]=*(const __attribute__((address_space(3))) bf16x8*)(kp+2560);
  kf[4]=*(const __attribute__((address_space(3))) bf16x8*)(kp+4096); kf[5]=*(const __attribute__((address_space(3))) bf16x8*)(kp+4608);
  kf[6]=*(const __attribute__((address_space(3))) bf16x8*)(kp+6144); kf[7]=*(const __attribute__((address_space(3))) bf16x8*)(kp+6656);
}
__device__ __forceinline__ void kload2(bf16x8*kf,lds_cptr kp,int j){ kf[2*j]=*(const __attribute__((address_space(3))) bf16x8*)(kp+j*2048); kf[2*j+1]=*(const __attribute__((address_space(3))) bf16x8*)(kp+j*2048+512); }
__device__ __forceinline__ s16x4 vtr(lds_cptr p){ return __builtin_bit_cast(s16x4,__builtin_amdgcn_ds_read_tr16_b64_v4i16((__attribute__((address_space(3))) v4i16_t*)p)); }
__device__ __forceinline__ float rowmax(const f32x16&p0,const f32x16&p1){
  float a=max3f(p0[0],p0[1],p1[0]),b=max3f(p0[2],p0[3],p1[1]);a=max3f(a,p1[2],p1[3]);
  #pragma unroll
  for(int r=4;r<16;r+=4){a=max3f(a,p0[r],p0[r+1]);b=max3f(b,p0[r+2],p0[r+3]);a=max3f(a,p1[r],p1[r+1]);b=max3f(b,p1[r+2],p1[r+3]);}
  const float m=max2f(a,b);
  auto rr=__builtin_amdgcn_permlane32_swap(__float_as_uint(m),__float_as_uint(m),false,false);
  return max2f(__uint_as_float(rr[0]),__uint_as_float(rr[1]));
}
__device__ __forceinline__ void pv(f32x16*o,int vb,bf16x8 pa0,bf16x8 pa1,bf16x8 pa2,bf16x8 pa3){
  #pragma unroll
  for(int d0=0;d0<2;++d0){s16x4 lo[4],hi[4];
    #pragma unroll
    for(int ks=0;ks<4;++ks){
      asm volatile("ds_read_b64_tr_b16 %0,%1 offset:%c2":"=&v"(lo[ks]):"v"(vb),"i"(d0*4096+ks*1024):"memory");
      asm volatile("ds_read_b64_tr_b16 %0,%1 offset:%c2":"=&v"(hi[ks]):"v"(vb),"i"(d0*4096+ks*1024+512):"memory");}
    asm volatile("s_waitcnt lgkmcnt(0)":::"memory");SBAR();
    #define PK(k) (bf16x8){lo[k][0],lo[k][1],lo[k][2],lo[k][3],hi[k][0],hi[k][1],hi[k][2],hi[k][3]}
    o[d0]=__builtin_amdgcn_mfma_f32_32x32x16_bf16(pa0,PK(0),o[d0],0,0,0);
    o[d0]=__builtin_amdgcn_mfma_f32_32x32x16_bf16(pa1,PK(1),o[d0],0,0,0);
    o[d0]=__builtin_amdgcn_mfma_f32_32x32x16_bf16(pa2,PK(2),o[d0],0,0,0);
    o[d0]=__builtin_amdgcn_mfma_f32_32x32x16_bf16(pa3,PK(3),o[d0],0,0,0);
    #undef PK
  }
}

#ifndef ATTN_STORE16
#define ATTN_STORE16(p,v) (*(u32x4*)(p)=(v))
#endif
template<int THRL> __device__ __forceinline__ void attn_unit(int b,int h,int qb,const bf16*Q,const bf16*__restrict__ K,const bf16*__restrict__ V,bf16*O,const unsigned long long*MK,char*shm){
  const int tid=mk_tid(),lane=tid&63,r32=lane&31,hi=lane>>5; const int wid=__builtin_amdgcn_readfirstlane(tid>>6);
  const long rowbase=(long)b*SEQ; const int q0=qb*QB;
  const bf16*Qw=Q+(rowbase+q0+wid*QBLK)*DM+h*D;
  const bf16*Kh=K+rowbase*DM+h*D,*Vh=V+rowbase*DM+h*D;
  const lds_cptr shm3=(lds_cptr)shm;
  const unsigned lds0=(unsigned)(uintptr_t)shm;
  float*wsf=(float*)(shm+LDS_WS)+wid*64;
  const bf16*ksrc=Kh+(long)lane*DM+wid*8;
  const bf16*vsrc=Vh+(long)(16*(wid&3)+(lane>>2))*DM+(wid>>2)*32+(lane&3)*8;
  const unsigned kdst=lds0+LDS_K+wid*1024, vdst=lds0+LDS_V+wid*1024;
  #define DMA_K(t,slot) glds16(ksrc+(long)(t)*KVBLK*DM,(unsigned)__builtin_amdgcn_readfirstlane(kdst+(slot)))
  #define DMA_V(t,slot) glds16(vsrc+(long)(t)*KVBLK*DM,(unsigned)__builtin_amdgcn_readfirstlane(vdst+(slot)))
  const int vb0=(int)(lds0+LDS_V)+((lane>>4)&1)*32+(lane&3)*8+(4*hi+((lane&15)>>2))*64;
  const char*Kbase=shm+LDS_K; bf16x8 kf[8];
  const lds_cptr kp0=shm3+LDS_K+hi*1024+r32*16; const lds_cptr vp0=shm3+LDS_V+((lane>>4)&1)*32+(lane&3)*8+(4*hi+((lane&15)>>2))*64;
  const int NT=(q0+QB)/KVBLK;
  const int qrel=wid*QBLK+r32;
  const unsigned long long*mkp=MK+(rowbase+q0+qrel)*64;
  const __attribute__((address_space(3))) float*bdl=(const __attribute__((address_space(3))) float*)(shm3+LDS_BIAS)+h*128;
  unsigned long long mwA,mwB;
  #define MLOAD(M,t) asm volatile("global_load_dwordx2 %0, %1, off":"=&v"(M):"v"(mkp+(t)):"memory")
  #define MPIN(M) asm volatile("":"+v"(M))
  MLOAD(mwA,0);MLOAD(mwB,1);
  DMA_K(0,0);DMA_V(0,0);DMA_K(1,SLOTB);
  bf16x8 qr[4];
  #pragma unroll
  for(int d0=0;d0<4;++d0)qr[d0]=*reinterpret_cast<const bf16x8*>(&Qw[(long)r32*DM+d0*16+hi*8]);
  float mhat=0.f,l_reg=0.f;f32x16 o[2];o[0]=f32x16{};o[1]=f32x16{};const f32x16 negm=f32x16{};
  #define CMASK(P0,P1,t,M) do{ if((t)>=NT-6)biasw(P0,P1,q0+qrel-64*(t)-4*hi,bdl); }while(0)
  bool resc=false;
  #define START(P0,P1) do{ const float rm=rowmax(P0,P1); resc=false; mhat=__builtin_fmaxf(rm,0.f); \
    _Pragma("unroll") for(int r=0;r<16;++r)P0[r]=mand(__builtin_amdgcn_exp2f(P0[r]-mhat),((unsigned)mwA)>>(4*hi),MPOS(r)); }while(0)
  #define RESC() do{ if(resc){ asm volatile("s_waitcnt lgkmcnt(0)":::"memory"); \
      _Pragma("unroll") for(int d_=0;d_<2;++d_) _Pragma("unroll") for(int r=0;r<16;++r)o[d_][r]*=wsf[crow(r,hi)]; } }while(0)
  f32x16 pA0,pA1,pB0,pB1;
  int sl_prev=0,sl_cur=0,sl_next=SLOTB;
  #define ROT() do{sl_prev=sl_cur;sl_cur=sl_next;sl_next=(sl_next==(NSLOT-1)*SLOTB)?0:sl_next+SLOTB;}while(0)
  DMA_K(2,2*SLOTB);
  WAIT_BAR(3); MPIN(mwA); MPIN(mwB);
  qkt(pA0,pA1,Kbase,qr,negm,r32,hi);asm volatile("s_nop 15\n\ts_nop 7":"+v"(pA0),"+v"(pA1));CMASK(pA0,pA1,0,mwA);
  START(pA0,pA1);
  _Pragma("unroll") for(int r=0;r<16;++r)pA1[r]=mand(__builtin_amdgcn_exp2f(pA1[r]-mhat),((unsigned)(mwA>>32))>>(4*hi),MPOS(r));
  WAIT_BAR(0);
  DMA_K(3,0);DMA_V(1,SLOTB);
  ROT();
  kload8(kf,kp0+sl_cur);
  WAIT_BAR(2);
  s16x4 vlo[8],vhi[8]; u32x4 pw0,pw1,pw2,pw3;
  #define PKW(P,B) cvtpk_s(P[B],P[B+1])
  #define PAF(k) __builtin_bit_cast(bf16x8,pw##k)
  #define VFR(i) (bf16x8){vlo[i][0],vlo[i][1],vlo[i][2],vlo[i][3],vhi[i][0],vhi[i][1],vhi[i][2],vhi[i][3]}
  #define PIN(x) asm volatile("":"+v"(x))
  #define MX3(a,b,c) __builtin_fmaxf(__builtin_fmaxf((a),(b)),(c))
  #define GAPA(MF,A0,A1,A2,A3,W0,W1,PW) do{ MF; sacc+=A0; sacc+=A1; sacc+=A2; sacc+=A3; PIN(sacc); W0; W1; PIN(PW); SBAR(); }while(0)
  #define EX(v) __builtin_amdgcn_exp2f(v)
  #define GAPB(MF,X,B,W) do{ MF; X[B]=mand(EX(X[B]-mhat),W,MPOS(B)); X[B+1]=mand(EX(X[B+1]-mhat),W,MPOS(B+1)); X[B+2]=mand(EX(X[B+2]-mhat),W,MPOS(B+2)); X[B+3]=mand(EX(X[B+3]-mhat),W,MPOS(B+3)); PIN(X); SBAR(); }while(0)
  #define VRD(i) do{ vlo[i]=vtr(vp_+(((i)>>2)*4096+((i)&3)*1024)); vhi[i]=vtr(vp_+(((i)>>2)*4096+((i)&3)*1024+512)); }while(0)
  #define KRD(G,j) do{ if(G){ kload2(kf,kp0+sl_next,j); SBAR(); } }while(0)
  #define STEP(C0,C1,P0,P1,t,GK,GV,GL,MC,MN) do{ SBAR(); if(GV){MLOAD(MN,(t)+1);} \
    const lds_cptr vp_=vp0+sl_prev; \
    VRD(0); SBAR(); float sacc=(P0[0]+P0[1]); \
    GAPA(C0=__builtin_amdgcn_mfma_f32_32x32x16_bf16(kf[0],qr[0],negm,0,0,0), P0[2],P0[3],P0[4],P0[5],     pw0[0]=PKW(P0,0), pw0[1]=PKW(P0,2), pw0); \
    VRD(4); SBAR(); GAPA(C1=__builtin_amdgcn_mfma_f32_32x32x16_bf16(kf[1],qr[0],negm,0,0,0), P0[6],P0[7],P0[8],P0[9],     pw0[2]=PKW(P0,4), pw0[3]=PKW(P0,6), pw0); \
    VRD(1); SBAR(); GAPA(C0=__builtin_amdgcn_mfma_f32_32x32x16_bf16(kf[2],qr[1],C0,0,0,0),   P0[10],P0[11],P0[12],P0[13], pw1[0]=PKW(P0,8), pw1[1]=PKW(P0,10), pw1); \
    VRD(5); SBAR(); GAPA(C1=__builtin_amdgcn_mfma_f32_32x32x16_bf16(kf[3],qr[1],C1,0,0,0),   P0[14],P0[15],P1[0],P1[1],   pw1[2]=PKW(P0,12),pw1[3]=PKW(P0,14), pw1); \
    VRD(2); SBAR(); GAPA(C0=__builtin_amdgcn_mfma_f32_32x32x16_bf16(kf[4],qr[2],C0,0,0,0),   P1[2],P1[3],P1[4],P1[5],     pw2[0]=PKW(P1,0), pw2[1]=PKW(P1,2), pw2); \
    VRD(6); SBAR(); GAPA(C1=__builtin_amdgcn_mfma_f32_32x32x16_bf16(kf[5],qr[2],C1,0,0,0),   P1[6],P1[7],P1[8],P1[9],     pw2[2]=PKW(P1,4), pw2[3]=PKW(P1,6), pw2); \
    VRD(3); SBAR(); GAPA(C0=__builtin_amdgcn_mfma_f32_32x32x16_bf16(kf[6],qr[3],C0,0,0,0),   P1[10],P1[11],P1[12],P1[13], pw3[0]=PKW(P1,8), pw3[1]=PKW(P1,10), pw3); \
    VRD(7); SBAR(); GAPA(C1=__builtin_amdgcn_mfma_f32_32x32x16_bf16(kf[7],qr[3],C1,0,0,0),   P1[14],P1[15],0.f,0.f,       pw3[2]=PKW(P1,12),pw3[3]=PKW(P1,14), pw3); \
    l_reg+=sacc; \
    if(GK){DMA_K((t)+3,sl_cur);} if(GV){DMA_V((t)+1,sl_next);} \
    CMASK(C0,C1,t,MC); const unsigned mlo_=((unsigned)(MC))>>(4*hi), mhi_=((unsigned)((MC)>>32))>>(4*hi); \
    { float a=MX3(C0[0],C0[1],C1[0]),b=MX3(C0[2],C0[3],C1[1]); a=MX3(a,C1[2],C1[3]); \
      _Pragma("unroll") for(int r=4;r<16;r+=4){a=MX3(a,C0[r],C0[r+1]);b=MX3(b,C0[r+2],C0[r+3]);a=MX3(a,C1[r],C1[r+1]);b=MX3(b,C1[r+2],C1[r+3]);} \
      float rm=__builtin_fmaxf(a,b); { auto rr=__builtin_amdgcn_permlane32_swap(__float_as_uint(rm),__float_as_uint(rm),false,false); rm=__builtin_fmaxf(__uint_as_float(rr[0]),__uint_as_float(rr[1])); } \
      resc=false; const float rd=rm-mhat; \
      if(__builtin_expect(__any(rd>(float)THRL),0)){ const float dl=__builtin_fmaxf(rd,0.f); mhat+=dl; \
        const float f=__builtin_amdgcn_exp2f(-dl); l_reg*=f; if(hi==0)wsf[r32]=f; resc=true; } } \
    SBAR(); \
    GAPB(o[0]=__builtin_amdgcn_mfma_f32_32x32x16_bf16(PAF(0),VFR(0),o[0],0,0,0), C0,0,mlo_); \
    GAPB(o[1]=__builtin_amdgcn_mfma_f32_32x32x16_bf16(PAF(0),VFR(4),o[1],0,0,0), C0,4,mlo_); \
    KRD(GL,0); GAPB(o[0]=__builtin_amdgcn_mfma_f32_32x32x16_bf16(PAF(1),VFR(1),o[0],0,0,0), C0,8,mlo_); \
    KRD(GL,1); GAPB(o[1]=__builtin_amdgcn_mfma_f32_32x32x16_bf16(PAF(1),VFR(5),o[1],0,0,0), C0,12,mlo_); \
    KRD(GL,2); GAPB(o[0]=__builtin_amdgcn_mfma_f32_32x32x16_bf16(PAF(2),VFR(2),o[0],0,0,0), C1,0,mhi_); \
    KRD(GL,3); GAPB(o[1]=__builtin_amdgcn_mfma_f32_32x32x16_bf16(PAF(2),VFR(6),o[1],0,0,0), C1,4,mhi_); \
    GAPB(o[0]=__builtin_amdgcn_mfma_f32_32x32x16_bf16(PAF(3),VFR(3),o[0],0,0,0), C1,8,mhi_); \
    GAPB(o[1]=__builtin_amdgcn_mfma_f32_32x32x16_bf16(PAF(3),VFR(7),o[1],0,0,0), C1,12,mhi_); \
    }while(0)
  int t=1;
  #undef CMASK
  #define CMASK(P0,P1,t,M) do{}while(0)
  for(;t+7<NT;t+=2){
    STEP(pB0,pB1,pA0,pA1,t,true,true,true,mwB,mwA);     WAIT_BAR(2); MPIN(mwA); RESC(); ROT();
    STEP(pA0,pA1,pB0,pB1,t+1,true,true,true,mwA,mwB);   WAIT_BAR(2); MPIN(mwB); RESC(); ROT();
  }
  #undef CMASK
  #define CMASK(P0,P1,t,M) do{ if((t)>=NT-6)biasw(P0,P1,q0+qrel-64*(t)-4*hi,bdl); }while(0)
  #define ENDW(tt) do{ if((tt)+3<NT){WAIT_BAR(2);} else if((tt)+2<NT){WAIT_BAR(1);} else {WAIT_BAR(0);} }while(0)
  for(;t+1<NT;t+=2){
    STEP(pB0,pB1,pA0,pA1,t,(t+3<NT),(t+1<NT),(t+1<NT),mwB,mwA);       ENDW(t);   MPIN(mwA); RESC(); ROT();
    STEP(pA0,pA1,pB0,pB1,t+1,(t+4<NT),(t+2<NT),(t+2<NT),mwA,mwB);     ENDW(t+1); MPIN(mwB); RESC(); ROT();
  }
  STEP(pB0,pB1,pA0,pA1,NT-1,false,false,false,mwB,mwA); RESC();
  { float sacc=pB0[0]+pB0[1]; _Pragma("unroll") for(int r=2;r<16;++r)sacc+=pB0[r]; _Pragma("unroll") for(int r=0;r<16;++r)sacc+=pB1[r]; l_reg+=sacc;
    pw0=(u32x4){PKW(pB0,0),PKW(pB0,2),PKW(pB0,4),PKW(pB0,6)};pw1=(u32x4){PKW(pB0,8),PKW(pB0,10),PKW(pB0,12),PKW(pB0,14)};pw2=(u32x4){PKW(pB1,0),PKW(pB1,2),PKW(pB1,4),PKW(pB1,6)};pw3=(u32x4){PKW(pB1,8),PKW(pB1,10),PKW(pB1,12),PKW(pB1,14)};
    SBAR(); pv(o,vb0+sl_cur,PAF(0),PAF(1),PAF(2),PAF(3)); }
  #undef PKW
  #undef PAF
  #undef VFR
  #undef PIN
  #undef MX3
  #undef GAPA
  #undef GAPB
  #undef EX
  #undef VRD
  #undef KRD
  #undef STEP
  #undef ENDW
  {auto rr=__builtin_amdgcn_permlane32_swap(__float_as_uint(l_reg),__float_as_uint(l_reg),false,false);l_reg=__uint_as_float(rr[0])+__uint_as_float(rr[1]);}
  if(hi==0)wsf[32+r32]=l_reg;asm volatile("s_waitcnt lgkmcnt(0)":::"memory");
  float rli[16];
  #pragma unroll
  for(int r=0;r<16;++r)rli[r]=__builtin_amdgcn_rcpf(wsf[32+crow(r,hi)]);
  bf16*Ow=O+(rowbase+q0+wid*QBLK)*DM+h*D;
  { bf16*stg=(bf16*)(shm+LDS_OST)+wid*2048;
    #pragma unroll
    for(int r=0;r<16;++r){const int orow=crow(r,hi);
      #pragma unroll
      for(int d0=0;d0<2;++d0)stg[orow*64+d0*32+r32]=__float2bfloat16(o[d0][r]*rli[r]);}
    asm volatile("s_waitcnt lgkmcnt(0)":::"memory");
    #pragma unroll
    for(int i=0;i<4;++i){const int row=i*8+(lane>>3),ch=lane&7; const u32x4 v=*(const u32x4*)(stg+row*64+ch*8); ATTN_STORE16(Ow+(long)row*DM+ch*8,v);} }
  asm volatile("s_waitcnt lgkmcnt(0)\n\ts_barrier":::"memory");
  #undef DMA_K
  #undef MLOAD
  #undef MPIN
  #undef DMA_V
  #undef CMASK
  #undef START
  #undef RESC
  #undef ROT
}
constexpr int ATTN_LDS_BYTES=LDS_BYTES;
#undef SBAR
#undef WAIT_BAR
}
namespace mk {
using pg8::bf16_t; using pg8::f32x4; using pg8::u32x4; using pg8::bf16x8; using pg8::Unit; using pg8::Gemm;
constexpr int T = 65536, SEQ = 4096, NBATCH = 16, DM = 1024;
constexpr int NTHREADS = 512, NWAVES = 8;
constexpr size_t MiB = 1u << 20;
constexpr size_t WS_CTL = 0;
constexpr size_t WS_EID = 1 * MiB, WS_GATE = 2 * MiB, WS_SLOT = 3 * MiB;
constexpr size_t WS_WTIN = 4 * MiB;
constexpr size_t WS_WTA = 16 * MiB, WS_WTB = 17 * MiB, WS_WTOUT = 18 * MiB, WS_WTLORA = 20 * MiB;
constexpr size_t WS_WTGU = 21 * MiB;
constexpr size_t WS_WTDN = 85 * MiB;
constexpr size_t WS_KN = 117 * MiB;
constexpr size_t WS_MISC = 125 * MiB;
constexpr size_t WS_AP = 145 * MiB;
constexpr size_t WS_MASK = 177 * MiB;
constexpr size_t WS_YB = 209 * MiB;
constexpr size_t WS_RW = 273 * MiB;
constexpr size_t WS_Q = 497 * MiB, WS_K = 561 * MiB, WS_V = 625 * MiB, WS_QI = 689 * MiB;
constexpr size_t WS_SGA = 753 * MiB, WS_SGB = 881 * MiB;
constexpr size_t WS_END = 1009 * MiB;
constexpr size_t WS_H1B = WS_RW;
constexpr size_t WS_XS = WS_Q;
constexpr size_t WS_ACT = 769 * MiB;
constexpr int NROWS_PAD = 131072 + 32 * 256;
static_assert(WS_XS + (size_t)NROWS_PAD * 2048 <= WS_ACT && WS_ACT + (size_t)NROWS_PAD * 1024 <= WS_END, "overlay map");
constexpr size_t DO_XBF = 0;
constexpr size_t DO_OMW = 0, DO_ASIG = 64 * MiB, DO_G = 128 * MiB, DO_YA = 192 * MiB;

constexpr int LDS_TOTAL = 155648;
constexpr int LDS_TAB = 131072;

struct Params { const float* in[30]; float* out; char* ws; };

__device__ __forceinline__ float wave_sum(float v) {
#pragma unroll
    for (int o = 1; o < 64; o <<= 1) v += __shfl_xor(v, o);
    return v;
}
__device__ __forceinline__ unsigned f2bf(float f) { unsigned u = __builtin_bit_cast(unsigned, f); return (u + 0x7fffu + ((u >> 16) & 1u)) >> 16; }
__device__ __forceinline__ unsigned pk2(float lo, float hi) { return f2bf(lo) | (f2bf(hi) << 16); }
__device__ __forceinline__ float bf2f(bf16_t v) { return __builtin_bit_cast(float, (unsigned)v << 16); }
__device__ __forceinline__ float bflo(unsigned w) { return __builtin_bit_cast(float, w << 16); }
__device__ __forceinline__ float bfhi(unsigned w) { return __builtin_bit_cast(float, w & 0xffff0000u); }
__device__ __forceinline__ float sigmoidf_(float x) { return __builtin_amdgcn_rcpf(1.f + __expf(-x)); }

template <class Src>
__device__ __forceinline__ void transpose_item(const Src& S, int K, bf16_t* dst, LAS float* scr, int k0, int n0, int lane) {
#pragma unroll 8
    for (int i = 0; i < 32; ++i) { const int kk = 2 * i + (lane >> 5); scr[kk * 33 + (lane & 31)] = S(k0 + kk, n0 + (lane & 31)); }
    asm volatile("s_waitcnt lgkmcnt(0)" ::: "memory");
    const int c = lane & 7;
#pragma unroll
    for (int j = 0; j < 4; ++j) { const int n = (lane >> 3) + 8 * j; const LAS float* s = scr + (8 * c) * 33 + n;
        u32x4 o; o.x = pk2(s[0 * 33], s[1 * 33]); o.y = pk2(s[2 * 33], s[3 * 33]); o.z = pk2(s[4 * 33], s[5 * 33]); o.w = pk2(s[6 * 33], s[7 * 33]);
        *(u32x4*)(dst + (size_t)(n0 + n) * K + k0 + 8 * c) = o; }
    asm volatile("s_waitcnt lgkmcnt(0)" ::: "memory");
}
struct SrcWin { const float* w; __device__ __forceinline__ float operator()(int k, int n) const {
    int c; if (n < 3840) c = n; else if (n < 5888) c = n + 72; else if (n < 5960) c = n - 5888 + 3840; else return 0.f;
    return w[(size_t)k * 5960 + c]; } };
struct SrcPlain { const float* w; int N; __device__ __forceinline__ float operator()(int k, int n) const { return w[(size_t)k * N + n]; } };
struct SrcGU { const float* g; long ud; __device__ __forceinline__ float operator()(int k, int n) const {
    const int pn = n >> 8, c = n & 255, bj = c >> 7, wc = (c & 127) >> 5, fq = (c & 31) >> 3, nn = (c & 7) >> 2, i = c & 3;
    const int hj = 128 * pn + 64 * bj + 16 * wc + 4 * fq + i; return g[(long)k * 512 + hj + (nn ? ud : 0l)]; } };

__device__ __forceinline__ void phase_prologue(const Params& p, LAS unsigned char* lds) {
    const int tid = mk_tid(), lane = tid & 63, wave = tid >> 6;
    const int gw = blockIdx.x * NWAVES + wave, NGW = gridDim.x * NWAVES;
    LAS float* scr = (LAS float*)(lds + wave * 16384);
    char* ws = p.ws;
    if (blockIdx.x == 0 && tid < 64) ((unsigned*)(ws + WS_CTL))[tid] = 0u;
    constexpr int I_IN = 16 * 192, I_A = 8 * 32, I_B = 8 * 32, I_O = 16 * 32, I_GU = 32 * 16 * 32, I_DN = 32 * 8 * 32;
    constexpr int NITEMS = I_IN + I_A + I_B + I_O + I_GU + I_DN;
    for (int it = gw; it < NITEMS; it += NGW) {
        int r = it;
        if (r < I_IN) { SrcWin S{p.in[1]}; transpose_item(S, 1024, (bf16_t*)(ws + WS_WTIN), scr, (r / 192) * 64, (r % 192) * 32, lane); continue; } r -= I_IN;
        if (r < I_A) { SrcPlain S{p.in[13], 1024}; transpose_item(S, 512, (bf16_t*)(ws + WS_WTA), scr, (r / 32) * 64, (r % 32) * 32, lane); continue; } r -= I_A;
        if (r < I_B) { SrcPlain S{p.in[17], 1024}; transpose_item(S, 512, (bf16_t*)(ws + WS_WTB), scr, (r / 32) * 64, (r % 32) * 32, lane); continue; } r -= I_B;
        if (r < I_O) { SrcPlain S{p.in[18], 1024}; transpose_item(S, 1024, (bf16_t*)(ws + WS_WTOUT), scr, (r / 32) * 64, (r % 32) * 32, lane); continue; } r -= I_O;
        if (r < I_GU) { const int e = r / 512, q = r % 512; SrcGU S{p.in[25] + (size_t)e * 1024 * 512, (long)(p.in[26] - p.in[25])};
            transpose_item(S, 1024, (bf16_t*)(ws + WS_WTGU) + (size_t)e * 1024 * 1024, scr, (q / 32) * 64, (q % 32) * 32, lane); continue; } r -= I_GU;
        { const int e = r / 256, q = r % 256; SrcPlain S{p.in[27] + (size_t)e * 512 * 1024, 1024};
            transpose_item(S, 512, (bf16_t*)(ws + WS_WTDN) + (size_t)e * 1024 * 512, scr, (q / 32) * 64, (q % 32) * 32, lane); }
    }
    { bf16_t* wl = (bf16_t*)(ws + WS_WTLORA); const int gt = blockIdx.x * NTHREADS + tid, NGT = gridDim.x * NTHREADS;
      for (int i = gt; i < 1536 * 256; i += NGT) { const int n = i >> 8, k = i & 255; float v = 0.f;
          if (n < 512) { if (k < 64) v = p.in[4][k * 512 + n]; }
          else if (n < 1024) { if (k >= 64 && k < 128) v = p.in[6][(k - 64) * 512 + (n - 512)]; }
          else { if (k >= 128) v = p.in[7][(k - 128) * 512 + (n - 1024)]; }
          wl[i] = (bf16_t)f2bf(v); } }
    { const f32x4* x4 = (const f32x4*)p.in[0]; unsigned long long* o8 = (unsigned long long*)((char*)p.out + DO_XBF);
      const size_t gt = (size_t)blockIdx.x * NTHREADS + tid, NGT = (size_t)gridDim.x * NTHREADS;
      for (size_t i = gt; i < (size_t)T * DM / 4; i += NGT) { const f32x4 v = x4[i]; o8[i] = (unsigned long long)pk2(v.x, v.y) | ((unsigned long long)pk2(v.z, v.w) << 32); } }
}

struct EpiIn {
    static constexpr bool PERM = true, AFTER_DRAIN = false;
    char* ws;
    __device__ __forceinline__ void operator()(const f32x4 (&acc)[2][2][4][2], const Unit& u, int wr, int wc, int fr, int fq) const {
        const int pn = u.pn, row0 = u.pm * 256 + wr * 64 + fr, cl = wc * 32 + 8 * fq;
        if (pn == 23) {
            if (cl < 72) { float* dst = (float*)(ws + WS_MISC);
#pragma unroll
                for (int ai = 0; ai < 2; ++ai)
#pragma unroll
                    for (int m = 0; m < 4; ++m) { float* d = dst + (size_t)(row0 + ai * 128 + m * 16) * 80 + cl; *(f32x4*)d = acc[ai][0][m][0]; *(f32x4*)(d + 4) = acc[ai][0][m][1]; } }
            return;
        }
        bf16_t* base; int ld, colt, mode = 0;
        if (pn < 7) { base = (bf16_t*)(ws + WS_RW); ld = 1792; colt = pn * 256; }
        else if (pn < 9) { base = (bf16_t*)(ws + WS_Q); ld = 512; colt = (pn - 7) * 256; mode = 2; }
        else if (pn < 11) { base = (bf16_t*)(ws + WS_K); ld = 512; colt = (pn - 9) * 256; }
        else if (pn < 13) { base = (bf16_t*)(ws + WS_V); ld = 512; colt = (pn - 11) * 256; }
        else if (pn < 15) { base = (bf16_t*)(ws + WS_QI); ld = 512; colt = (pn - 13) * 256; }
        else if (pn < 19) { base = (bf16_t*)(ws + WS_SGA); ld = 1024; colt = (pn - 15) * 256; mode = 1; }
        else { base = (bf16_t*)(ws + WS_SGB); ld = 1024; colt = (pn - 19) * 256; mode = 1; }
#pragma unroll
        for (int ai = 0; ai < 2; ++ai)
#pragma unroll
            for (int m = 0; m < 4; ++m) { bf16_t* rowp = base + (size_t)(row0 + ai * 128 + m * 16) * ld + colt + cl;
#pragma unroll
                for (int bj = 0; bj < 2; ++bj) { f32x4 v0 = acc[ai][bj][m][0], v1 = acc[ai][bj][m][1];
                    if (mode == 1) {
#pragma unroll
                        for (int i = 0; i < 4; ++i) { v0[i] = sigmoidf_(v0[i]); v1[i] = sigmoidf_(v1[i]); } }
                    else if (mode == 2) { v0 = v0 * attn_body::C2; v1 = v1 * attn_body::C2; }
                    u32x4 w; w.x = pk2(v0[0], v0[1]); w.y = pk2(v0[2], v0[3]); w.z = pk2(v1[0], v1[1]); w.w = pk2(v1[2], v1[3]);
                    *(u32x4*)(rowp + bj * 128) = w; } }
    }
};
struct EpiLora {
    static constexpr bool PERM = true, AFTER_DRAIN = false;
    char* dout;
    __device__ __forceinline__ void operator()(const f32x4 (&acc)[2][2][4][2], const Unit& u, int wr, int wc, int fr, int fq) const {
        const int pn = u.pn, seg = pn >> 1, row0 = u.pm * 256 + wr * 64 + fr, col0 = (pn & 1) * 256 + wc * 32 + 8 * fq;
        bf16_t* base = (bf16_t*)(dout + (size_t)seg * (64 * MiB));
#pragma unroll
        for (int ai = 0; ai < 2; ++ai)
#pragma unroll
            for (int m = 0; m < 4; ++m)
#pragma unroll
                for (int bj = 0; bj < 2; ++bj) { const f32x4 v0 = acc[ai][bj][m][0], v1 = acc[ai][bj][m][1]; u32x4 w;
                    w.x = pk2(v0[0], v0[1]); w.y = pk2(v0[2], v0[3]); w.z = pk2(v1[0], v1[1]); w.w = pk2(v1[2], v1[3]);
                    *(u32x4*)(base + (size_t)(row0 + ai * 128 + m * 16) * 512 + col0 + bj * 128) = w; }
    }
};
struct EpiGateMul {
    static constexpr bool PERM = true, AFTER_DRAIN = false;
    const bf16_t* gate; bf16_t* dst; int add;
    __device__ __forceinline__ void operator()(const f32x4 (&acc)[2][2][4][2], const Unit& u, int wr, int wc, int fr, int fq) const {
        const int row0 = u.pm * 256 + wr * 64 + fr, col0 = u.pn * 256 + wc * 32 + 8 * fq;
#pragma unroll
        for (int ai = 0; ai < 2; ++ai)
#pragma unroll
            for (int m = 0; m < 4; ++m)
#pragma unroll
                for (int bj = 0; bj < 2; ++bj) { const size_t off = (size_t)(row0 + ai * 128 + m * 16) * 1024 + col0 + bj * 128;
                    const u32x4 g = *(const u32x4*)(gate + off); u32x4 d = {0u, 0u, 0u, 0u}; if (add) d = *(const u32x4*)(dst + off);
                    const f32x4 v0 = acc[ai][bj][m][0], v1 = acc[ai][bj][m][1]; u32x4 w;
                    w.x = pk2(bflo(d.x) + bflo(g.x) * v0[0], bfhi(d.x) + bfhi(g.x) * v0[1]); w.y = pk2(bflo(d.y) + bflo(g.y) * v0[2], bfhi(d.y) + bfhi(g.y) * v0[3]);
                    w.z = pk2(bflo(d.z) + bflo(g.z) * v1[0], bfhi(d.z) + bfhi(g.z) * v1[1]); w.w = pk2(bflo(d.w) + bflo(g.w) * v1[2], bfhi(d.w) + bfhi(g.w) * v1[3]);
                    *(u32x4*)(dst + off) = w; }
    }
};
struct EpiResid {
    static constexpr bool PERM = true, AFTER_DRAIN = false;
    const float* x; float* out; float alpha;
    __device__ __forceinline__ void operator()(const f32x4 (&acc)[2][2][4][2], const Unit& u, int wr, int wc, int fr, int fq) const {
        const int row0 = u.pm * 256 + wr * 64 + fr, col0 = u.pn * 256 + wc * 32 + 8 * fq;
#pragma unroll
        for (int ai = 0; ai < 2; ++ai)
#pragma unroll
            for (int m = 0; m < 4; ++m)
#pragma unroll
                for (int bj = 0; bj < 2; ++bj) { const size_t off = (size_t)(row0 + ai * 128 + m * 16) * 1024 + col0 + bj * 128;
                    const f32x4 x0 = *(const f32x4*)(x + off), x1 = *(const f32x4*)(x + off + 4);
                    *(f32x4*)(out + off) = x0 * alpha + acc[ai][bj][m][0]; *(f32x4*)(out + off + 4) = x1 * alpha + acc[ai][bj][m][1]; }
    }
};
struct EpiSwiglu {
    static constexpr bool PERM = true, AFTER_DRAIN = false;
    bf16_t* act;
    __device__ __forceinline__ void operator()(const f32x4 (&acc)[2][2][4][2], const Unit& u, int wr, int wc, int fr, int fq) const {
        const int row0 = u.pm * 256 + wr * 64 + fr, col0 = (u.pn & 3) * 128 + 16 * wc + 4 * fq;
#pragma unroll
        for (int ai = 0; ai < 2; ++ai)
#pragma unroll
            for (int m = 0; m < 4; ++m)
#pragma unroll
                for (int bj = 0; bj < 2; ++bj) { const f32x4 g = acc[ai][bj][m][0], up = acc[ai][bj][m][1]; float a[4];
#pragma unroll
                    for (int i = 0; i < 4; ++i) a[i] = g[i] * sigmoidf_(g[i]) * up[i];
                    *(unsigned long long*)(act + (size_t)(row0 + ai * 128 + m * 16) * 512 + col0 + bj * 64) = (unsigned long long)pk2(a[0], a[1]) | ((unsigned long long)pk2(a[2], a[3]) << 32); }
    }
};
struct EpiDown {
    static constexpr bool PERM = true, AFTER_DRAIN = false;
    bf16_t* ys;
    __device__ __forceinline__ void operator()(const f32x4 (&acc)[2][2][4][2], const Unit& u, int wr, int wc, int fr, int fq) const {
        const int row0 = u.pm * 256 + wr * 64 + fr, col0 = (u.pn & 3) * 256 + wc * 32 + 8 * fq;
#pragma unroll
        for (int ai = 0; ai < 2; ++ai)
#pragma unroll
            for (int m = 0; m < 4; ++m)
#pragma unroll
                for (int bj = 0; bj < 2; ++bj) { const f32x4 v0 = acc[ai][bj][m][0], v1 = acc[ai][bj][m][1]; u32x4 w;
                    w.x = pk2(v0[0], v0[1]); w.y = pk2(v0[2], v0[3]); w.z = pk2(v1[0], v1[1]); w.w = pk2(v1[2], v1[3]);
                    *(u32x4*)(ys + (size_t)(row0 + ai * 128 + m * 16) * 1024 + col0 + bj * 128) = w; }
    }
};
struct MoeOrder {
    const LAS int* tab;
    int G, c;
    __device__ __forceinline__ bool next(int i, Unit& u) const {
        const int L = i * G + c; const int nt = tab[0]; if (L >= nt * 4) return false;
        const int ti = L >> 2; u.pm = ti; u.pn = tab[1 + ti] * 4 + (L & 3); return true; }
    __device__ __forceinline__ void a_ready(const Unit&) const {}
    __device__ __forceinline__ void done(const Unit&) const {}
};
__device__ __forceinline__ void moe_tables(const Params& p, LAS int* tab) {
    const int tid = mk_tid(); const unsigned* cnt = (const unsigned*)(p.ws + WS_CTL);
    __syncthreads();
    if (tid == 0) { int ts = 0; for (int e = 0; e < 32; ++e) { const int c = (int)cnt[e]; tab[1024 + e] = ts * 256; const int nt = (c + 255) >> 8; for (int j = 0; j < nt; ++j) tab[1 + ts + j] = e; ts += nt; } tab[0] = ts; tab[1024 + 32] = ts * 256; }
    __syncthreads();
}

__device__ __forceinline__ void phase_prep(const Params& p) {
    const int tid = mk_tid(), lane = tid & 63, wave = tid >> 6;
    const int gw = blockIdx.x * NWAVES + wave, NGW = gridDim.x * NWAVES;
    const bf16_t* RW = (const bf16_t*)(p.ws + WS_RW); const float* MISC = (const float*)(p.ws + WS_MISC);
    bf16_t* AP = (bf16_t*)(p.ws + WS_AP); bf16_t* KN = (bf16_t*)(p.ws + WS_KN);
    const float* mu = p.in[2];
    const float mu_wd = mu[512 + lane], mu_ad = mu[1600 + lane], mu_g0 = mu[1664 + lane], mu_g1 = mu[1728 + lane];
    const float lg = p.in[14][lane], lb = p.in[15][lane];
    for (int tok = gw; tok < T; tok += NGW) {
        const bf16_t* cur = RW + (size_t)tok * 1792; const bool hp = (tok & (SEQ - 1)) != 0; const bf16_t* prv = cur - 1792;
        float wd = bf2f(cur[512 + lane]), ad = bf2f(cur[1600 + lane]), g0 = bf2f(cur[1664 + lane]), g1 = bf2f(cur[1728 + lane]);
        const float wdp = hp ? bf2f(prv[512 + lane]) : 0.f, adp = hp ? bf2f(prv[1600 + lane]) : 0.f, g0p = hp ? bf2f(prv[1664 + lane]) : 0.f, g1p = hp ? bf2f(prv[1728 + lane]) : 0.f;
        wd += (wdp - wd) * mu_wd; ad += (adp - ad) * mu_ad; g0 += (g0p - g0) * mu_g0; g1 += (g1p - g1) * mu_g1;
        bf16_t* ap = AP + (size_t)tok * 256;
        ap[lane] = (bf16_t)f2bf(tanhf(wd)); ap[64 + lane] = (bf16_t)f2bf(ad); ap[128 + lane] = (bf16_t)f2bf(sigmoidf_(g0)); ap[192 + lane] = (bf16_t)f2bf(sigmoidf_(g1));
        const float kx = MISC[(size_t)tok * 80 + lane]; const float mean = wave_sum(kx) * (1.f / 64.f); const float d = kx - mean;
        const float var = wave_sum(d * d) * (1.f / 64.f);
        KN[(size_t)tok * 64 + lane] = (bf16_t)f2bf(d * rsqrtf(var + 1e-5f) * lg + lb);
    }
}

typedef _Float16 h8 __attribute__((ext_vector_type(8)));
__device__ __forceinline__ float dpp_sum8(float x) {
    x += __builtin_bit_cast(float, __builtin_amdgcn_mov_dpp(__builtin_bit_cast(int, x), 0xB1, 0xF, 0xF, true));
    x += __builtin_bit_cast(float, __builtin_amdgcn_mov_dpp(__builtin_bit_cast(int, x), 0x4E, 0xF, 0xF, true));
    x += __builtin_bit_cast(float, __builtin_amdgcn_mov_dpp(__builtin_bit_cast(int, x), 0x141, 0xF, 0xF, true));
    return x;
}
__device__ __forceinline__ float dpp_sum16(float x) {
    x += __builtin_bit_cast(float, __builtin_amdgcn_mov_dpp(__builtin_bit_cast(int, x), 0xB1, 0xF, 0xF, true));
    x += __builtin_bit_cast(float, __builtin_amdgcn_mov_dpp(__builtin_bit_cast(int, x), 0x4E, 0xF, 0xF, true));
    x += __builtin_bit_cast(float, __builtin_amdgcn_mov_dpp(__builtin_bit_cast(int, x), 0x141, 0xF, 0xF, true));
    x += __builtin_bit_cast(float, __builtin_amdgcn_mov_dpp(__builtin_bit_cast(int, x), 0x140, 0xF, 0xF, true));
    return x;
}
constexpr int SC = 32;
typedef unsigned u32x2 __attribute__((ext_vector_type(2)));
typedef float f2 __attribute__((ext_vector_type(2)));
struct ScanRaw { u32x2 r, k, v, rp, kp, vp, w, a, g; };
struct ScanKeep { f32x4 v, g; float bonus; };
constexpr int SCL_VEC = 0, SCL_VBUF = SCL_VEC + 2 * SC * 1280, SCL_YBUF = SCL_VBUF + 2 * SC * 256, SCL_DUMMY = SCL_YBUF + 2 * SC * 256, SCL_END = SCL_DUMMY + 8704;
__device__ __forceinline__ void scan_item(const Params& p, LAS unsigned char* lds, int bh) {
    const int b = bh >> 3, h = bh & 7;
    const int tid = mk_tid(), lane = tid & 63, wave = tid >> 6;
    const bf16_t* RW = (const bf16_t*)(p.ws + WS_RW);
    const bf16_t* OMW = (const bf16_t*)((char*)p.out + DO_OMW); const bf16_t* ASIG = (const bf16_t*)((char*)p.out + DO_ASIG); const bf16_t* GG = (const bf16_t*)((char*)p.out + DO_G);
    bf16_t* YA = (bf16_t*)((char*)p.out + DO_YA);
    const size_t row0 = (size_t)b * SEQ;
    constexpr int NCH = SEQ / SC;
    __syncthreads();
    if (wave >= 4) {
        const int hw_ = wave - 4, tokl = lane >> 4, cg = lane & 15, col = h * 64 + 4 * cg;
        const f32x4 mu_r = *(const f32x4*)(p.in[2] + col), mu_k = *(const f32x4*)(p.in[2] + 576 + col), mu_v = *(const f32x4*)(p.in[2] + 1088 + col);
        const f32x4 w0c = *(const f32x4*)(p.in[3] + col), a0c = *(const f32x4*)(p.in[5] + col), kkc = *(const f32x4*)(p.in[8] + col), kac = *(const f32x4*)(p.in[9] + col);
        const f32x4 rkc = *(const f32x4*)(p.in[10] + col), lxg = *(const f32x4*)(p.in[11] + col), lxb = *(const f32x4*)(p.in[12] + col);
        ScanRaw R[2]; ScanKeep K0[2], K1[2];
#define SCAN_LOAD(c_, q_) do { const int t_ = (c_) * SC + hw_ * 8 + (q_) * 4 + tokl; const size_t rw_ = row0 + t_; const bf16_t* cur_ = RW + rw_ * 1792 + col; const bf16_t* prv_ = cur_ - 1792; \
        R[q_].r = *(const u32x2*)cur_; R[q_].k = *(const u32x2*)(cur_ + 576); R[q_].v = *(const u32x2*)(cur_ + 1088); \
        if (t_ > 0) { R[q_].rp = *(const u32x2*)prv_; R[q_].kp = *(const u32x2*)(prv_ + 576); R[q_].vp = *(const u32x2*)(prv_ + 1088); } else { R[q_].rp = (u32x2){0u, 0u}; R[q_].kp = R[q_].rp; R[q_].vp = R[q_].rp; } \
        R[q_].w = *(const u32x2*)(OMW + rw_ * 512 + col); R[q_].a = *(const u32x2*)(ASIG + rw_ * 512 + col); R[q_].g = *(const u32x2*)(GG + rw_ * 512 + col); } while (0)
#define UNPK(u_) (f32x4){bflo((u_).x), bfhi((u_).x), bflo((u_).y), bfhi((u_).y)}
#define SCAN_PREP(c_, q_) do { const int tk_ = hw_ * 8 + (q_) * 4 + tokl; const int bf_ = (c_) & 1; \
        f32x4 r = UNPK(R[q_].r), k = UNPK(R[q_].k), v = UNPK(R[q_].v); const f32x4 rp = UNPK(R[q_].rp), kp = UNPK(R[q_].kp), vp = UNPK(R[q_].vp); \
        r += (rp - r) * mu_r; k += (kp - k) * mu_k; v += (vp - v) * mu_v; \
        const f32x4 wr = UNPK(R[q_].w) + w0c, ar = UNPK(R[q_].a) + a0c; f32x4 a, omw; \
        _Pragma("unroll") for (int i = 0; i < 4; ++i) { a[i] = sigmoidf_(ar[i]); \
            const float z = -wr[i]; const float sp = z > 20.f ? z : __logf(1.f + __expf(z)); const float e = __expf(-sp - 0.5f); \
            omw[i] = e < 0.1f ? e * (1.f - e * (0.5f - e * ((1.f / 6.f) - e * ((1.f / 24.f) - e * (1.f / 120.f))))) : 1.f - __expf(-e); } \
        const f32x4 kkr = k * kkc; const float n2 = dpp_sum16((kkr.x * kkr.x + kkr.y * kkr.y) + (kkr.z * kkr.z + kkr.w * kkr.w)); \
        const f32x4 kk = kkr * __builtin_amdgcn_rsqf(fmaxf(n2, 1e-24f)); const f32x4 k2 = k * ((a - 1.f) * kac + 1.f); \
        const f32x4 rb = r * k2 * rkc; K0[q_].bonus = dpp_sum16((rb.x + rb.y) + (rb.z + rb.w)); K0[q_].v = v; K0[q_].g = UNPK(R[q_].g); \
        LAS float* vp_ = (LAS float*)(lds + SCL_VEC) + (bf_ * SC + tk_) * 320 + 4 * cg; \
        *(LAS f32x4*)(vp_) = 1.f - omw; *(LAS f32x4*)(vp_ + 64) = -kk; *(LAS f32x4*)(vp_ + 128) = kk * a; *(LAS f32x4*)(vp_ + 192) = k2; *(LAS f32x4*)(vp_ + 256) = r; \
        *(LAS f32x4*)((LAS float*)(lds + SCL_VBUF) + (bf_ * SC + tk_) * 64 + 4 * cg) = v; } while (0)
#define SCAN_POST(c_, q_) do { const int tk_ = hw_ * 8 + (q_) * 4 + tokl; const int bf_ = (c_) & 1; \
        const f32x4 y = *(const LAS f32x4*)((LAS float*)(lds + SCL_YBUF) + (bf_ * SC + tk_) * 64 + 4 * cg); \
        const float mean = dpp_sum16((y.x + y.y) + (y.z + y.w)) * (1.f / 64.f); const f32x4 d = y - mean; \
        const float var = dpp_sum16((d.x * d.x + d.y * d.y) + (d.z * d.z + d.w * d.w)) * (1.f / 64.f); const float rs = __builtin_amdgcn_rsqf(var + 64e-5f); \
        const f32x4 o = (d * rs * lxg + lxb + K1[q_].v * K1[q_].bonus) * K1[q_].g; \
        *(u32x2*)(YA + (row0 + (size_t)(c_) * SC + tk_) * 512 + col) = (u32x2){pk2(o.x, o.y), pk2(o.z, o.w)}; } while (0)
        SCAN_LOAD(0, 0); SCAN_LOAD(0, 1);
        SCAN_PREP(0, 0); SCAN_PREP(0, 1);
        SCAN_LOAD(1, 0); SCAN_LOAD(1, 1);
        K1[0] = K0[0]; K1[1] = K0[1];
        __syncthreads();
        for (int c = 0; c <= NCH; ++c) {
            if (c >= 1) { SCAN_POST(c - 1, 0); SCAN_POST(c - 1, 1); }
            K1[0] = K0[0]; K1[1] = K0[1];
            if (c + 1 < NCH) { SCAN_PREP(c + 1, 0); SCAN_PREP(c + 1, 1); }
            if (c + 2 < NCH) { SCAN_LOAD(c + 2, 0); SCAN_LOAD(c + 2, 1); }
            if (c < NCH) __syncthreads();
        }
#undef SCAN_LOAD
#undef UNPK
#undef SCAN_PREP
#undef SCAN_POST
    } else {
        const int rp = lane >> 3, jg = lane & 7, i0 = wave * 16 + rp * 2;
        const int yoff = (jg == 0) ? i0 : (SCL_DUMMY - SCL_YBUF) / 4 + 2 * lane;
        f2 s0[4], s1[4];
#pragma unroll
        for (int j = 0; j < 4; ++j) { s0[j] = (f2){0.f, 0.f}; s1[j] = s0[j]; }
        __syncthreads();
        for (int c = 0; c < NCH; ++c) {
            const int bf = c & 1;
            const LAS float* vecb = (const LAS float*)(lds + SCL_VEC) + bf * SC * 320; const LAS float* vbb = (const LAS float*)(lds + SCL_VBUF) + bf * SC * 64 + i0;
            LAS float* ybb = (LAS float*)(lds + SCL_YBUF) + ((jg == 0) ? bf * SC * 64 : 0) + yoff;
#if defined(MK_REP) && MK_REP == 302
            f2 k0_[4], k1_[4];
#pragma unroll
            for (int j = 0; j < 4; ++j) { k0_[j] = s0[j]; k1_[j] = s1[j]; }
            for (int rep_ = 0; rep_ < 2; ++rep_) {
#pragma unroll
            for (int j = 0; j < 4; ++j) { s0[j] = k0_[j]; s1[j] = k1_[j]; asm volatile("" : "+v"(s0[j]), "+v"(s1[j]) :: "memory"); }
#endif
#define LDV(t_, W, A, B, K, Rr, V) do { const LAS f32x4* q_ = (const LAS f32x4*)(vecb + (t_) * 320) + 2 * jg; W##0 = q_[0]; W##1 = q_[1]; A##0 = q_[16]; A##1 = q_[17]; B##0 = q_[32]; B##1 = q_[33]; \
        K##0 = q_[48]; K##1 = q_[49]; Rr##0 = q_[64]; Rr##1 = q_[65]; V = *(const LAS f2*)(vbb + (t_) * 64); } while (0)
#define LO2(v_) __builtin_shufflevector(v_, v_, 0, 1)
#define HI2(v_) __builtin_shufflevector(v_, v_, 2, 3)
#define FMA2(a_, b_, c_) __builtin_elementwise_fma(a_, b_, c_)
            f32x4 vw0, vw1, va0, va1, vb0, vb1, vk0, vk1, vr0, vr1; f2 vv;
            LDV(0, vw, va, vb, vk, vr, vv);
#pragma unroll 2
            for (int tk = 0; tk < SC; ++tk) {
                f32x4 nw0, nw1, na0, na1, nb0, nb1, nk0, nk1, nr0, nr1; f2 nv;
                { const int tn = (tk + 1 < SC) ? tk + 1 : tk; LDV(tn, nw, na, nb, nk, nr, nv); }
                f2 p0 = s0[0] * LO2(va0), p1 = s1[0] * LO2(va0);
                p0 = FMA2(s0[1], HI2(va0), p0); p1 = FMA2(s1[1], HI2(va0), p1); p0 = FMA2(s0[2], LO2(va1), p0); p1 = FMA2(s1[2], LO2(va1), p1); p0 = FMA2(s0[3], HI2(va1), p0); p1 = FMA2(s1[3], HI2(va1), p1);
                const float sa0 = dpp_sum8(p0.x + p0.y), sa1 = dpp_sum8(p1.x + p1.y);
                const f2 sa0v = {sa0, sa0}, sa1v = {sa1, sa1}, v0v = {vv.x, vv.x}, v1v = {vv.y, vv.y};
                s0[0] = FMA2(v0v, LO2(vk0), FMA2(sa0v, LO2(vb0), s0[0] * LO2(vw0))); s1[0] = FMA2(v1v, LO2(vk0), FMA2(sa1v, LO2(vb0), s1[0] * LO2(vw0)));
                s0[1] = FMA2(v0v, HI2(vk0), FMA2(sa0v, HI2(vb0), s0[1] * HI2(vw0))); s1[1] = FMA2(v1v, HI2(vk0), FMA2(sa1v, HI2(vb0), s1[1] * HI2(vw0)));
                s0[2] = FMA2(v0v, LO2(vk1), FMA2(sa0v, LO2(vb1), s0[2] * LO2(vw1))); s1[2] = FMA2(v1v, LO2(vk1), FMA2(sa1v, LO2(vb1), s1[2] * LO2(vw1)));
                s0[3] = FMA2(v0v, HI2(vk1), FMA2(sa0v, HI2(vb1), s0[3] * HI2(vw1))); s1[3] = FMA2(v1v, HI2(vk1), FMA2(sa1v, HI2(vb1), s1[3] * HI2(vw1)));
                f2 q0 = s0[0] * LO2(vr0), q1 = s1[0] * LO2(vr0);
                q0 = FMA2(s0[1], HI2(vr0), q0); q1 = FMA2(s1[1], HI2(vr0), q1); q0 = FMA2(s0[2], LO2(vr1), q0); q1 = FMA2(s1[2], LO2(vr1), q1); q0 = FMA2(s0[3], HI2(vr1), q0); q1 = FMA2(s1[3], HI2(vr1), q1);
                const float y0 = dpp_sum8(q0.x + q0.y), y1 = dpp_sum8(q1.x + q1.y);
                *(LAS f2*)(ybb + tk * 64) = (f2){y0, y1};
                vw0 = nw0; vw1 = nw1; va0 = na0; va1 = na1; vb0 = nb0; vb1 = nb1; vk0 = nk0; vk1 = nk1; vr0 = nr0; vr1 = nr1; vv = nv;
            }
#undef LDV
#undef LO2
#undef HI2
#undef FMA2
#if defined(MK_REP) && MK_REP == 302
            }
#endif
            __syncthreads();
        }
    }
}

constexpr int IX_HIST = 0, IX_MASK = 65536, IX_MROW = 129  , IX_CAND = IX_MASK + 8448, IX_MISC = IX_CAND + 16384, IX_CAP = 128;
struct IxSel { int B0, B1; float lo1; int refined; };
template <int MODE, int NH = 8>
__device__ __forceinline__ void ix_block(const bool DIAG, const bf16x8 a0, const bf16x8 a1, const bf16x8 (&qf)[9][2], const float (&hw)[8], int s0, int quad, int n, int tq, const IxSel& S,
                                         LAS unsigned* hist, LAS unsigned* mrow, LAS int* ccnt, LAS float* candv, LAS int* cands) {
    f32x4 idx = {0.f, 0.f, 0.f, 0.f};
    idx = __builtin_amdgcn_mfma_f32_16x16x32_bf16(a0, qf[8][0], idx, 0, 0, 0);
    idx = __builtin_amdgcn_mfma_f32_16x16x32_bf16(a1, qf[8][1], idx, 0, 0, 0);
#pragma unroll
    for (int h = 0; h < NH; ++h) { f32x4 acc = {0.f, 0.f, 0.f, 0.f};
        acc = __builtin_amdgcn_mfma_f32_16x16x32_bf16(a0, qf[h][0], acc, 0, 0, 0);
        acc = __builtin_amdgcn_mfma_f32_16x16x32_bf16(a1, qf[h][1], acc, 0, 0, 0);
#pragma unroll
        for (int j = 0; j < 4; ++j) idx[j] = __builtin_fmaf(hw[h], __builtin_fabsf(acc[j]), idx[j]); }
    int bin[4];
#pragma unroll
    for (int j = 0; j < 4; ++j) { int bq = (int)__builtin_fmaf(idx[j], 64.f, 512.f); bin[j] = bq < 0 ? 0 : (bq > 1023 ? 1023 : bq); }
    const int sb = s0 + quad * 4;
    if (MODE == 0) {
#pragma unroll
        for (int j = 0; j < 4; ++j) if (!DIAG || sb + j <= tq) __hip_atomic_fetch_add(&hist[n * 1024 + bin[j]], 1u, __ATOMIC_RELAXED, __HIP_MEMORY_SCOPE_WORKGROUP);
    } else if (MODE == 1) {
#pragma unroll
        for (int j = 0; j < 4; ++j) if ((!DIAG || sb + j <= tq) && bin[j] == S.B0) { int sq = (int)((idx[j] - S.lo1) * 65536.f); sq = sq < 0 ? 0 : (sq > 1023 ? 1023 : sq);
            __hip_atomic_fetch_add(&hist[n * 1024 + sq], 1u, __ATOMIC_RELAXED, __HIP_MEMORY_SCOPE_WORKGROUP); }
    } else {
        unsigned m = 0u, cm = 0u;
#pragma unroll
        for (int j = 0; j < 4; ++j) { const bool ok = !DIAG || sb + j <= tq; if (ok && bin[j] > S.B0) m |= 1u << j;
            if (ok && bin[j] == S.B0) { if (S.refined) { int sq = (int)((idx[j] - S.lo1) * 65536.f); sq = sq < 0 ? 0 : (sq > 1023 ? 1023 : sq); if (sq > S.B1) m |= 1u << j; else if (sq == S.B1) cm |= 1u << j; } else cm |= 1u << j; } }
        {
            unsigned t = m << (4 * quad);
            { auto r = __builtin_amdgcn_permlane16_swap(t, t, false, false); t = r[0] | r[1]; }
            { auto r = __builtin_amdgcn_permlane32_swap(t, t, false, false); t = r[0] | r[1]; }
            if (quad == 0) ((LAS unsigned short*)mrow)[n * (IX_MROW * 2) + (s0 >> 4)] = (unsigned short)t; }
        if (cm) {
            int sl = __hip_atomic_fetch_add(&ccnt[n], (int)__builtin_popcount(cm), __ATOMIC_RELAXED, __HIP_MEMORY_SCOPE_WORKGROUP);
#pragma unroll
            for (int j = 0; j < 4; ++j) if ((cm >> j) & 1u) { if (sl < IX_CAP) { candv[n * IX_CAP + sl] = idx[j]; cands[n * IX_CAP + sl] = sb + j; } ++sl; } }
    }
}
template <int MODE, int NH = 8>
__device__ __forceinline__ void ix_pass(const bf16_t* KNb, const bf16x8 (&qf)[9][2], const float (&hw)[8], int qg, int wave, int quad, int n, int tq, const IxSel& S,
                                        LAS unsigned* hist, LAS unsigned* mrow, LAS int* ccnt, LAS float* candv, LAS int* cands) {
    if (wave > qg) return;
    const int nb = (qg - wave) / NWAVES + 1;
    const bf16_t* kp0 = KNb + (size_t)(wave * 16 + n) * 64 + quad * 8;
    constexpr size_t KSTEP = (size_t)NWAVES * 16 * 64;
#define IX_LD(i_, x0_, x1_) do { const int ii_ = (i_) < nb ? (i_) : nb - 1; const bf16_t* q_ = kp0 + (size_t)ii_ * KSTEP; x0_ = *(const bf16x8*)q_; x1_ = *(const bf16x8*)(q_ + 32); } while (0)
#define IX_DO(i_, x0_, x1_) do { if ((i_) < nb) { const int kb_ = wave + NWAVES * (i_); const bf16x8 a0_ = x0_, a1_ = x1_; IX_LD((i_) + 4, x0_, x1_); \
        ix_block<MODE, NH>(kb_ == qg, a0_, a1_, qf, hw, kb_ * 16, quad, n, tq, S, hist, mrow, ccnt, candv, cands); } } while (0)
    bf16x8 r00, r01, r10, r11, r20, r21, r30, r31;
    IX_LD(0, r00, r01); IX_LD(1, r10, r11); IX_LD(2, r20, r21); IX_LD(3, r30, r31);
#pragma unroll 1
    for (int i = 0; i < nb; i += 4) { IX_DO(i, r00, r01); IX_DO(i + 1, r10, r11); IX_DO(i + 2, r20, r21); IX_DO(i + 3, r30, r31); }
#undef IX_LD
#undef IX_DO
}
__device__ __forceinline__ void ix_search(int tid, LAS unsigned* hist, LAS int* segsum, LAS int* needv, LAS int* outB, LAS int* outG, LAS int* outC) {
    const int qn = tid >> 5, seg = tid & 31;
    { int sum = 0; for (int w = 0; w < 32; ++w) sum += (int)hist[qn * 1024 + seg * 32 + w]; segsum[qn * 32 + seg] = sum; }
    __syncthreads();
    { const int need = needv[qn]; int above = 0; for (int s2 = seg + 1; s2 < 32; ++s2) above += segsum[qn * 32 + s2]; const int mine = segsum[qn * 32 + seg];
      if (above < need && above + mine >= need) { int cum = above;
          for (int bin = seg * 32 + 31; bin >= seg * 32; --bin) { const int cnt = (int)hist[qn * 1024 + bin];
              if (cum + cnt >= need) { outB[qn] = bin; outG[qn] = cum; outC[qn] = cnt; break; } cum += cnt; } } }
    __syncthreads();
}
__device__ __forceinline__ void indexer_unit(const Params& p, LAS unsigned char* lds, int b, int qg, int mode = 0) {
    const int tid = mk_tid(), lane = tid & 63, wave = tid >> 6;
    LAS unsigned* hist = (LAS unsigned*)(lds + IX_HIST);
    LAS unsigned* mrow = (LAS unsigned*)(lds + IX_MASK);
    LAS float* candv = (LAS float*)(lds + IX_CAND);
    LAS int* cands = (LAS int*)(lds + IX_CAND + 8192);
    LAS int* ccnt = (LAS int*)(lds + IX_MISC);
    LAS int* thrB = ccnt + 16; LAS int* thrG = ccnt + 32;
    LAS int* segsum = ccnt + 64;
    LAS int* needv = ccnt + 64 + 512; LAS int* thrC = needv + 16; LAS int* thrB1 = needv + 32; LAS int* thrG1 = needv + 48; LAS int* thrC1 = needv + 64;
    unsigned* MASK = (unsigned*)(p.ws + WS_MASK);
    const int t0 = qg * 16; const size_t rowb = (size_t)b * SEQ;
    if (qg < 16) {
        for (int i = tid; i < 2048; i += NTHREADS) { const int n = i >> 7, w = i & 127, tq = t0 + n; const int s0 = 32 * w;
            const unsigned m = tq >= s0 + 31 ? 0xffffffffu : (tq < s0 ? 0u : ((2u << (tq - s0)) - 1u));
            MASK[(rowb + t0) * 128 + i] = m; }
        return;
    }
    for (int i = tid; i < 16384 + 16 * IX_MROW; i += NTHREADS) hist[i] = 0u;
    if (tid < 16) { ccnt[tid] = 0; needv[tid] = 256; }
    const bf16_t* QI = (const bf16_t*)(p.ws + WS_QI); const bf16_t* KNb = (const bf16_t*)(p.ws + WS_KN) + rowb * 64; const float* MISC = (const float*)(p.ws + WS_MISC);
    const int n = lane & 15, quad = lane >> 4, tq = t0 + n;
    bf16x8 qf[9][2]; float hw[8];
#pragma unroll
    for (int h = 0; h < 8; ++h) { hw[h] = MISC[(rowb + tq) * 80 + 64 + h] * (0.5f * 0.125f * 0.35355339059327373f);
#pragma unroll
        for (int ks = 0; ks < 2; ++ks) qf[h][ks] = *(const bf16x8*)(QI + (rowb + tq) * 512 + h * 64 + ks * 32 + quad * 8); }
    { float s2 = 0.f;
#pragma unroll
      for (int h = 0; h < 8; ++h) { float qq = 0.f;
#pragma unroll
          for (int ks = 0; ks < 2; ++ks)
#pragma unroll
              for (int i = 0; i < 8; ++i) { const float e = bf2f((bf16_t)qf[h][ks][i]); qq = __builtin_fmaf(e, e, qq); }
          s2 = __builtin_fmaf(hw[h] * hw[h], qq, s2); }
      { auto r = __builtin_amdgcn_permlane16_swap(__builtin_bit_cast(unsigned, s2), __builtin_bit_cast(unsigned, s2), false, false); s2 = __builtin_bit_cast(float, r[0]) + __builtin_bit_cast(float, r[1]); }
      { auto r = __builtin_amdgcn_permlane32_swap(__builtin_bit_cast(unsigned, s2), __builtin_bit_cast(unsigned, s2), false, false); s2 = __builtin_bit_cast(float, r[0]) + __builtin_bit_cast(float, r[1]); }
      const float rs = rsqrtf(fmaxf(s2, 1e-30f));
#pragma unroll
      for (int h = 0; h < 8; ++h) hw[h] *= rs; }
#pragma unroll
    for (int ks = 0; ks < 2; ++ks)
#pragma unroll
        for (int i = 0; i < 8; i += 2) { float e0 = 0.f, e1 = 0.f;
#pragma unroll
            for (int h = 0; h < 8; ++h) { e0 = __builtin_fmaf(hw[h], bf2f((bf16_t)qf[h][ks][i]), e0); e1 = __builtin_fmaf(hw[h], bf2f((bf16_t)qf[h][ks][i + 1]), e1); }
            qf[8][ks][i] = (short)f2bf(e0); qf[8][ks][i + 1] = (short)f2bf(e1); }
    __syncthreads();
    IxSel S; S.B0 = 0; S.B1 = 0; S.lo1 = 0.f; S.refined = 0;
    if (mode == 7) { ix_pass<0, 2>(KNb, qf, hw, qg, wave, quad, n, tq, S, hist, mrow, ccnt, candv, cands); __syncthreads(); return; }
    if (mode == 8) { ix_pass<0, 8>(KNb, qf, hw, qg, wave, quad, n, tq, S, hist, mrow, ccnt, candv, cands); __syncthreads(); return; }
    ix_pass<0>(KNb, qf, hw, qg, wave, quad, n, tq, S, hist, mrow, ccnt, candv, cands);
    __syncthreads();
    ix_search(tid, hist, segsum, needv, thrB, thrG, thrC);
    S.B0 = thrB[n]; S.lo1 = (float)S.B0 * (1.f / 64.f) - 8.f;
    { int mx = 0;
#pragma unroll
      for (int q = 0; q < 16; ++q) mx = max(mx, thrC[q]);
      S.refined = mx > IX_CAP / 2; }
    if (S.refined) {
        __syncthreads();
        for (int i = tid; i < 16384; i += NTHREADS) hist[i] = 0u;
        if (tid < 16) needv[tid] = 256 - thrG[tid];
        __syncthreads();
        ix_pass<1>(KNb, qf, hw, qg, wave, quad, n, tq, S, hist, mrow, ccnt, candv, cands);
        __syncthreads();
        ix_search(tid, hist, segsum, needv, thrB1, thrG1, thrC1);
        S.B1 = thrB1[n];
    }
    ix_pass<2>(KNb, qf, hw, qg, wave, quad, n, tq, S, hist, mrow, ccnt, candv, cands);
    __syncthreads();
    { const int qn = tid >> 5, sub = tid & 31; const int nc = min(ccnt[qn], IX_CAP), need = 256 - thrG[qn] - (S.refined ? thrG1[qn] : 0);
#ifdef MK_CHK
      if (ccnt[qn] > MK_CHK) ((unsigned*)(p.ws + WS_CTL))[50] = 2u;
#endif
      for (int c = sub; c < nc; c += 32) { const float v = candv[qn * IX_CAP + c]; const int s = cands[qn * IX_CAP + c]; int rank = 0;
          for (int c2 = 0; c2 < nc; ++c2) { const float v2 = candv[qn * IX_CAP + c2]; const int s2 = cands[qn * IX_CAP + c2]; rank += (v2 > v || (v2 == v && s2 < s)) ? 1 : 0; }
          if (rank < need) __hip_atomic_fetch_or(&mrow[qn * IX_MROW + (s >> 5)], 1u << (s & 31), __ATOMIC_RELAXED, __HIP_MEMORY_SCOPE_WORKGROUP); } }
    __syncthreads();
    for (int i = tid; i < 2048; i += NTHREADS) MASK[(rowb + t0) * 128 + i] = mrow[(i >> 7) * IX_MROW + (i & 127)];
    __syncthreads();
}

__device__ __forceinline__ void phase_ln_router(const Params& p, LAS unsigned char* lds, bool dry = false) {
    const int tid = mk_tid(), lane = tid & 63, wave = tid >> 6;
    LAS float* WR = (LAS float*)lds;
    LAS int* lcnt = (LAS int*)(lds + 147456);
    LAS int* lbase = lcnt + 32;
    LAS int* tke = lcnt + 64;
    LAS int* tks = lcnt + 64 + 512;
    for (int i = tid; i < 36 * 1024; i += NTHREADS) { const int o = i >> 10, k = i & 1023; WR[i] = o < 4 ? p.in[21][k * 4 + o] : p.in[23][k * 32 + (o - 4)]; }
    float* H = p.out; bf16_t* H1B = (bf16_t*)(p.ws + WS_H1B);
    int* EID = (int*)(p.ws + WS_EID); float* GATE = (float*)(p.ws + WS_GATE); int* SLOT = (int*)(p.ws + WS_SLOT); unsigned* gcnt = (unsigned*)(p.ws + WS_CTL);
    const float* g1 = p.in[19]; const float* b1 = p.in[20];
    for (int tile = blockIdx.x; tile < T / 256; tile += gridDim.x) {
        if (tid < 32) lcnt[tid] = 0;
        __syncthreads();
        for (int it = 0; it < 32; ++it) {
            const int tl = wave * 32 + it, tok = tile * 256 + tl;
            f32x4* hr = (f32x4*)(H + (size_t)tok * DM) + lane;
            f32x4 v[4]; float s = 0.f;
#pragma unroll
            for (int j = 0; j < 4; ++j) { v[j] = hr[64 * j]; s += (v[j].x + v[j].y) + (v[j].z + v[j].w); }
            const float mean = wave_sum(s) * (1.f / DM); float s2 = 0.f;
#pragma unroll
            for (int j = 0; j < 4; ++j) { v[j] = v[j] - mean; s2 += (v[j].x * v[j].x + v[j].y * v[j].y) + (v[j].z * v[j].z + v[j].w * v[j].w); }
            const float rstd = rsqrtf(wave_sum(s2) * (1.f / DM) + 1e-5f);
#pragma unroll
            for (int j = 0; j < 4; ++j) { const f32x4 g = ((const f32x4*)g1)[lane + 64 * j], bb = ((const f32x4*)b1)[lane + 64 * j]; v[j] = v[j] * rstd * g + bb; if (!dry) hr[64 * j] = v[j];
                if (!dry) ((unsigned long long*)(H1B + (size_t)tok * DM))[lane + 64 * j] = (unsigned long long)pk2(v[j].x, v[j].y) | ((unsigned long long)pk2(v[j].z, v[j].w) << 32); }
            float lg[36];
#pragma unroll
            for (int o = 0; o < 36; ++o) { float a = 0.f;
#pragma unroll
                for (int j = 0; j < 4; ++j) { const f32x4 w = ((const LAS f32x4*)(WR + o * 1024))[lane + 64 * j]; a += (v[j].x * w.x + v[j].y * w.y) + (v[j].z * w.z + v[j].w * w.w); }
                lg[o] = wave_sum(a); }
            float gl[4];
#pragma unroll
            for (int o = 0; o < 4; ++o) gl[o] = lg[o] + p.in[22][o];
            float gm = gl[0]; int gs = 0;
#pragma unroll
            for (int o = 1; o < 4; ++o) if (gl[o] > gm) { gm = gl[o]; gs = o; }
            float gden = 0.f;
#pragma unroll
            for (int o = 0; o < 4; ++o) gden += __expf(gl[o] - gm);
            const float pg = 1.f / gden;
            float el[8];
#pragma unroll
            for (int o = 0; o < 8; ++o) { float x = 0.f;
#pragma unroll
                for (int g = 0; g < 4; ++g) if (g == gs) x = lg[4 + g * 8 + o] + p.in[24][g * 8 + o];
                el[o] = x; }
            float m1 = el[0]; int i1 = 0;
#pragma unroll
            for (int o = 1; o < 8; ++o) if (el[o] > m1) { m1 = el[o]; i1 = o; }
            float m2 = -INFINITY; int i2 = 0;
#pragma unroll
            for (int o = 0; o < 8; ++o) if (o != i1 && el[o] > m2) { m2 = el[o]; i2 = o; }
            const float e2 = __expf(m2 - m1); const float ga = pg / (1.f + e2), gb = pg * e2 / (1.f + e2);
            if (lane == 0 && !dry) { const int ea = gs * 8 + i1, eb = gs * 8 + i2;
                EID[tok * 2] = ea; EID[tok * 2 + 1] = eb; GATE[tok * 2] = ga; GATE[tok * 2 + 1] = gb;
                tke[tl * 2] = ea; tke[tl * 2 + 1] = eb; tks[tl * 2] = __hip_atomic_fetch_add(&lcnt[ea], 1, __ATOMIC_RELAXED, __HIP_MEMORY_SCOPE_WORKGROUP); tks[tl * 2 + 1] = __hip_atomic_fetch_add(&lcnt[eb], 1, __ATOMIC_RELAXED, __HIP_MEMORY_SCOPE_WORKGROUP); }
        }
        __syncthreads();
        if (tid < 32 && !dry) lbase[tid] = (int)__hip_atomic_fetch_add(&gcnt[tid], (unsigned)lcnt[tid], __ATOMIC_RELAXED, __HIP_MEMORY_SCOPE_AGENT);
        __syncthreads();
        if (!dry) SLOT[tile * 512 + tid] = lbase[tke[tid]] + tks[tid];
        __syncthreads();
    }
}

__device__ __forceinline__ void phase_permute(const Params& p, LAS int* tab) {
    const int tid = mk_tid(), lane = tid & 63, wave = tid >> 6;
    const int gw = blockIdx.x * NWAVES + wave, NGW = gridDim.x * NWAVES;
    const int* EID = (const int*)(p.ws + WS_EID); const int* SLOT = (const int*)(p.ws + WS_SLOT);
    const u32x4* H1B = (const u32x4*)(p.ws + WS_H1B); u32x4* XS = (u32x4*)(p.ws + WS_XS);
    for (int i = gw; i < T * 2; i += NGW) { const int tok = i >> 1; const int dst = tab[1024 + EID[i]] + SLOT[i];
        const u32x4 a = H1B[(size_t)tok * 128 + lane], b2 = H1B[(size_t)tok * 128 + 64 + lane];
        XS[(size_t)dst * 128 + lane] = a; XS[(size_t)dst * 128 + 64 + lane] = b2; }
}

__device__ __forceinline__ void phase_final(const Params& p, LAS int* tab, bool dry = false) {
    const int tid = mk_tid(), lane = tid & 63, wave = tid >> 6;
    const int gw = blockIdx.x * NWAVES + wave, NGW = gridDim.x * NWAVES;
    const int* EID = (const int*)(p.ws + WS_EID); const int* SLOT = (const int*)(p.ws + WS_SLOT); const float* GATE = (const float*)(p.ws + WS_GATE);
    const bf16_t* YS = (const bf16_t*)(p.ws + WS_XS); const float alpha = 1.189207115002721f;
    const float* g2 = p.in[28]; const float* b2 = p.in[29];
#ifdef MK_CHK
#ifndef MK_CHKSEL
#define MK_CHKSEL 7
#endif
    { const volatile unsigned* cw = (const volatile unsigned*)(p.ws + WS_CTL); const bool bad = ((MK_CHKSEL & 1) && cw[50] == 1u) || ((MK_CHKSEL & 4) && cw[50] == 2u) || ((MK_CHKSEL & 2) && cw[51] != 0u);
      if (bad && blockIdx.x == 0 && tid == 0) p.out[0] = __builtin_nanf(""); }
#endif
    for (int tok = gw; tok < T; tok += NGW) {
        const int r0 = tab[1024 + EID[tok * 2]] + SLOT[tok * 2], r1 = tab[1024 + EID[tok * 2 + 1]] + SLOT[tok * 2 + 1]; const float ga = GATE[tok * 2], gb = GATE[tok * 2 + 1];
        f32x4* hr = (f32x4*)(p.out + (size_t)tok * DM) + lane; f32x4 v[4]; float s = 0.f;
#pragma unroll
        for (int j = 0; j < 4; ++j) { const f32x4 hv = hr[64 * j];
            const unsigned long long ya = ((const unsigned long long*)(YS + (size_t)r0 * DM))[lane + 64 * j], yb = ((const unsigned long long*)(YS + (size_t)r1 * DM))[lane + 64 * j];
            const unsigned a0 = (unsigned)ya, a1 = (unsigned)(ya >> 32), c0 = (unsigned)yb, c1 = (unsigned)(yb >> 32);
            v[j].x = alpha * hv.x + ga * bflo(a0) + gb * bflo(c0); v[j].y = alpha * hv.y + ga * bfhi(a0) + gb * bfhi(c0);
            v[j].z = alpha * hv.z + ga * bflo(a1) + gb * bflo(c1); v[j].w = alpha * hv.w + ga * bfhi(a1) + gb * bfhi(c1);
            s += (v[j].x + v[j].y) + (v[j].z + v[j].w); }
        const float mean = wave_sum(s) * (1.f / DM); float s2 = 0.f;
#pragma unroll
        for (int j = 0; j < 4; ++j) { v[j] = v[j] - mean; s2 += (v[j].x * v[j].x + v[j].y * v[j].y) + (v[j].z * v[j].z + v[j].w * v[j].w); }
        const float rstd = rsqrtf(wave_sum(s2) * (1.f / DM) + 1e-5f);
#pragma unroll
        for (int j = 0; j < 4; ++j) { const f32x4 g = ((const f32x4*)g2)[lane + 64 * j], bb = ((const f32x4*)b2)[lane + 64 * j]; const f32x4 o = v[j] * rstd * g + bb; if (!dry) hr[64 * j] = o; }
    }
}


#ifdef MK_CHK
#ifndef MK_CHK_MISM
#define MK_CHK_MISM 16
#endif
#ifndef MK_CHK_ATT
#define MK_CHK_ATT 1e-3f
#endif
__device__ __forceinline__ void phase_check(const Params& p, LAS unsigned char* lds) {
    const int tid = mk_tid(), blk = blockIdx.x;
    LAS float* sc = (LAS float*)lds;
    LAS int* red = (LAS int*)(lds + 16384);
    LAS float* redf = (LAS float*)(lds + 16384 + 64);
    LAS float* ov = (LAS float*)(lds + 16384 + 128);
    const int b = blk & 15, t = ((blk >> 4) * 263 + 290 + 37 * blk) & 4095, h = (blk >> 2) & 7;
    const size_t rowb = (size_t)b * SEQ, row = rowb + t;
    const bf16_t* QI = (const bf16_t*)(p.ws + WS_QI); const bf16_t* KN = (const bf16_t*)(p.ws + WS_KN); const float* MISC = (const float*)(p.ws + WS_MISC);
    const unsigned* MASK = (const unsigned*)(p.ws + WS_MASK) + row * 128;
    unsigned* ctl = (unsigned*)(p.ws + WS_CTL);
    if (tid < 8) red[tid] = 0; if (tid < 4) redf[tid] = 0.f; if (tid < 64) ov[tid] = 0.f;
    for (int s_ = tid; s_ <= t; s_ += NTHREADS) { float acc = 0.f;
        for (int hh = 0; hh < 8; ++hh) { float d = 0.f; for (int k = 0; k < 64; ++k) d += bf2f(QI[row * 512 + hh * 64 + k]) * bf2f(KN[(rowb + s_) * 64 + k]);
            acc += (MISC[row * 80 + 64 + hh] * 0.35355339059327373f) * fmaxf(d * 0.125f, 0.f); }
        sc[s_] = acc; }
    __syncthreads();
    int mism = 0, pc = 0;
    for (int s_ = tid; s_ <= t; s_ += NTHREADS) { const float v = sc[s_]; int rank = 0;
        for (int s2 = 0; s2 <= t; ++s2) { const float v2 = sc[s2]; rank += (v2 > v || (v2 == v && s2 < s_)) ? 1 : 0; }
        const int ref = rank < 256 ? 1 : 0, got = (int)((MASK[s_ >> 5] >> (s_ & 31)) & 1u); mism += ref != got; pc += got; }
    for (int s_ = t + 1 + tid; s_ < 4096; s_ += NTHREADS) pc += 4096 * (int)((MASK[s_ >> 5] >> (s_ & 31)) & 1u);
    __hip_atomic_fetch_add(&red[0], mism, __ATOMIC_RELAXED, __HIP_MEMORY_SCOPE_WORKGROUP); __hip_atomic_fetch_add(&red[1], pc, __ATOMIC_RELAXED, __HIP_MEMORY_SCOPE_WORKGROUP);
    __syncthreads();
    if (tid == 0) { const int want = t + 1 < 256 ? t + 1 : 256; if (red[1] != want) ctl[50] = 2u; else if (red[0] > MK_CHK_MISM) ctl[50] = 1u; }
    const bf16_t* Q = (const bf16_t*)(p.ws + WS_Q); const bf16_t* K = (const bf16_t*)(p.ws + WS_K); const bf16_t* V = (const bf16_t*)(p.ws + WS_V); const bf16_t* YB = (const bf16_t*)(p.ws + WS_YB);
    __syncthreads();
    for (int s_ = tid; s_ <= t; s_ += NTHREADS) { float l = -INFINITY;
        if ((MASK[s_ >> 5] >> (s_ & 31)) & 1u) { float d = 0.f; for (int k = 0; k < 64; ++k) d += bf2f(Q[row * 512 + h * 64 + k]) * bf2f(K[(rowb + s_) * 512 + h * 64 + k]);
            const int dist = t - s_; int bk = dist; if (dist >= 16) { bk = 16 + (int)(log2f((float)dist * 0.0625f) * (16.f / 3.f)); bk = bk > 31 ? 31 : bk; }
            l = d + p.in[16][bk * 8 + h] * 1.4426950408889634f; }
        sc[s_] = l; }
    __syncthreads();
    float mx = -INFINITY; for (int s_ = 0; s_ <= t; ++s_) mx = fmaxf(mx, sc[s_]);
    float den = 0.f; for (int s_ = 0; s_ <= t; ++s_) den += exp2f(sc[s_] - mx);
    { const int d = tid & 63, part = tid >> 6; float o = 0.f;
      for (int s_ = part; s_ <= t; s_ += 8) { const float l = sc[s_]; if (l > -INFINITY) o += exp2f(l - mx) * bf2f(V[(rowb + s_) * 512 + h * 64 + d]); }
      __hip_atomic_fetch_add(&ov[d], o / den, __ATOMIC_RELAXED, __HIP_MEMORY_SCOPE_WORKGROUP); }
    __syncthreads();
    if (tid < 64) { const float ref = ov[tid], got = bf2f(YB[row * 512 + h * 64 + tid]); const float df = ref - got;
        __hip_atomic_fetch_add(&redf[0], df * df, __ATOMIC_RELAXED, __HIP_MEMORY_SCOPE_WORKGROUP); __hip_atomic_fetch_add(&redf[1], ref * ref, __ATOMIC_RELAXED, __HIP_MEMORY_SCOPE_WORKGROUP); }
    __syncthreads();
    if (tid == 0) { if (!(redf[0] <= MK_CHK_ATT * redf[1] + 1e-12f)) ctl[51] = 1u; }
    __syncthreads();
}
#endif
constexpr int NPHASE = 14;
template <int PH> __device__ __forceinline__ void run_phase(const Params& p, unsigned char* lds_g) {
    LAS unsigned char* lds = (LAS unsigned char*)lds_g;
    const int G = gridDim.x, c = blockIdx.x;
    if constexpr (PH == 0) phase_prologue(p, lds);
    if constexpr (PH == 1) { Gemm g{(const bf16_t*)((char*)p.out + DO_XBF), (const bf16_t*)(p.ws + WS_WTIN), T, 6144, 1024}; pg8::StaticOrder S; S.init(T, 6144, G, c);
        EpiIn E{p.ws}; pg8::gemm_phase<EpiIn, pg8::StaticOrder, true, true>(lds, g, S, E); }
    if constexpr (PH == 2) phase_prep(p);
    if constexpr (PH == 3) { Gemm g{(const bf16_t*)(p.ws + WS_AP), (const bf16_t*)(p.ws + WS_WTLORA), T, 1536, 256}; pg8::StaticOrder S; S.init(T, 1536, G, c);
        EpiLora E{(char*)p.out}; pg8::gemm_phase<EpiLora, pg8::StaticOrder, true, true>(lds, g, S, E); }
    if constexpr (PH == 4) {
        for (int bh = c; bh < 128; bh += G) scan_item(p, lds, bh);
        LAS unsigned* qs = (LAS unsigned*)(lds + LDS_TOTAL - 32);
        for (int qi = 0; qi < 8; ++qi) { const int xq = (c + qi) & 7; unsigned* qctr = (unsigned*)(p.ws + WS_CTL) + 40 + xq;
            for (;;) { __syncthreads(); if (mk_tid() == 0) qs[0] = __hip_atomic_fetch_add(qctr, 1u, __ATOMIC_RELAXED, __HIP_MEMORY_SCOPE_AGENT); __syncthreads();
                const unsigned u = qs[0]; if (u >= 512u) break; indexer_unit(p, lds, 2 * xq + (int)(u & 1u), 255 - (int)(u >> 1)); } }
    }
    if constexpr (PH == 6) {
        LAS float* bd = (LAS float*)(lds + attn_body::LDS_BIAS);
        for (int i = mk_tid(); i < 8 * 128; i += NTHREADS) { const int h = i >> 7, d = i & 127; int bk = d;
            if (d >= 16) { bk = 16 + (int)(log2f((float)d * 0.0625f) * (16.f / 3.f)); bk = bk > 31 ? 31 : bk; }
            bd[i] = (p.in[16][bk * 8 + h] - p.in[16][31 * 8 + h]) * 1.4426950408889634f; }
        __syncthreads();
        for (int v = c; v < 256; v += G) { const int bh = v >> 1, od = v & 1;
            for (int i = 0; i < 8; ++i) { const int pr = 2 * (i >> 1) + od; const int qb = (i & 1) ? 15 - pr : pr;
                attn_body::attn_unit<8>(bh >> 3, bh & 7, qb, (const attn_body::bf16*)(p.ws + WS_Q), (const attn_body::bf16*)(p.ws + WS_K), (const attn_body::bf16*)(p.ws + WS_V),
                                        (attn_body::bf16*)(p.ws + WS_YB), (const unsigned long long*)(p.ws + WS_MASK), (char*)lds_g); } }
    }
    if constexpr (PH == 7) { Gemm g{(const bf16_t*)((char*)p.out + DO_YA), (const bf16_t*)(p.ws + WS_WTA), T, 1024, 512}; pg8::StaticOrder S; S.init(T, 1024, G, c);
        EpiGateMul E{(const bf16_t*)(p.ws + WS_SGA), (bf16_t*)(p.ws + WS_SGA), 0}; pg8::gemm_phase<EpiGateMul, pg8::StaticOrder, true, true>(lds, g, S, E); }
    if constexpr (PH == 8) { Gemm g{(const bf16_t*)(p.ws + WS_YB), (const bf16_t*)(p.ws + WS_WTB), T, 1024, 512}; pg8::StaticOrder S; S.init(T, 1024, G, c);
        EpiGateMul E{(const bf16_t*)(p.ws + WS_SGB), (bf16_t*)(p.ws + WS_SGA), 1}; pg8::gemm_phase<EpiGateMul, pg8::StaticOrder, true, true>(lds, g, S, E); }
    if constexpr (PH == 9) { Gemm g{(const bf16_t*)(p.ws + WS_SGA), (const bf16_t*)(p.ws + WS_WTOUT), T, 1024, 1024}; pg8::StaticOrder S; S.init(T, 1024, G, c);
        EpiResid E{p.in[0], p.out, 1.189207115002721f}; pg8::gemm_phase<EpiResid, pg8::StaticOrder, true, true>(lds, g, S, E); }
    if constexpr (PH == 10) phase_ln_router(p, lds);
    if constexpr (PH == 11) { LAS int* tab = (LAS int*)(lds + LDS_TAB); moe_tables(p, tab); phase_permute(p, tab); }
    if constexpr (PH == 12) { LAS int* tab = (LAS int*)(lds + LDS_TAB); moe_tables(p, tab);
        { Gemm g{(const bf16_t*)(p.ws + WS_XS), (const bf16_t*)(p.ws + WS_WTGU), NROWS_PAD, 32 * 1024, 1024}; MoeOrder S{tab, G, c};
          EpiSwiglu E{(bf16_t*)(p.ws + WS_ACT)}; pg8::gemm_phase<EpiSwiglu, MoeOrder, true, true>(lds, g, S, E); } }
    if constexpr (PH == 13) { LAS int* tab = (LAS int*)(lds + LDS_TAB); moe_tables(p, tab);
        { Gemm g{(const bf16_t*)(p.ws + WS_ACT), (const bf16_t*)(p.ws + WS_WTDN), NROWS_PAD, 32 * 1024, 512}; MoeOrder S{tab, G, c};
          EpiDown E{(bf16_t*)(p.ws + WS_XS)}; pg8::gemm_phase<EpiDown, MoeOrder, true, true>(lds, g, S, E); } }
    if constexpr (PH == 14) { LAS int* tab = (LAS int*)(lds + LDS_TAB); moe_tables(p, tab); phase_final(p, tab); }
}

template <int PH> __global__ void __launch_bounds__(NTHREADS, 2) k_phase(Params p) {
    extern __shared__ __attribute__((aligned(16))) unsigned char lds[];
    run_phase<PH>(p, lds);
}
__global__ void __launch_bounds__(NTHREADS, 2) k_all(Params p) {
    extern __shared__ __attribute__((aligned(16))) unsigned char lds[];
    cooperative_groups::grid_group grid = cooperative_groups::this_grid();
    unsigned* barw = (unsigned*)(p.ws + WS_CTL) + 16384;
    volatile LAS unsigned* bst = (volatile LAS unsigned*)((LAS unsigned char*)lds + LDS_TOTAL - 16);
    if (mk_tid() < 2) bst[mk_tid()] = 0u;
    if (blockIdx.x == 0) for (int i = mk_tid(); i < XCD_BAR_WORDS; i += NTHREADS) barw[i] = 0u;
    __syncthreads();
#ifndef MK_REP
#define MK_REP -1
#endif
#define MK_DRY() (((volatile unsigned*)(p.ws + WS_CTL))[62] == 0u)
#define MK_PH(n) do { run_phase<n>(p, lds); xcd_barrier(bar); if (MK_REP == (n)) { run_phase<n>(p, lds); xcd_barrier(bar); } } while (0)
    run_phase<0>(p, lds); grid.sync();
    const XcdBarrier bar = xcd_barrier_post(barw, bst);
    MK_PH(1); MK_PH(2); MK_PH(3); MK_PH(4); MK_PH(6);
#ifdef MK_CHK
    phase_check(p, (LAS unsigned char*)lds); xcd_barrier(bar);
#endif
    run_phase<7>(p, lds);
    MK_PH(8); MK_PH(9); MK_PH(10); MK_PH(11); MK_PH(12); MK_PH(13);
    if (MK_REP >= 401 && MK_REP <= 409) { if (blockIdx.x == 0 && mk_tid() < 8) __hip_atomic_store((unsigned*)(p.ws + WS_CTL) + 40 + mk_tid(), 0u, __ATOMIC_RELAXED, __HIP_MEMORY_SCOPE_AGENT); xcd_barrier(bar);
        { LAS unsigned* qs = (LAS unsigned*)((LAS unsigned char*)lds + LDS_TOTAL - 32); const int c = blockIdx.x;
          for (int qi = 0; qi < 8; ++qi) { const int xq = (c + qi) & 7; unsigned* qctr = (unsigned*)(p.ws + WS_CTL) + 40 + xq;
            for (;;) { __syncthreads(); if (mk_tid() == 0) qs[0] = __hip_atomic_fetch_add(qctr, 1u, __ATOMIC_RELAXED, __HIP_MEMORY_SCOPE_AGENT); __syncthreads();
                const unsigned u = qs[0]; if (u >= 512u) break; indexer_unit(p, (LAS unsigned char*)lds, 2 * xq + (int)(u & 1u), 255 - (int)(u >> 1), MK_REP - 401); } } }
        xcd_barrier(bar); }
    if (MK_REP == 200) { for (int i = 0; i < 20; ++i) xcd_barrier(bar); }
    run_phase<14>(p, lds);
}
}

extern "C" void kernel_launch(void* const* d_in, const int* in_sizes, int n_in, void* d_out, int out_size,
                              void* d_ws, size_t ws_size, hipStream_t stream) {
    mk::Params p{};
    for (int i = 0; i < 30; ++i) p.in[i] = (const float*)d_in[i];
    p.out = (float*)d_out; p.ws = (char*)d_ws;
    if (ws_size < mk::WS_END) { fprintf(stderr, "workspace too small: %zu\n", ws_size); return; }
    static int grid_blocks = 0;
    if (!grid_blocks) {
        int dev = 0, cus = 0, per_cu = 0;
        (void)hipGetDevice(&dev);
        (void)hipDeviceGetAttribute(&cus, hipDeviceAttributeMultiprocessorCount, dev);
        (void)hipFuncSetAttribute((const void*)mk::k_all, hipFuncAttributeMaxDynamicSharedMemorySize, mk::LDS_TOTAL);
        (void)hipOccupancyMaxActiveBlocksPerMultiprocessor(&per_cu, mk::k_all, mk::NTHREADS, mk::LDS_TOTAL);
        grid_blocks = cus * (per_cu > 1 ? 1 : per_cu);
    }
    void* args[] = {&p};
    hipError_t e = hipLaunchCooperativeKernel((void*)mk::k_all, dim3(grid_blocks), dim3(mk::NTHREADS), args, mk::LDS_TOTAL, stream);
    if (e != hipSuccess) fprintf(stderr, "cooperative launch failed: %s (grid %d)\n", hipGetErrorString(e), grid_blocks);
}
```

```cpp
#include <hip/hip_runtime.h>
#include <hip/hip_bf16.h>
#include <hip/hip_cooperative_groups.h>
#include <cstdio>
#include <cstdint>
#include <cmath>
__device__ __forceinline__ int mk_tid() { int t = threadIdx.x; asm volatile("" : "+v"(t)); return t; }
#define LAS __attribute__((address_space(3)))
#define XB_TMO      128
#define XB_XCNT(j)  (256  + 64 * (j))
#define XB_XSUB(j)  (1280 + 64 * (j))
#define XB_XGEN(j)  (2304 + 64 * (j))
#define XB_TOP      3328
#define XB_TOPGEN   3392
#define XCD_BAR_WORDS 3456
#define XB_SPIN_CAP (1u << 18)

__device__ __forceinline__ unsigned xb_ld(unsigned* p)              { return __hip_atomic_load(p, __ATOMIC_RELAXED, __HIP_MEMORY_SCOPE_AGENT); }
__device__ __forceinline__ unsigned xb_add(unsigned* p, unsigned v) { return __hip_atomic_fetch_add(p, v, __ATOMIC_RELAXED, __HIP_MEMORY_SCOPE_AGENT); }
__device__ __forceinline__ unsigned xb_xcc_id() { return (unsigned)__builtin_amdgcn_s_getreg((3 << 11) | 20) & 0xFu; }
#define XB_SPIN(cond, bar) do { unsigned _sp = 0; while (cond) { __builtin_amdgcn_s_sleep(1); \
    if ((++_sp & 255u) == 0u) { if (xb_ld(&(bar)[XB_TMO])) break; if (_sp > XB_SPIN_CAP) { atomicAdd(&(bar)[XB_TMO], 1u); break; } } } } while (0)

struct XcdBarrier {
    unsigned* bar; unsigned x;
    volatile LAS unsigned* st;
};

__device__ __forceinline__ XcdBarrier xcd_barrier_post(unsigned* bar, volatile LAS unsigned* st) {
    XcdBarrier b; b.bar = bar; b.x = xb_xcc_id(); b.st = st;
    if (mk_tid() == 0) (void)xb_add(&bar[XB_XCNT(b.x)], 1u);
    return b;
}
__device__ __forceinline__ void xcd_barrier_complete(unsigned* bar, unsigned x, unsigned& nloc, unsigned& nx) {
    const unsigned G = gridDim.x * gridDim.y * gridDim.z;
    unsigned sum, cnt, mine, sp = 0u;
    for (;;) {
        sum = 0u; cnt = 0u; mine = 0u;
#pragma unroll
        for (unsigned j = 0; j < 16; ++j) { const unsigned c = xb_ld(&bar[XB_XCNT(j)]); sum += c; cnt += (c > 0u) ? 1u : 0u; mine = (j == x) ? c : mine; }
        if (sum == G) break;
        __builtin_amdgcn_s_sleep(1);
        if ((++sp & 255u) == 0u) { if (xb_ld(&bar[XB_TMO])) break; if (sp > XB_SPIN_CAP) { atomicAdd(&bar[XB_TMO], 1u); break; } }
    }
    nloc = mine > 0u ? mine : 1u; nx = cnt > 0u ? cnt : 1u;
}

__device__ __forceinline__ void xcd_barrier(const XcdBarrier& b) {
    asm volatile("s_waitcnt vmcnt(0)" ::: "memory");
    __syncthreads();
    if (mk_tid() == 0) {
        unsigned* bar = b.bar;
        __builtin_amdgcn_s_waitcnt(0);
        unsigned nloc = b.st[0], nx = b.st[1];
        if (nloc == 0u) { xcd_barrier_complete(bar, b.x, nloc, nx); b.st[0] = nloc; b.st[1] = nx; }
        const unsigned old = xb_add(&bar[XB_XSUB(b.x)], 1u);
        const unsigned gen = old / nloc;
        if (old + 1u == (gen + 1u) * nloc) {
            __builtin_amdgcn_fence(__ATOMIC_RELEASE, "agent");
            asm volatile("s_waitcnt vmcnt(0)" ::: "memory");
            const unsigned og = xb_add(&bar[XB_TOP], 1u);
            const unsigned tg = og / nx;
            if (og + 1u == (tg + 1u) * nx) xb_add(&bar[XB_TOPGEN], 1u);
            else XB_SPIN(xb_ld(&bar[XB_TOPGEN]) == tg, bar);
            __builtin_amdgcn_fence(__ATOMIC_ACQUIRE, "agent");
            xb_add(&bar[XB_XGEN(b.x)], 1u);
            asm volatile("s_waitcnt vmcnt(0)" ::: "memory");
        } else {
            XB_SPIN(xb_ld(&bar[XB_XGEN(b.x)]) == gen, bar);
            __builtin_amdgcn_fence(__ATOMIC_ACQUIRE, "agent");
            asm volatile("s_waitcnt vmcnt(0)" ::: "memory");
        }
    }
    __syncthreads();
}

namespace pg8 {
#define PG8_LAS __attribute__((address_space(3)))
typedef unsigned short bf16_t;
typedef short bf16x8 __attribute__((ext_vector_type(8)));
typedef float f32x4 __attribute__((ext_vector_type(4)));
typedef unsigned u32x4 __attribute__((ext_vector_type(4)));
constexpr int BM = 256, BK = 64, HALF = 128, HTB = HALF * BK * 2  , STAGE_BYTES = 8 * HTB, NXCD = 8, WGM = 8;

__host__ __device__ __forceinline__ int lds_byte(int r, int c) { const int st = (r >> 4) * 2 + (c >> 5), rr = r & 15, cc = c & 31, ob = rr * 64 + cc * 2; return st * 1024 + (ob ^ (((ob >> 9) & 1) << 5)); }
__host__ __device__ __forceinline__ void stage_rc(int b, int& R, int& C) { const int st = b / 1024, sb = b % 1024, swz = sb ^ (((sb >> 9) & 1) << 5); R = (st >> 1) * 16 + swz / 64; C = (st & 1) * 32 + (swz % 64) / 2; }
__host__ __device__ __forceinline__ int perm32(int rho) { const int n = rho >> 4, i = rho & 15; return 8 * (i >> 2) + 4 * n + (i & 3); }

struct Unit { int pm, pn; };
struct Gemm { const bf16_t* A; const bf16_t* Bt; int M, N, K; };

struct StaticOrder {
    int nM, nN, nwg, G, c;
    __host__ __device__ void init(int M, int N, int G_, int c_) { nM = M / BM; nN = N / BM; nwg = nM * nN; G = G_; c = c_; }
    __host__ __device__ bool next(int i, Unit& u) const {
        const long L = (long)i * G + c; if (L >= nwg) return false;
        int wgid = (int)L; { const int q = nwg / NXCD, r = nwg % NXCD, xcd = wgid % NXCD, off = wgid / NXCD; wgid = (xcd < r ? xcd * (q + 1) : r * (q + 1) + (xcd - r) * q) + off; }
        const int nig = WGM * nN, gid = wgid / nig, fm = gid * WGM, gsz = (nM - fm) < WGM ? (nM - fm) : WGM;
        u.pm = fm + ((wgid % nig) % gsz); u.pn = (wgid % nig) / gsz; return true;
    }
    __device__ __forceinline__ void a_ready(const Unit&) const {}
    __device__ __forceinline__ void done(const Unit&) const {}
};

__device__ __forceinline__ unsigned cvt_pk_bf16(float lo, float hi) { unsigned r; asm volatile("v_cvt_pk_bf16_f32 %0, %1, %2" : "=v"(r) : "v"(lo), "v"(hi)); return r; }

template <class Epi, class Sched, bool ALIGN_EPI = false, bool SP2 = false>
__device__ __forceinline__ void gemm_phase(PG8_LAS unsigned char* lds, const Gemm g, const Sched& S, const Epi& E) {
    const int tid = mk_tid(), wid = __builtin_amdgcn_readfirstlane(tid >> 6), lane = tid & 63, wr = wid >> 2, wc = wid & 3, fr = lane & 15, fq = lane >> 4;
    const int K = g.K, nt = K / BK;
    unsigned voffA[2], voffB[2];
#pragma unroll
    for (int i = 0; i < 2; ++i) { int R, C; stage_rc(tid * 16 + i * 8192, R, C); const int Rb = Epi::PERM ? ((R & ~31) + perm32(R & 31)) : R;
        voffA[i] = (unsigned)(R * K + C) * 2u; voffB[i] = (unsigned)(Rb * K + C) * 2u; }
    const size_t kstep = (size_t)(BK * 2);
    const size_t hstep = (size_t)HALF * K * 2;
    const size_t tstep = 2 * hstep;
    const unsigned ldsw = (unsigned)wid * 1024u;
    const int aoff = lds_byte(wr * 64 + fr, fq * 8), boff = lds_byte(wc * 32 + fr, fq * 8);
#define PG8_SA(b, h) (((b) * 2 + (h)) * HTB)
#define PG8_SB(b, h) ((4 + (b) * 2 + (h)) * HTB)
#define PG8_STAGE(bufoff, gbase, voff) do { _Pragma("unroll") for (int _i = 0; _i < 2; ++_i) \
        __builtin_amdgcn_global_load_lds((const unsigned*)((const char*)(gbase) + (voff)[_i]), (PG8_LAS unsigned*)(lds + (bufoff) + ldsw + _i * 8192), 16, 0, 0); } while (0)
#define PG8_LDA(dst, b, h) do { _Pragma("unroll") for (int m = 0; m < 4; ++m) _Pragma("unroll") for (int k = 0; k < 2; ++k) dst[m][k] = *(const PG8_LAS bf16x8*)(lds + PG8_SA(b, h) + aoff + m * 2048 + k * 1024); } while (0)
#define PG8_LDB(dst, b, h) do { _Pragma("unroll") for (int n = 0; n < 2; ++n) _Pragma("unroll") for (int k = 0; k < 2; ++k) dst[n][k] = *(const PG8_LAS bf16x8*)(lds + PG8_SB(b, h) + boff + n * 2048 + k * 1024); } while (0)
#define PG8_MMA(ai, bj, At, Bt) do { __builtin_amdgcn_s_setprio(1); _Pragma("unroll") for (int m = 0; m < 4; ++m) _Pragma("unroll") for (int n = 0; n < 2; ++n) _Pragma("unroll") for (int k = 0; k < 2; ++k) \
        acc[ai][bj][m][n] = __builtin_amdgcn_mfma_f32_16x16x32_bf16(Bt[n][k], At[m][k], acc[ai][bj][m][n], 0, 0, 0); __builtin_amdgcn_s_setprio(0); } while (0)
#define PG8_WAIT_V(n) asm volatile("s_waitcnt vmcnt(" #n ")" ::: "memory")
#define PG8_WAIT_L(n) asm volatile("s_waitcnt lgkmcnt(" #n ")" ::: "memory")
#define PG8_BAR __builtin_amdgcn_s_barrier()
#define PG8_SCHED __builtin_amdgcn_sched_barrier(0)
    Unit cur, nxt; int ui = 0;
    if (!S.next(0, cur)) return;
    f32x4 acc[2][2][4][2];
#pragma unroll
    for (int a = 0; a < 2; ++a)
#pragma unroll
        for (int b = 0; b < 2; ++b)
#pragma unroll
            for (int m = 0; m < 4; ++m)
#pragma unroll
                for (int n = 0; n < 2; ++n) acc[a][b][m][n] = (f32x4){0.f, 0.f, 0.f, 0.f};
    bf16x8 At[4][2], B0[2][2], B1[2][2];
    const char* cA = (const char*)g.A + (size_t)cur.pm * tstep; const char* cB = (const char*)g.Bt + (size_t)cur.pn * tstep;
    S.a_ready(cur);
    if constexpr (SP2) {
        PG8_STAGE(PG8_SB(0, 0), cB, voffB); PG8_STAGE(PG8_SB(0, 1), cB + hstep, voffB); PG8_STAGE(PG8_SA(0, 0), cA, voffA); PG8_STAGE(PG8_SA(0, 1), cA + hstep, voffA);
        if (wr == 1) PG8_BAR;
        PG8_WAIT_V(2); PG8_BAR;
        PG8_STAGE(PG8_SB(1, 0), cB + kstep, voffB); PG8_STAGE(PG8_SA(1, 0), cA + kstep, voffA); PG8_STAGE(PG8_SB(1, 1), cB + hstep + kstep, voffB);
        PG8_WAIT_V(6); PG8_BAR;
    } else {
        PG8_STAGE(PG8_SB(0, 0), cB, voffB); PG8_STAGE(PG8_SA(0, 0), cA, voffA); PG8_STAGE(PG8_SB(0, 1), cB + hstep, voffB); PG8_STAGE(PG8_SA(0, 1), cA + hstep, voffA);
        if (wr == 1) PG8_BAR;
        PG8_WAIT_V(4); PG8_BAR;
        PG8_STAGE(PG8_SB(1, 0), cB + kstep, voffB); PG8_STAGE(PG8_SA(1, 0), cA + kstep, voffA); PG8_STAGE(PG8_SB(1, 1), cB + hstep + kstep, voffB);
        PG8_WAIT_V(6); PG8_BAR;
    }
    for (;;) {
        const bool has_next = S.next(ui + 1, nxt);
        const char* nA = has_next ? (const char*)g.A + (size_t)nxt.pm * tstep : cA; const char* nB = has_next ? (const char*)g.Bt + (size_t)nxt.pn * tstep : cB;
        for (int t = 0; t < nt; t += 2) {
            const bool last = (t == nt - 2);
            const char* a1 = cA + (size_t)(t + 1) * kstep;
            const char* a2 = last ? nA : cA + (size_t)(t + 2) * kstep; const char* b2 = last ? nB : cB + (size_t)(t + 2) * kstep;
            const char* a3 = a2 + kstep; const char* b3 = b2 + kstep;
            if (last && has_next) S.a_ready(nxt);
            if constexpr (SP2) {
            PG8_LDB(B0, 0, 0); PG8_LDB(B1, 0, 1); PG8_SCHED; PG8_LDA(At, 0, 0); PG8_STAGE(PG8_SA(1, 1), a1 + hstep, voffA);
            PG8_WAIT_V(8); PG8_WAIT_L(0); PG8_BAR; PG8_MMA(0, 0, At, B0); PG8_MMA(0, 1, At, B1); PG8_BAR; PG8_SCHED;
            PG8_LDA(At, 0, 1); PG8_STAGE(PG8_SB(0, 0), b2, voffB); PG8_STAGE(PG8_SB(0, 1), b2 + hstep, voffB); PG8_STAGE(PG8_SA(0, 0), a2, voffA);
            PG8_WAIT_V(8); PG8_WAIT_L(0); PG8_BAR; PG8_MMA(1, 0, At, B0); PG8_MMA(1, 1, At, B1); PG8_BAR; PG8_SCHED;
            PG8_LDB(B0, 1, 0); PG8_LDB(B1, 1, 1); PG8_SCHED; PG8_LDA(At, 1, 0); PG8_STAGE(PG8_SA(0, 1), a2 + hstep, voffA);
            PG8_WAIT_V(8); PG8_WAIT_L(0); PG8_BAR; PG8_MMA(0, 0, At, B0); PG8_MMA(0, 1, At, B1); PG8_BAR; PG8_SCHED;
            PG8_LDA(At, 1, 1); PG8_STAGE(PG8_SB(1, 0), b3, voffB); PG8_STAGE(PG8_SB(1, 1), b3 + hstep, voffB); PG8_STAGE(PG8_SA(1, 0), a3, voffA);
            PG8_WAIT_V(8); PG8_WAIT_L(0); PG8_BAR; PG8_MMA(1, 0, At, B0); PG8_MMA(1, 1, At, B1); PG8_BAR; PG8_SCHED;
            } else {
            PG8_LDB(B0, 0, 0); PG8_SCHED; PG8_LDA(At, 0, 0); PG8_STAGE(PG8_SA(1, 1), a1 + hstep, voffA);
            PG8_WAIT_L(8); PG8_BAR; PG8_WAIT_L(0); PG8_MMA(0, 0, At, B0); PG8_BAR; PG8_SCHED;
            PG8_LDB(B1, 0, 1); PG8_STAGE(PG8_SB(0, 0), b2, voffB);
            PG8_BAR; PG8_WAIT_L(0); PG8_MMA(0, 1, At, B1); PG8_BAR;
            PG8_LDA(At, 0, 1); PG8_STAGE(PG8_SA(0, 0), a2, voffA);
            PG8_BAR; PG8_WAIT_L(0); PG8_MMA(1, 0, At, B0); PG8_BAR; PG8_SCHED;
            PG8_STAGE(PG8_SB(0, 1), b2 + hstep, voffB);
            PG8_WAIT_V(6); PG8_BAR; PG8_MMA(1, 1, At, B1); PG8_BAR;
            PG8_LDB(B0, 1, 0); PG8_SCHED; PG8_LDA(At, 1, 0); PG8_STAGE(PG8_SA(0, 1), a2 + hstep, voffA);
            PG8_WAIT_L(8); PG8_BAR; PG8_WAIT_L(0); PG8_MMA(0, 0, At, B0); PG8_BAR; PG8_SCHED;
            PG8_LDB(B1, 1, 1); PG8_STAGE(PG8_SB(1, 0), b3, voffB);
            PG8_BAR; PG8_WAIT_L(0); PG8_MMA(0, 1, At, B1); PG8_BAR;
            PG8_LDA(At, 1, 1); PG8_STAGE(PG8_SA(1, 0), a3, voffA);
            PG8_BAR; PG8_WAIT_L(0); PG8_MMA(1, 0, At, B0); PG8_BAR; PG8_SCHED;
            PG8_STAGE(PG8_SB(1, 1), b3 + hstep, voffB);
            PG8_WAIT_V(6); PG8_BAR; PG8_MMA(1, 1, At, B1); PG8_BAR;
            }
        }
        if constexpr (ALIGN_EPI) { if (wr == 0) PG8_BAR; }
        if constexpr (!Epi::AFTER_DRAIN) { E(acc, cur, wr, wc, fr, fq); S.done(cur); }
        if (!has_next) break;
#pragma unroll
        for (int a = 0; a < 2; ++a)
#pragma unroll
            for (int b = 0; b < 2; ++b)
#pragma unroll
                for (int m = 0; m < 4; ++m)
#pragma unroll
                    for (int n = 0; n < 2; ++n) acc[a][b][m][n] = (f32x4){0.f, 0.f, 0.f, 0.f};
        cur = nxt; cA = nA; cB = nB; ++ui;
        if constexpr (ALIGN_EPI) { if (wr == 1) PG8_BAR; }
    }
    PG8_WAIT_V(0);
    if constexpr (!ALIGN_EPI) { if (wr == 0) PG8_BAR; }
    PG8_BAR;
    if constexpr (Epi::AFTER_DRAIN) { E.fused(acc, cur, wr, wc, fr, fq, lds, wid, lane); S.done(cur); }
#undef PG8_SA
#undef PG8_SB
#undef PG8_STAGE
#undef PG8_LDA
#undef PG8_LDB
#undef PG8_MMA
#undef PG8_WAIT_V
#undef PG8_WAIT_L
#undef PG8_BAR
#undef PG8_SCHED
}
}
namespace attn_body {
using bf16=__hip_bfloat16;
using bf16x8=__attribute__((ext_vector_type(8)))short;
using s16x4=__attribute__((ext_vector_type(4)))short;
using f32x16=__attribute__((ext_vector_type(16)))float;
using u32x4=__attribute__((ext_vector_type(4)))unsigned;
constexpr int BATCH=16,NHEAD=8,SEQ=4096,D=64,DM=NHEAD*D;
constexpr int NW=8,QBLK=32,QB=QBLK*NW,KVBLK=64,NQB=SEQ/QB;
constexpr int ATTN_PITCH=DM, ATTN_UNIT_ROWS=QB;
__device__ __forceinline__ int crow(int r,int hi){return (r&3)+8*(r>>2)+4*hi;}
#define SBAR() __builtin_amdgcn_sched_barrier(0)
__device__ __forceinline__ void biasw(f32x16&p0,f32x16&p1,int dbase,const __attribute__((address_space(3))) float*bdl){
  #pragma unroll
  for(int r=0;r<16;++r){const int pos=(r&3)+8*(r>>2);
    int d0=dbase-pos, d1=d0-32; d0=d0<0?0:(d0>127?127:d0); d1=d1<0?0:(d1>127?127:d1); p0[r]+=bdl[d0]; p1[r]+=bdl[d1]; }
}
#define MPOS(r) (((r)&3)+8*((r)>>2))
__device__ __forceinline__ float mand(float p,unsigned w,int pos){ return __builtin_bit_cast(float,__builtin_bit_cast(unsigned,p)&(unsigned)__builtin_amdgcn_sbfe((int)w,pos,1)); }

constexpr int NSLOT=3, SLOTB=8192;
constexpr int LDS_K=0, LDS_V=NSLOT*SLOTB, LDS_WS=2*NSLOT*SLOTB, LDS_OST=LDS_WS+NW*64*4, LDS_BIAS=LDS_OST+NW*4096, LDS_BYTES=LDS_BIAS+NHEAD*128*4;
constexpr float C2=0.125f*1.4426950408889634f;
__device__ __forceinline__ void glds16(const void*gsrc,unsigned lds_dst){unsigned keep;
  asm volatile("s_mov_b32 %0, m0\n\ts_mov_b32 m0, %2\n\ts_nop 0\n\tglobal_load_lds_dwordx4 %1, off\n\ts_mov_b32 m0, %0":"=&s"(keep):"v"(gsrc),"s"(lds_dst):"memory");}
__device__ __forceinline__ float max3f(float a,float b,float c){float r;asm("v_max3_f32 %0, %1, %2, %3":"=v"(r):"v"(a),"v"(b),"v"(c));return r;}
__device__ __forceinline__ float max2f(float a,float b){float r;asm("v_max_f32_e32 %0, %1, %2":"=v"(r):"v"(a),"v"(b));return r;}
__device__ __forceinline__ float fadd_s(float a,float b){float r;asm("v_add_f32_e32 %0, %1, %2":"=v"(r):"v"(a),"v"(b));return r;}
__device__ __forceinline__ float fsub_s(float a,float b){float r;asm("v_sub_f32_e32 %0, %1, %2":"=v"(r):"v"(a),"v"(b));return r;}
typedef float f32x2_t __attribute__((ext_vector_type(2))); typedef __bf16 bf16x2_t __attribute__((ext_vector_type(2)));
__device__ __forceinline__ unsigned cvtpk_s(float lo,float hi){f32x2_t v={lo,hi};bf16x2_t b=__builtin_convertvector(v,bf16x2_t);return __builtin_bit_cast(unsigned,b);}
#define WAIT_BAR(N) asm volatile("s_waitcnt vmcnt(" #N ") lgkmcnt(0)\n\ts_barrier":::"memory")

__device__ __forceinline__ void qkt(f32x16&p0,f32x16&p1,const char*Kslot,const bf16x8*qr,const f32x16&negm,int r32,int hi){
  const char*kb=Kslot+hi*1024+r32*16;
  #pragma unroll
  for(int d0=0;d0<4;++d0){
    const bf16x8 b0=*reinterpret_cast<const bf16x8*>(kb+d0*2048);
    const bf16x8 b1=*reinterpret_cast<const bf16x8*>(kb+d0*2048+512);
    if(d0==0){p0=__builtin_amdgcn_mfma_f32_32x32x16_bf16(b0,qr[0],negm,0,0,0);p1=__builtin_amdgcn_mfma_f32_32x32x16_bf16(b1,qr[0],negm,0,0,0);}
    else{p0=__builtin_amdgcn_mfma_f32_32x32x16_bf16(b0,qr[d0],p0,0,0,0);p1=__builtin_amdgcn_mfma_f32_32x32x16_bf16(b1,qr[d0],p1,0,0,0);}}
}
typedef __attribute__((address_space(3))) const char* lds_cptr;
typedef short v4i16_t __attribute__((ext_vector_type(4)));
__device__ __forceinline__ void kload8(bf16x8*kf,lds_cptr kp){
  kf[0]=*(const __attribute__((address_space(3))) bf16x8*)(kp);      kf[1]=*(const __attribute__((address_space(3))) bf16x8*)(kp+512);
  kf[2]=*(const __attribute__((address_space(3))) bf16x8*)(kp+2048); kf[3]=*(const __attribute__((address_space(3))) bf16x8*)(kp+2560);
  kf[4]=*(const __attribute__((address_space(3))) bf16x8*)(kp+4096); kf[5]=*(const __attribute__((address_space(3))) bf16x8*)(kp+4608);
  kf[6]=*(const __attribute__((address_space(3))) bf16x8*)(kp+6144); kf[7]=*(const __attribute__((address_space(3))) bf16x8*)(kp+6656);
}
__device__ __forceinline__ void kload2(bf16x8*kf,lds_cptr kp,int j){ kf[2*j]=*(const __attribute__((address_space(3))) bf16x8*)(kp+j*2048); kf[2*j+1]=*(const __attribute__((address_space(3))) bf16x8*)(kp+j*2048+512); }
__device__ __forceinline__ s16x4 vtr(lds_cptr p){ return __builtin_bit_cast(s16x4,__builtin_amdgcn_ds_read_tr16_b64_v4i16((__attribute__((address_space(3))) v4i16_t*)p)); }
__device__ __forceinline__ float rowmax(const f32x16&p0,const f32x16&p1){
  float a=max3f(p0[0],p0[1],p1[0]),b=max3f(p0[2],p0[3],p1[1]);a=max3f(a,p1[2],p1[3]);
  #pragma unroll
  for(int r=4;r<16;r+=4){a=max3f(a,p0[r],p0[r+1]);b=max3f(b,p0[r+2],p0[r+3]);a=max3f(a,p1[r],p1[r+1]);b=max3f(b,p1[r+2],p1[r+3]);}
  const float m=max2f(a,b);
  auto rr=__builtin_amdgcn_permlane32_swap(__float_as_uint(m),__float_as_uint(m),false,false);
  return max2f(__uint_as_float(rr[0]),__uint_as_float(rr[1]));
}
__device__ __forceinline__ void pv(f32x16*o,int vb,bf16x8 pa0,bf16x8 pa1,bf16x8 pa2,bf16x8 pa3){
  #pragma unroll
  for(int d0=0;d0<2;++d0){s16x4 lo[4],hi[4];
    #pragma unroll
    for(int ks=0;ks<4;++ks){
      asm volatile("ds_read_b64_tr_b16 %0,%1 offset:%c2":"=&v"(lo[ks]):"v"(vb),"i"(d0*4096+ks*1024):"memory");
      asm volatile("ds_read_b64_tr_b16 %0,%1 offset:%c2":"=&v"(hi[ks]):"v"(vb),"i"(d0*4096+ks*1024+512):"memory");}
    asm volatile("s_waitcnt lgkmcnt(0)":::"memory");SBAR();
    #define PK(k) (bf16x8){lo[k][0],lo[k][1],lo[k][2],lo[k][3],hi[k][0],hi[k][1],hi[k][2],hi[k][3]}
    o[d0]=__builtin_amdgcn_mfma_f32_32x32x16_bf16(pa0,PK(0),o[d0],0,0,0);
    o[d0]=__builtin_amdgcn_mfma_f32_32x32x16_bf16(pa1,PK(1),o[d0],0,0,0);
    o[d0]=__builtin_amdgcn_mfma_f32_32x32x16_bf16(pa2,PK(2),o[d0],0,0,0);
    o[d0]=__builtin_amdgcn_mfma_f32_32x32x16_bf16(pa3,PK(3),o[d0],0,0,0);
    #undef PK
  }
}

#ifndef ATTN_STORE16
#define ATTN_STORE16(p,v) (*(u32x4*)(p)=(v))
#endif
template<int THRL> __device__ __forceinline__ void attn_unit(int b,int h,int qb,const bf16*Q,const bf16*__restrict__ K,const bf16*__restrict__ V,bf16*O,const unsigned long long*MK,char*shm){
  const int tid=mk_tid(),lane=tid&63,r32=lane&31,hi=lane>>5; const int wid=__builtin_amdgcn_readfirstlane(tid>>6);
  const long rowbase=(long)b*SEQ; const int q0=qb*QB;
  const bf16*Qw=Q+(rowbase+q0+wid*QBLK)*DM+h*D;
  const bf16*Kh=K+rowbase*DM+h*D,*Vh=V+rowbase*DM+h*D;
  const lds_cptr shm3=(lds_cptr)shm;
  const unsigned lds0=(unsigned)(uintptr_t)shm;
  float*wsf=(float*)(shm+LDS_WS)+wid*64;
  const bf16*ksrc=Kh+(long)lane*DM+wid*8;
  const bf16*vsrc=Vh+(long)(16*(wid&3)+(lane>>2))*DM+(wid>>2)*32+(lane&3)*8;
  const unsigned kdst=lds0+LDS_K+wid*1024, vdst=lds0+LDS_V+wid*1024;
  #define DMA_K(t,slot) glds16(ksrc+(long)(t)*KVBLK*DM,(unsigned)__builtin_amdgcn_readfirstlane(kdst+(slot)))
  #define DMA_V(t,slot) glds16(vsrc+(long)(t)*KVBLK*DM,(unsigned)__builtin_amdgcn_readfirstlane(vdst+(slot)))
  const int vb0=(int)(lds0+LDS_V)+((lane>>4)&1)*32+(lane&3)*8+(4*hi+((lane&15)>>2))*64;
  const char*Kbase=shm+LDS_K; bf16x8 kf[8];
  const lds_cptr kp0=shm3+LDS_K+hi*1024+r32*16; const lds_cptr vp0=shm3+LDS_V+((lane>>4)&1)*32+(lane&3)*8+(4*hi+((lane&15)>>2))*64;
  const int NT=(q0+QB)/KVBLK;
  const int qrel=wid*QBLK+r32;
  const unsigned long long*mkp=MK+(rowbase+q0+qrel)*64;
  const __attribute__((address_space(3))) float*bdl=(const __attribute__((address_space(3))) float*)(shm3+LDS_BIAS)+h*128;
  unsigned long long mwA,mwB;
  #define MLOAD(M,t) asm volatile("global_load_dwordx2 %0, %1, off":"=&v"(M):"v"(mkp+(t)):"memory")
  #define MPIN(M) asm volatile("":"+v"(M))
  MLOAD(mwA,0);MLOAD(mwB,1);
  DMA_K(0,0);DMA_V(0,0);DMA_K(1,SLOTB);
  bf16x8 qr[4];
  #pragma unroll
  for(int d0=0;d0<4;++d0)qr[d0]=*reinterpret_cast<const bf16x8*>(&Qw[(long)r32*DM+d0*16+hi*8]);
  float mhat=0.f,l_reg=0.f;f32x16 o[2];o[0]=f32x16{};o[1]=f32x16{};const f32x16 negm=f32x16{};
  #define CMASK(P0,P1,t,M) do{ if((t)>=NT-6)biasw(P0,P1,q0+qrel-64*(t)-4*hi,bdl); }while(0)
  bool resc=false;
  #define START(P0,P1) do{ const float rm=rowmax(P0,P1); resc=false; mhat=__builtin_fmaxf(rm,0.f); \
    _Pragma("unroll") for(int r=0;r<16;++r)P0[r]=mand(__builtin_amdgcn_exp2f(P0[r]-mhat),((unsigned)mwA)>>(4*hi),MPOS(r)); }while(0)
  #define RESC() do{ if(resc){ asm volatile("s_waitcnt lgkmcnt(0)":::"memory"); \
      _Pragma("unroll") for(int d_=0;d_<2;++d_) _Pragma("unroll") for(int r=0;r<16;++r)o[d_][r]*=wsf[crow(r,hi)]; } }while(0)
  f32x16 pA0,pA1,pB0,pB1;
  int sl_prev=0,sl_cur=0,sl_next=SLOTB;
  #define ROT() do{sl_prev=sl_cur;sl_cur=sl_next;sl_next=(sl_next==(NSLOT-1)*SLOTB)?0:sl_next+SLOTB;}while(0)
  DMA_K(2,2*SLOTB);
  WAIT_BAR(3); MPIN(mwA); MPIN(mwB);
  qkt(pA0,pA1,Kbase,qr,negm,r32,hi);asm volatile("s_nop 15\n\ts_nop 7":"+v"(pA0),"+v"(pA1));CMASK(pA0,pA1,0,mwA);
  START(pA0,pA1);
  _Pragma("unroll") for(int r=0;r<16;++r)pA1[r]=mand(__builtin_amdgcn_exp2f(pA1[r]-mhat),((unsigned)(mwA>>32))>>(4*hi),MPOS(r));
  WAIT_BAR(0);
  DMA_K(3,0);DMA_V(1,SLOTB);
  ROT();
  kload8(kf,kp0+sl_cur);
  WAIT_BAR(2);
  s16x4 vlo[8],vhi[8]; u32x4 pw0,pw1,pw2,pw3;
  #define PKW(P,B) cvtpk_s(P[B],P[B+1])
  #define PAF(k) __builtin_bit_cast(bf16x8,pw##k)
  #define VFR(i) (bf16x8){vlo[i][0],vlo[i][1],vlo[i][2],vlo[i][3],vhi[i][0],vhi[i][1],vhi[i][2],vhi[i][3]}
  #define PIN(x) asm volatile("":"+v"(x))
  #define MX3(a,b,c) __builtin_fmaxf(__builtin_fmaxf((a),(b)),(c))
  #define GAPA(MF,A0,A1,A2,A3,W0,W1,PW) do{ MF; sacc+=A0; sacc+=A1; sacc+=A2; sacc+=A3; PIN(sacc); W0; W1; PIN(PW); SBAR(); }while(0)
  #define EX(v) __builtin_amdgcn_exp2f(v)
  #define GAPB(MF,X,B,W) do{ MF; X[B]=mand(EX(X[B]-mhat),W,MPOS(B)); X[B+1]=mand(EX(X[B+1]-mhat),W,MPOS(B+1)); X[B+2]=mand(EX(X[B+2]-mhat),W,MPOS(B+2)); X[B+3]=mand(EX(X[B+3]-mhat),W,MPOS(B+3)); PIN(X); SBAR(); }while(0)
  #define VRD(i) do{ vlo[i]=vtr(vp_+(((i)>>2)*4096+((i)&3)*1024)); vhi[i]=vtr(vp_+(((i)>>2)*4096+((i)&3)*1024+512)); }while(0)
  #define KRD(G,j) do{ if(G){ kload2(kf,kp0+sl_next,j); SBAR(); } }while(0)
  #define STEP(C0,C1,P0,P1,t,GK,GV,GL,MC,MN) do{ SBAR(); if(GV){MLOAD(MN,(t)+1);} \
    const lds_cptr vp_=vp0+sl_prev; \
    VRD(0); SBAR(); float sacc=(P0[0]+P0[1]); \
    GAPA(C0=__builtin_amdgcn_mfma_f32_32x32x16_bf16(kf[0],qr[0],negm,0,0,0), P0[2],P0[3],P0[4],P0[5],     pw0[0]=PKW(P0,0), pw0[1]=PKW(P0,2), pw0); \
    VRD(4); SBAR(); GAPA(C1=__builtin_amdgcn_mfma_f32_32x32x16_bf16(kf[1],qr[0],negm,0,0,0), P0[6],P0[7],P0[8],P0[9],     pw0[2]=PKW(P0,4), pw0[3]=PKW(P0,6), pw0); \
    VRD(1); SBAR(); GAPA(C0=__builtin_amdgcn_mfma_f32_32x32x16_bf16(kf[2],qr[1],C0,0,0,0),   P0[10],P0[11],P0[12],P0[13], pw1[0]=PKW(P0,8), pw1[1]=PKW(P0,10), pw1); \
    VRD(5); SBAR(); GAPA(C1=__builtin_amdgcn_mfma_f32_32x32x16_bf16(kf[3],qr[1],C1,0,0,0),   P0[14],P0[15],P1[0],P1[1],   pw1[2]=PKW(P0,12),pw1[3]=PKW(P0,14), pw1); \
    VRD(2); SBAR(); GAPA(C0=__builtin_amdgcn_mfma_f32_32x32x16_bf16(kf[4],qr[2],C0,0,0,0),   P1[2],P1[3],P1[4],P1[5],     pw2[0]=PKW(P1,0), pw2[1]=PKW(P1,2), pw2); \
    VRD(6); SBAR(); GAPA(C1=__builtin_amdgcn_mfma_f32_32x32x16_bf16(kf[5],qr[2],C1,0,0,0),   P1[6],P1[7],P1[8],P1[9],     pw2[2]=PKW(P1,4), pw2[3]=PKW(P1,6), pw2); \
    VRD(3); SBAR(); GAPA(C0=__builtin_amdgcn_mfma_f32_32x32x16_bf16(kf[6],qr[3],C0,0,0,0),   P1[10],P1[11],P1[12],P1[13], pw3[0]=PKW(P1,8), pw3[1]=PKW(P1,10), pw3); \
    VRD(7); SBAR(); GAPA(C1=__builtin_amdgcn_mfma_f32_32x32x16_bf16(kf[7],qr[3],C1,0,0,0),   P1[14],P1[15],0.f,0.f,       pw3[2]=PKW(P1,12),pw3[3]=PKW(P1,14), pw3); \
    l_reg+=sacc; \
    if(GK){DMA_K((t)+3,sl_cur);} if(GV){DMA_V((t)+1,sl_next);} \
    CMASK(C0,C1,t,MC); const unsigned mlo_=((unsigned)(MC))>>(4*hi), mhi_=((unsigned)((MC)>>32))>>(4*hi); \
    { float a=MX3(C0[0],C0[1],C1[0]),b=MX3(C0[2],C0[3],C1[1]); a=MX3(a,C1[2],C1[3]); \
      _Pragma("unroll") for(int r=4;r<16;r+=4){a=MX3(a,C0[r],C0[r+1]);b=MX3(b,C0[r+2],C0[r+3]);a=MX3(a,C1[r],C1[r+1]);b=MX3(b,C1[r+2],C1[r+3]);} \
      float rm=__builtin_fmaxf(a,b); { auto rr=__builtin_amdgcn_permlane32_swap(__float_as_uint(rm),__float_as_uint(rm),false,false); rm=__builtin_fmaxf(__uint_as_float(rr[0]),__uint_as_float(rr[1])); } \
      resc=false; const float rd=rm-mhat; \
      if(__builtin_expect(__any(rd>(float)THRL),0)){ const float dl=__builtin_fmaxf(rd,0.f); mhat+=dl; \
        const float f=__builtin_amdgcn_exp2f(-dl); l_reg*=f; if(hi==0)wsf[r32]=f; resc=true; } } \
    SBAR(); \
    GAPB(o[0]=__builtin_amdgcn_mfma_f32_32x32x16_bf16(PAF(0),VFR(0),o[0],0,0,0), C0,0,mlo_); \
    GAPB(o[1]=__builtin_amdgcn_mfma_f32_32x32x16_bf16(PAF(0),VFR(4),o[1],0,0,0), C0,4,mlo_); \
    KRD(GL,0); GAPB(o[0]=__builtin_amdgcn_mfma_f32_32x32x16_bf16(PAF(1),VFR(1),o[0],0,0,0), C0,8,mlo_); \
    KRD(GL,1); GAPB(o[1]=__builtin_amdgcn_mfma_f32_32x32x16_bf16(PAF(1),VFR(5),o[1],0,0,0), C0,12,mlo_); \
    KRD(GL,2); GAPB(o[0]=__builtin_amdgcn_mfma_f32_32x32x16_bf16(PAF(2),VFR(2),o[0],0,0,0), C1,0,mhi_); \
    KRD(GL,3); GAPB(o[1]=__builtin_amdgcn_mfma_f32_32x32x16_bf16(PAF(2),VFR(6),o[1],0,0,0), C1,4,mhi_); \
    GAPB(o[0]=__builtin_amdgcn_mfma_f32_32x32x16_bf16(PAF(3),VFR(3),o[0],0,0,0), C1,8,mhi_); \
    GAPB(o[1]=__builtin_amdgcn_mfma_f32_32x32x16_bf16(PAF(3),VFR(7),o[1],0,0,0), C1,12,mhi_); \
    }while(0)
  int t=1;
  #undef CMASK
  #define CMASK(P0,P1,t,M) do{}while(0)
  for(;t+7<NT;t+=2){
    STEP(pB0,pB1,pA0,pA1,t,true,true,true,mwB,mwA);     WAIT_BAR(2); MPIN(mwA); RESC(); ROT();
    STEP(pA0,pA1,pB0,pB1,t+1,true,true,true,mwA,mwB);   WAIT_BAR(2); MPIN(mwB); RESC(); ROT();
  }
  #undef CMASK
  #define CMASK(P0,P1,t,M) do{ if((t)>=NT-6)biasw(P0,P1,q0+qrel-64*(t)-4*hi,bdl); }while(0)
  #define ENDW(tt) do{ if((tt)+3<NT){WAIT_BAR(2);} else if((tt)+2<NT){WAIT_BAR(1);} else {WAIT_BAR(0);} }while(0)
  for(;t+1<NT;t+=2){
    STEP(pB0,pB1,pA0,pA1,t,(t+3<NT),(t+1<NT),(t+1<NT),mwB,mwA);       ENDW(t);   MPIN(mwA); RESC(); ROT();
    STEP(pA0,pA1,pB0,pB1,t+1,(t+4<NT),(t+2<NT),(t+2<NT),mwA,mwB);     ENDW(t+1); MPIN(mwB); RESC(); ROT();
  }
  STEP(pB0,pB1,pA0,pA1,NT-1,false,false,false,mwB,mwA); RESC();
  { float sacc=pB0[0]+pB0[1]; _Pragma("unroll") for(int r=2;r<16;++r)sacc+=pB0[r]; _Pragma("unroll") for(int r=0;r<16;++r)sacc+=pB1[r]; l_reg+=sacc;
    pw0=(u32x4){PKW(pB0,0),PKW(pB0,2),PKW(pB0,4),PKW(pB0,6)};pw1=(u32x4){PKW(pB0,8),PKW(pB0,10),PKW(pB0,12),PKW(pB0,14)};pw2=(u32x4){PKW(pB1,0),PKW(pB1,2),PKW(pB1,4),PKW(pB1,6)};pw3=(u32x4){PKW(pB1,8),PKW(pB1,10),PKW(pB1,12),PKW(pB1,14)};
    SBAR(); pv(o,vb0+sl_cur,PAF(0),PAF(1),PAF(2),PAF(3)); }
  #undef PKW
  #undef PAF
  #undef VFR
  #undef PIN
  #undef MX3
  #undef GAPA
  #undef GAPB
  #undef EX
  #undef VRD
  #undef KRD
  #undef STEP
  #undef ENDW
  {auto rr=__builtin_amdgcn_permlane32_swap(__float_as_uint(l_reg),__float_as_uint(l_reg),false,false);l_reg=__uint_as_float(rr[0])+__uint_as_float(rr[1]);}
  if(hi==0)wsf[32+r32]=l_reg;asm volatile("s_waitcnt lgkmcnt(0)":::"memory");
  float rli[16];
  #pragma unroll
  for(int r=0;r<16;++r)rli[r]=__builtin_amdgcn_rcpf(wsf[32+crow(r,hi)]);
  bf16*Ow=O+(rowbase+q0+wid*QBLK)*DM+h*D;
  { bf16*stg=(bf16*)(shm+LDS_OST)+wid*2048;
    #pragma unroll
    for(int r=0;r<16;++r){const int orow=crow(r,hi);
      #pragma unroll
      for(int d0=0;d0<2;++d0)stg[orow*64+d0*32+r32]=__float2bfloat16(o[d0][r]*rli[r]);}
    asm volatile("s_waitcnt lgkmcnt(0)":::"memory");
    #pragma unroll
    for(int i=0;i<4;++i){const int row=i*8+(lane>>3),ch=lane&7; const u32x4 v=*(const u32x4*)(stg+row*64+ch*8); ATTN_STORE16(Ow+(long)row*DM+ch*8,v);} }
  asm volatile("s_waitcnt lgkmcnt(0)\n\ts_barrier":::"memory");
  #undef DMA_K
  #undef MLOAD
  #undef MPIN
  #undef DMA_V
  #undef CMASK
  #undef START
  #undef RESC
  #undef ROT
}
constexpr int ATTN_LDS_BYTES=LDS_BYTES;
#undef SBAR
#undef WAIT_BAR
}
namespace mk {
using pg8::bf16_t; using pg8::f32x4; using pg8::u32x4; using pg8::bf16x8; using pg8::Unit; using pg8::Gemm;
constexpr int T = 65536, SEQ = 4096, NBATCH = 16, DM = 1024;
constexpr int NTHREADS = 512, NWAVES = 8;
constexpr size_t MiB = 1u << 20;
constexpr size_t WS_CTL = 0;
constexpr size_t WS_EID = 1 * MiB, WS_GATE = 2 * MiB, WS_SLOT = 3 * MiB;
constexpr size_t WS_WTIN = 4 * MiB;
constexpr size_t WS_WTA = 16 * MiB, WS_WTB = 17 * MiB, WS_WTOUT = 18 * MiB, WS_WTLORA = 20 * MiB;
constexpr size_t WS_WTGU = 21 * MiB;
constexpr size_t WS_WTDN = 85 * MiB;
constexpr size_t WS_KN = 117 * MiB;
constexpr size_t WS_MISC = 125 * MiB;
constexpr size_t WS_AP = 145 * MiB;
constexpr size_t WS_MASK = 177 * MiB;
constexpr size_t WS_YB = 209 * MiB;
constexpr size_t WS_RW = 273 * MiB;
constexpr size_t WS_Q = 497 * MiB, WS_K = 561 * MiB, WS_V = 625 * MiB, WS_QI = 689 * MiB;
constexpr size_t WS_SGA = 753 * MiB, WS_SGB = 881 * MiB;
constexpr size_t WS_END = 1009 * MiB;
constexpr size_t WS_H1B = WS_RW;
constexpr size_t WS_MA = WS_Q;
constexpr size_t WS_XS = WS_Q;
constexpr size_t WS_ACT = 769 * MiB;
constexpr int NROWS_PAD = 131072 + 32 * 256;
static_assert(WS_XS + (size_t)NROWS_PAD * 2048 <= WS_ACT && WS_ACT + (size_t)NROWS_PAD * 1024 <= WS_END, "overlay map");
constexpr size_t DO_XBF = 0;
constexpr size_t DO_OMW = 0, DO_ASIG = 64 * MiB, DO_G = 128 * MiB, DO_YA = 192 * MiB;

constexpr int LDS_TOTAL = 155648;
constexpr int LDS_TAB = 131072;

struct Params { const float* in[30]; float* out; char* ws; };

__device__ __forceinline__ float xrow_sum(float x) {
    float a = x, b = x; asm volatile("s_nop 1\n\tv_permlane16_swap_b32 %0, %1" : "+v"(a), "+v"(b)); x = a + b;
    a = x; b = x; asm volatile("s_nop 1\n\tv_permlane32_swap_b32 %0, %1" : "+v"(a), "+v"(b)); return a + b;
}
__device__ __forceinline__ float wave_sum(float x) {
    x += __builtin_bit_cast(float, __builtin_amdgcn_mov_dpp(__builtin_bit_cast(int, x), 0xB1, 0xF, 0xF, true));
    x += __builtin_bit_cast(float, __builtin_amdgcn_mov_dpp(__builtin_bit_cast(int, x), 0x4E, 0xF, 0xF, true));
    x += __builtin_bit_cast(float, __builtin_amdgcn_mov_dpp(__builtin_bit_cast(int, x), 0x141, 0xF, 0xF, true));
    x += __builtin_bit_cast(float, __builtin_amdgcn_mov_dpp(__builtin_bit_cast(int, x), 0x140, 0xF, 0xF, true));
    return xrow_sum(x);
}
__device__ __forceinline__ unsigned f2bf(float f) { unsigned u = __builtin_bit_cast(unsigned, f); return (u + 0x7fffu + ((u >> 16) & 1u)) >> 16; }
__device__ __forceinline__ unsigned pk2(float lo, float hi) { return f2bf(lo) | (f2bf(hi) << 16); }
__device__ __forceinline__ float bf2f(bf16_t v) { return __builtin_bit_cast(float, (unsigned)v << 16); }
__device__ __forceinline__ float bflo(unsigned w) { return __builtin_bit_cast(float, w << 16); }
__device__ __forceinline__ float bfhi(unsigned w) { return __builtin_bit_cast(float, w & 0xffff0000u); }
__device__ __forceinline__ float sigmoidf_(float x) { return __builtin_amdgcn_rcpf(1.f + __expf(-x)); }

template <class Src>
__device__ __forceinline__ void transpose_item(const Src& S, int K, bf16_t* dst, LAS float* scr, int k0, int n0, int lane) {
#pragma unroll 8
    for (int i = 0; i < 32; ++i) { const int kk = 2 * i + (lane >> 5); scr[kk * 33 + (lane & 31)] = S(k0 + kk, n0 + (lane & 31)); }
    asm volatile("s_waitcnt lgkmcnt(0)" ::: "memory");
    const int c = lane & 7;
#pragma unroll
    for (int j = 0; j < 4; ++j) { const int n = (lane >> 3) + 8 * j; const LAS float* s = scr + (8 * c) * 33 + n;
        u32x4 o; o.x = pk2(s[0 * 33], s[1 * 33]); o.y = pk2(s[2 * 33], s[3 * 33]); o.z = pk2(s[4 * 33], s[5 * 33]); o.w = pk2(s[6 * 33], s[7 * 33]);
        *(u32x4*)(dst + (size_t)(n0 + n) * K + k0 + 8 * c) = o; }
    asm volatile("s_waitcnt lgkmcnt(0)" ::: "memory");
}
struct SrcWin { const float* w; __device__ __forceinline__ float operator()(int k, int n) const {
    int c; if (n < 3840) c = n; else if (n < 5888) c = n + 72; else if (n < 5960) c = n - 5888 + 3840; else return 0.f;
    return w[(size_t)k * 5960 + c]; } };
struct SrcPlain { const float* w; int N; __device__ __forceinline__ float operator()(int k, int n) const { return w[(size_t)k * N + n]; } };
struct SrcGU { const float* g; long ud; __device__ __forceinline__ float operator()(int k, int n) const {
    const int pn = n >> 8, c = n & 255, bj = c >> 7, wc = (c & 127) >> 5, fq = (c & 31) >> 3, nn = (c & 7) >> 2, i = c & 3;
    const int hj = 128 * pn + 64 * bj + 16 * wc + 4 * fq + i; return g[(long)k * 512 + hj + (nn ? ud : 0l)]; } };

__device__ __forceinline__ void phase_prologue(const Params& p, LAS unsigned char* lds) {
    const int tid = mk_tid(), lane = tid & 63, wave = tid >> 6;
    const int gw = blockIdx.x * NWAVES + wave, NGW = gridDim.x * NWAVES;
    LAS float* scr = (LAS float*)(lds + wave * 16384);
    char* ws = p.ws;
    if (blockIdx.x == 0 && tid < 64) ((unsigned*)(ws + WS_CTL))[tid] = 0u;
    constexpr int I_IN = 16 * 192, I_A = 8 * 32, I_B = 8 * 32, I_O = 16 * 32, I_GU = 32 * 16 * 32, I_DN = 32 * 8 * 32;
    constexpr int NITEMS = I_IN + I_A + I_B + I_O + I_GU + I_DN;
    for (int it = gw; it < NITEMS; it += NGW) {
        int r = it;
        if (r < I_IN) { SrcWin S{p.in[1]}; transpose_item(S, 1024, (bf16_t*)(ws + WS_WTIN), scr, (r / 192) * 64, (r % 192) * 32, lane); continue; } r -= I_IN;
        if (r < I_A) { SrcPlain S{p.in[13], 1024}; transpose_item(S, 512, (bf16_t*)(ws + WS_WTA), scr, (r / 32) * 64, (r % 32) * 32, lane); continue; } r -= I_A;
        if (r < I_B) { SrcPlain S{p.in[17], 1024}; transpose_item(S, 512, (bf16_t*)(ws + WS_WTB), scr, (r / 32) * 64, (r % 32) * 32, lane); continue; } r -= I_B;
        if (r < I_O) { SrcPlain S{p.in[18], 1024}; transpose_item(S, 1024, (bf16_t*)(ws + WS_WTOUT), scr, (r / 32) * 64, (r % 32) * 32, lane); continue; } r -= I_O;
        if (r < I_GU) { const int e = r / 512, q = r % 512; SrcGU S{p.in[25] + (size_t)e * 1024 * 512, (long)(p.in[26] - p.in[25])};
            transpose_item(S, 1024, (bf16_t*)(ws + WS_WTGU) + (size_t)e * 1024 * 1024, scr, (q / 32) * 64, (q % 32) * 32, lane); continue; } r -= I_GU;
        { const int e = r / 256, q = r % 256; SrcPlain S{p.in[27] + (size_t)e * 512 * 1024, 1024};
            transpose_item(S, 512, (bf16_t*)(ws + WS_WTDN) + (size_t)e * 1024 * 512, scr, (q / 32) * 64, (q % 32) * 32, lane); }
    }
    { bf16_t* wl = (bf16_t*)(ws + WS_WTLORA); const int gt = blockIdx.x * NTHREADS + tid, NGT = gridDim.x * NTHREADS;
      for (int i = gt; i < 1536 * 256; i += NGT) { const int n = i >> 8, k = i & 255; float v = 0.f;
          if (n < 512) { if (k < 64) v = p.in[4][k * 512 + n]; }
          else if (n < 1024) { if (k >= 64 && k < 128) v = p.in[6][(k - 64) * 512 + (n - 512)]; }
          else { if (k >= 128) v = p.in[7][(k - 128) * 512 + (n - 1024)]; }
          wl[i] = (bf16_t)f2bf(v); } }
    { const f32x4* x4 = (const f32x4*)p.in[0]; unsigned long long* o8 = (unsigned long long*)((char*)p.out + DO_XBF);
      const size_t gt = (size_t)blockIdx.x * NTHREADS + tid, NGT = (size_t)gridDim.x * NTHREADS;
      for (size_t i = gt; i < (size_t)T * DM / 4; i += NGT) { const f32x4 v = x4[i]; o8[i] = (unsigned long long)pk2(v.x, v.y) | ((unsigned long long)pk2(v.z, v.w) << 32); } }
}

struct EpiIn {
    static constexpr bool PERM = true, AFTER_DRAIN = false;
    char* ws;
    __device__ __forceinline__ void operator()(const f32x4 (&acc)[2][2][4][2], const Unit& u, int wr, int wc, int fr, int fq) const {
        const int pn = u.pn, row0 = u.pm * 256 + wr * 64 + fr, cl = wc * 32 + 8 * fq;
        if (pn == 23) {
            if (cl < 72) { float* dst = (float*)(ws + WS_MISC);
#pragma unroll
                for (int ai = 0; ai < 2; ++ai)
#pragma unroll
                    for (int m = 0; m < 4; ++m) { float* d = dst + (size_t)(row0 + ai * 128 + m * 16) * 80 + cl; *(f32x4*)d = acc[ai][0][m][0]; *(f32x4*)(d + 4) = acc[ai][0][m][1]; } }
            return;
        }
        bf16_t* base; int ld, colt, mode = 0;
        if (pn < 7) { base = (bf16_t*)(ws + WS_RW); ld = 1792; colt = pn * 256; }
        else if (pn < 9) { base = (bf16_t*)(ws + WS_Q); ld = 512; colt = (pn - 7) * 256; mode = 2; }
        else if (pn < 11) { base = (bf16_t*)(ws + WS_K); ld = 512; colt = (pn - 9) * 256; }
        else if (pn < 13) { base = (bf16_t*)(ws + WS_V); ld = 512; colt = (pn - 11) * 256; }
        else if (pn < 15) { base = (bf16_t*)(ws + WS_QI); ld = 512; colt = (pn - 13) * 256; }
        else if (pn < 19) { base = (bf16_t*)(ws + WS_SGA); ld = 1024; colt = (pn - 15) * 256; mode = 1; }
        else { base = (bf16_t*)(ws + WS_SGB); ld = 1024; colt = (pn - 19) * 256; mode = 1; }
#pragma unroll
        for (int ai = 0; ai < 2; ++ai)
#pragma unroll
            for (int m = 0; m < 4; ++m) { bf16_t* rowp = base + (size_t)(row0 + ai * 128 + m * 16) * ld + colt + cl;
#pragma unroll
                for (int bj = 0; bj < 2; ++bj) { f32x4 v0 = acc[ai][bj][m][0], v1 = acc[ai][bj][m][1];
                    if (mode == 1) {
#pragma unroll
                        for (int i = 0; i < 4; ++i) { v0[i] = sigmoidf_(v0[i]); v1[i] = sigmoidf_(v1[i]); } }
                    else if (mode == 2) { v0 = v0 * attn_body::C2; v1 = v1 * attn_body::C2; }
                    u32x4 w; w.x = pk2(v0[0], v0[1]); w.y = pk2(v0[2], v0[3]); w.z = pk2(v1[0], v1[1]); w.w = pk2(v1[2], v1[3]);
                    *(u32x4*)(rowp + bj * 128) = w; } }
    }
};
struct EpiLora {
    static constexpr bool PERM = true, AFTER_DRAIN = false;
    char* dout;
    __device__ __forceinline__ void operator()(const f32x4 (&acc)[2][2][4][2], const Unit& u, int wr, int wc, int fr, int fq) const {
        const int pn = u.pn, seg = pn >> 1, row0 = u.pm * 256 + wr * 64 + fr, col0 = (pn & 1) * 256 + wc * 32 + 8 * fq;
        bf16_t* base = (bf16_t*)(dout + (size_t)seg * (64 * MiB));
#pragma unroll
        for (int ai = 0; ai < 2; ++ai)
#pragma unroll
            for (int m = 0; m < 4; ++m)
#pragma unroll
                for (int bj = 0; bj < 2; ++bj) { const f32x4 v0 = acc[ai][bj][m][0], v1 = acc[ai][bj][m][1]; u32x4 w;
                    w.x = pk2(v0[0], v0[1]); w.y = pk2(v0[2], v0[3]); w.z = pk2(v1[0], v1[1]); w.w = pk2(v1[2], v1[3]);
                    *(u32x4*)(base + (size_t)(row0 + ai * 128 + m * 16) * 512 + col0 + bj * 128) = w; }
    }
};
struct EpiGateMul {
    static constexpr bool PERM = true, AFTER_DRAIN = false;
    const bf16_t* gate; bf16_t* dst; const bf16_t* addsrc;
    __device__ __forceinline__ void operator()(const f32x4 (&acc)[2][2][4][2], const Unit& u, int wr, int wc, int fr, int fq) const {
        const int row0 = u.pm * 256 + wr * 64 + fr, col0 = u.pn * 256 + wc * 32 + 8 * fq;
#pragma unroll
        for (int ai = 0; ai < 2; ++ai)
#pragma unroll
            for (int m = 0; m < 4; ++m)
#pragma unroll
                for (int bj = 0; bj < 2; ++bj) { const size_t off = (size_t)(row0 + ai * 128 + m * 16) * 1024 + col0 + bj * 128;
                    const u32x4 g = *(const u32x4*)(gate + off); u32x4 d = {0u, 0u, 0u, 0u}; if (addsrc) d = *(const u32x4*)(addsrc + off);
                    const f32x4 v0 = acc[ai][bj][m][0], v1 = acc[ai][bj][m][1]; u32x4 w;
                    w.x = pk2(bflo(d.x) + bflo(g.x) * v0[0], bfhi(d.x) + bfhi(g.x) * v0[1]); w.y = pk2(bflo(d.y) + bflo(g.y) * v0[2], bfhi(d.y) + bfhi(g.y) * v0[3]);
                    w.z = pk2(bflo(d.z) + bflo(g.z) * v1[0], bfhi(d.z) + bfhi(g.z) * v1[1]); w.w = pk2(bflo(d.w) + bflo(g.w) * v1[2], bfhi(d.w) + bfhi(g.w) * v1[3]);
                    *(u32x4*)(dst + off) = w; }
    }
};
struct EpiResid {
    static constexpr bool PERM = true, AFTER_DRAIN = false;
    const float* x; float* out; float alpha;
    __device__ __forceinline__ void operator()(const f32x4 (&acc)[2][2][4][2], const Unit& u, int wr, int wc, int fr, int fq) const {
        const int row0 = u.pm * 256 + wr * 64 + fr, col0 = u.pn * 256 + wc * 32 + 8 * fq;
#pragma unroll
        for (int ai = 0; ai < 2; ++ai)
#pragma unroll
            for (int m = 0; m < 4; ++m)
#pragma unroll
                for (int bj = 0; bj < 2; ++bj) { const size_t off = (size_t)(row0 + ai * 128 + m * 16) * 1024 + col0 + bj * 128;
                    const f32x4 x0 = *(const f32x4*)(x + off), x1 = *(const f32x4*)(x + off + 4);
                    *(f32x4*)(out + off) = x0 * alpha + acc[ai][bj][m][0]; *(f32x4*)(out + off + 4) = x1 * alpha + acc[ai][bj][m][1]; }
    }
};
struct EpiSwiglu {
    static constexpr bool PERM = true, AFTER_DRAIN = false;
    bf16_t* act;
    __device__ __forceinline__ void operator()(const f32x4 (&acc)[2][2][4][2], const Unit& u, int wr, int wc, int fr, int fq) const {
        const int row0 = u.pm * 256 + wr * 64 + fr, col0 = (u.pn & 3) * 128 + 16 * wc + 4 * fq;
#pragma unroll
        for (int ai = 0; ai < 2; ++ai)
#pragma unroll
            for (int m = 0; m < 4; ++m)
#pragma unroll
                for (int bj = 0; bj < 2; ++bj) { const f32x4 g = acc[ai][bj][m][0], up = acc[ai][bj][m][1]; float a[4];
#pragma unroll
                    for (int i = 0; i < 4; ++i) a[i] = g[i] * sigmoidf_(g[i]) * up[i];
                    *(unsigned long long*)(act + (size_t)(row0 + ai * 128 + m * 16) * 512 + col0 + bj * 64) = (unsigned long long)pk2(a[0], a[1]) | ((unsigned long long)pk2(a[2], a[3]) << 32); }
    }
};
struct EpiDown {
    static constexpr bool PERM = true, AFTER_DRAIN = false;
    bf16_t* ys;
    __device__ __forceinline__ void operator()(const f32x4 (&acc)[2][2][4][2], const Unit& u, int wr, int wc, int fr, int fq) const {
        const int row0 = u.pm * 256 + wr * 64 + fr, col0 = (u.pn & 3) * 256 + wc * 32 + 8 * fq;
#pragma unroll
        for (int ai = 0; ai < 2; ++ai)
#pragma unroll
            for (int m = 0; m < 4; ++m)
#pragma unroll
                for (int bj = 0; bj < 2; ++bj) { const f32x4 v0 = acc[ai][bj][m][0], v1 = acc[ai][bj][m][1]; u32x4 w;
                    w.x = pk2(v0[0], v0[1]); w.y = pk2(v0[2], v0[3]); w.z = pk2(v1[0], v1[1]); w.w = pk2(v1[2], v1[3]);
                    *(u32x4*)(ys + (size_t)(row0 + ai * 128 + m * 16) * 1024 + col0 + bj * 128) = w; }
    }
};
struct MoeOrder {
    const LAS int* tab;
    int G, c;
    __device__ __forceinline__ bool next(int i, Unit& u) const {
        const int L = i * G + c; const int nt = tab[0]; if (L >= nt * 4) return false;
        const int ti = L >> 2; u.pm = ti; u.pn = tab[1 + ti] * 4 + (L & 3); return true; }
    __device__ __forceinline__ void a_ready(const Unit&) const {}
    __device__ __forceinline__ void done(const Unit&) const {}
};
__device__ __forceinline__ void moe_tables(const Params& p, LAS int* tab) {
    const int tid = mk_tid(); const unsigned* cnt = (const unsigned*)(p.ws + WS_CTL);
    __syncthreads();
    if (tid == 0) { int ts = 0; for (int e = 0; e < 32; ++e) { const int c = (int)cnt[e]; tab[1024 + e] = ts * 256; const int nt = (c + 255) >> 8; for (int j = 0; j < nt; ++j) tab[1 + ts + j] = e; ts += nt; } tab[0] = ts; tab[1024 + 32] = ts * 256; }
    __syncthreads();
}

__device__ __forceinline__ void phase_prep(const Params& p) {
    const int tid = mk_tid(), lane = tid & 63, wave = tid >> 6;
    const int gw = blockIdx.x * NWAVES + wave, NGW = gridDim.x * NWAVES;
    const bf16_t* RW = (const bf16_t*)(p.ws + WS_RW); const float* MISC = (const float*)(p.ws + WS_MISC);
    bf16_t* AP = (bf16_t*)(p.ws + WS_AP); bf16_t* KN = (bf16_t*)(p.ws + WS_KN);
    const float* mu = p.in[2];
    const float mu_wd = mu[512 + lane], mu_ad = mu[1600 + lane], mu_g0 = mu[1664 + lane], mu_g1 = mu[1728 + lane];
    const float lg = p.in[14][lane], lb = p.in[15][lane];
    for (int tok = gw; tok < T; tok += NGW) {
        const bf16_t* cur = RW + (size_t)tok * 1792; const bool hp = (tok & (SEQ - 1)) != 0; const bf16_t* prv = cur - 1792;
        float wd = bf2f(cur[512 + lane]), ad = bf2f(cur[1600 + lane]), g0 = bf2f(cur[1664 + lane]), g1 = bf2f(cur[1728 + lane]);
        const float wdp = hp ? bf2f(prv[512 + lane]) : 0.f, adp = hp ? bf2f(prv[1600 + lane]) : 0.f, g0p = hp ? bf2f(prv[1664 + lane]) : 0.f, g1p = hp ? bf2f(prv[1728 + lane]) : 0.f;
        wd += (wdp - wd) * mu_wd; ad += (adp - ad) * mu_ad; g0 += (g0p - g0) * mu_g0; g1 += (g1p - g1) * mu_g1;
        bf16_t* ap = AP + (size_t)tok * 256;
        ap[lane] = (bf16_t)f2bf(tanhf(wd)); ap[64 + lane] = (bf16_t)f2bf(ad); ap[128 + lane] = (bf16_t)f2bf(sigmoidf_(g0)); ap[192 + lane] = (bf16_t)f2bf(sigmoidf_(g1));
        const float kx = MISC[(size_t)tok * 80 + lane]; const float mean = wave_sum(kx) * (1.f / 64.f); const float d = kx - mean;
        const float var = wave_sum(d * d) * (1.f / 64.f);
        KN[(size_t)tok * 64 + lane] = (bf16_t)f2bf(d * rsqrtf(var + 1e-5f) * lg + lb);
    }
}

typedef _Float16 h8 __attribute__((ext_vector_type(8)));
__device__ __forceinline__ float dpp_sum8(float x) {
    x += __builtin_bit_cast(float, __builtin_amdgcn_mov_dpp(__builtin_bit_cast(int, x), 0xB1, 0xF, 0xF, true));
    x += __builtin_bit_cast(float, __builtin_amdgcn_mov_dpp(__builtin_bit_cast(int, x), 0x4E, 0xF, 0xF, true));
    x += __builtin_bit_cast(float, __builtin_amdgcn_mov_dpp(__builtin_bit_cast(int, x), 0x141, 0xF, 0xF, true));
    return x;
}
__device__ __forceinline__ float dpp_sum16(float x) {
    x += __builtin_bit_cast(float, __builtin_amdgcn_mov_dpp(__builtin_bit_cast(int, x), 0xB1, 0xF, 0xF, true));
    x += __builtin_bit_cast(float, __builtin_amdgcn_mov_dpp(__builtin_bit_cast(int, x), 0x4E, 0xF, 0xF, true));
    x += __builtin_bit_cast(float, __builtin_amdgcn_mov_dpp(__builtin_bit_cast(int, x), 0x141, 0xF, 0xF, true));
    x += __builtin_bit_cast(float, __builtin_amdgcn_mov_dpp(__builtin_bit_cast(int, x), 0x140, 0xF, 0xF, true));
    return x;
}
constexpr int SC = 32;
typedef unsigned u32x2 __attribute__((ext_vector_type(2)));
typedef float f2 __attribute__((ext_vector_type(2)));
struct ScanRaw { u32x2 r, k, v, rp, kp, vp, w, a, g; };
struct ScanKeep { f32x4 v, g; float bonus; };
constexpr int SCL_VEC = 0, SCL_VBUF = SCL_VEC + 2 * SC * 1280, SCL_YBUF = SCL_VBUF + 2 * SC * 256, SCL_DUMMY = SCL_YBUF + 2 * SC * 256, SCL_END = SCL_DUMMY + 8704;
__device__ __forceinline__ void scan_item(const Params& p, LAS unsigned char* lds, int bh) {
    const int b = bh >> 3, h = bh & 7;
    const int tid = mk_tid(), lane = tid & 63, wave = tid >> 6;
    const bf16_t* RW = (const bf16_t*)(p.ws + WS_RW);
    const bf16_t* OMW = (const bf16_t*)((char*)p.out + DO_OMW); const bf16_t* ASIG = (const bf16_t*)((char*)p.out + DO_ASIG); const bf16_t* GG = (const bf16_t*)((char*)p.out + DO_G);
    bf16_t* YA = (bf16_t*)((char*)p.out + DO_YA);
    const size_t row0 = (size_t)b * SEQ;
    constexpr int NCH = SEQ / SC;
    __syncthreads();
    if (wave >= 4) {
        const int hw_ = wave - 4, tokl = lane >> 4, cg = lane & 15, col = h * 64 + 4 * cg;
        const f32x4 mu_r = *(const f32x4*)(p.in[2] + col), mu_k = *(const f32x4*)(p.in[2] + 576 + col), mu_v = *(const f32x4*)(p.in[2] + 1088 + col);
        const f32x4 w0c = *(const f32x4*)(p.in[3] + col), a0c = *(const f32x4*)(p.in[5] + col), kkc = *(const f32x4*)(p.in[8] + col), kac = *(const f32x4*)(p.in[9] + col);
        const f32x4 rkc = *(const f32x4*)(p.in[10] + col), lxg = *(const f32x4*)(p.in[11] + col), lxb = *(const f32x4*)(p.in[12] + col);
        ScanRaw R[2]; ScanKeep K0[2], K1[2];
#define SCAN_LOAD(c_, q_) do { const int t_ = (c_) * SC + hw_ * 8 + (q_) * 4 + tokl; const size_t rw_ = row0 + t_; const bf16_t* cur_ = RW + rw_ * 1792 + col; const bf16_t* prv_ = cur_ - 1792; \
        R[q_].r = *(const u32x2*)cur_; R[q_].k = *(const u32x2*)(cur_ + 576); R[q_].v = *(const u32x2*)(cur_ + 1088); \
        if (t_ > 0) { R[q_].rp = *(const u32x2*)prv_; R[q_].kp = *(const u32x2*)(prv_ + 576); R[q_].vp = *(const u32x2*)(prv_ + 1088); } else { R[q_].rp = (u32x2){0u, 0u}; R[q_].kp = R[q_].rp; R[q_].vp = R[q_].rp; } \
        R[q_].w = *(const u32x2*)(OMW + rw_ * 512 + col); R[q_].a = *(const u32x2*)(ASIG + rw_ * 512 + col); R[q_].g = *(const u32x2*)(GG + rw_ * 512 + col); } while (0)
#define UNPK(u_) (f32x4){bflo((u_).x), bfhi((u_).x), bflo((u_).y), bfhi((u_).y)}
#define SCAN_PREP(c_, q_) do { const int tk_ = hw_ * 8 + (q_) * 4 + tokl; const int bf_ = (c_) & 1; \
        f32x4 r = UNPK(R[q_].r), k = UNPK(R[q_].k), v = UNPK(R[q_].v); const f32x4 rp = UNPK(R[q_].rp), kp = UNPK(R[q_].kp), vp = UNPK(R[q_].vp); \
        r += (rp - r) * mu_r; k += (kp - k) * mu_k; v += (vp - v) * mu_v; \
        const f32x4 wr = UNPK(R[q_].w) + w0c, ar = UNPK(R[q_].a) + a0c; f32x4 a, omw; \
        _Pragma("unroll") for (int i = 0; i < 4; ++i) { a[i] = sigmoidf_(ar[i]); \
            const float z = -wr[i]; const float sp = z > 20.f ? z : __logf(1.f + __expf(z)); const float e = __expf(-sp - 0.5f); \
            omw[i] = e < 0.1f ? e * (1.f - e * (0.5f - e * ((1.f / 6.f) - e * ((1.f / 24.f) - e * (1.f / 120.f))))) : 1.f - __expf(-e); } \
        const f32x4 kkr = k * kkc; const float n2 = dpp_sum16((kkr.x * kkr.x + kkr.y * kkr.y) + (kkr.z * kkr.z + kkr.w * kkr.w)); \
        const f32x4 kk = kkr * __builtin_amdgcn_rsqf(fmaxf(n2, 1e-24f)); const f32x4 k2 = k * ((a - 1.f) * kac + 1.f); \
        const f32x4 rb = r * k2 * rkc; K0[q_].bonus = dpp_sum16((rb.x + rb.y) + (rb.z + rb.w)); K0[q_].v = v; K0[q_].g = UNPK(R[q_].g); \
        LAS float* vp_ = (LAS float*)(lds + SCL_VEC) + (bf_ * SC + tk_) * 320 + 4 * cg; \
        *(LAS f32x4*)(vp_) = 1.f - omw; *(LAS f32x4*)(vp_ + 64) = -kk; *(LAS f32x4*)(vp_ + 128) = kk * a; *(LAS f32x4*)(vp_ + 192) = k2; *(LAS f32x4*)(vp_ + 256) = r; \
        *(LAS f32x4*)((LAS float*)(lds + SCL_VBUF) + (bf_ * SC + tk_) * 64 + 4 * cg) = v; } while (0)
#define SCAN_POST(c_, q_) do { const int tk_ = hw_ * 8 + (q_) * 4 + tokl; const int bf_ = (c_) & 1; \
        const f32x4 y = *(const LAS f32x4*)((LAS float*)(lds + SCL_YBUF) + (bf_ * SC + tk_) * 64 + 4 * cg); \
        const float mean = dpp_sum16((y.x + y.y) + (y.z + y.w)) * (1.f / 64.f); const f32x4 d = y - mean; \
        const float var = dpp_sum16((d.x * d.x + d.y * d.y) + (d.z * d.z + d.w * d.w)) * (1.f / 64.f); const float rs = __builtin_amdgcn_rsqf(var + 64e-5f); \
        const f32x4 o = (d * rs * lxg + lxb + K1[q_].v * K1[q_].bonus) * K1[q_].g; \
        *(u32x2*)(YA + (row0 + (size_t)(c_) * SC + tk_) * 512 + col) = (u32x2){pk2(o.x, o.y), pk2(o.z, o.w)}; } while (0)
        SCAN_LOAD(0, 0); SCAN_LOAD(0, 1);
        SCAN_PREP(0, 0); SCAN_PREP(0, 1);
        SCAN_LOAD(1, 0); SCAN_LOAD(1, 1);
        K1[0] = K0[0]; K1[1] = K0[1];
        __syncthreads();
        for (int c = 0; c <= NCH; ++c) {
            if (c >= 1) { SCAN_POST(c - 1, 0); SCAN_POST(c - 1, 1); }
            K1[0] = K0[0]; K1[1] = K0[1];
            if (c + 1 < NCH) { SCAN_PREP(c + 1, 0); SCAN_PREP(c + 1, 1); }
            if (c + 2 < NCH) { SCAN_LOAD(c + 2, 0); SCAN_LOAD(c + 2, 1); }
            if (c < NCH) __syncthreads();
        }
#undef SCAN_LOAD
#undef UNPK
#undef SCAN_PREP
#undef SCAN_POST
    } else {
        const int rp = lane >> 3, jg = lane & 7, i0 = wave * 16 + rp * 2;
        const int yoff = (jg == 0) ? i0 : (SCL_DUMMY - SCL_YBUF) / 4 + 2 * lane;
        f2 s0[4], s1[4];
#pragma unroll
        for (int j = 0; j < 4; ++j) { s0[j] = (f2){0.f, 0.f}; s1[j] = s0[j]; }
        __syncthreads();
        for (int c = 0; c < NCH; ++c) {
            const int bf = c & 1;
            const LAS float* vecb = (const LAS float*)(lds + SCL_VEC) + bf * SC * 320; const LAS float* vbb = (const LAS float*)(lds + SCL_VBUF) + bf * SC * 64 + i0;
            LAS float* ybb = (LAS float*)(lds + SCL_YBUF) + ((jg == 0) ? bf * SC * 64 : 0) + yoff;
#if defined(MK_REP) && MK_REP == 302
            f2 k0_[4], k1_[4];
#pragma unroll
            for (int j = 0; j < 4; ++j) { k0_[j] = s0[j]; k1_[j] = s1[j]; }
            for (int rep_ = 0; rep_ < 2; ++rep_) {
#pragma unroll
            for (int j = 0; j < 4; ++j) { s0[j] = k0_[j]; s1[j] = k1_[j]; asm volatile("" : "+v"(s0[j]), "+v"(s1[j]) :: "memory"); }
#endif
#define LDV(t_, W, A, B, K, Rr, V) do { const LAS f32x4* q_ = (const LAS f32x4*)(vecb + (t_) * 320) + 2 * jg; W##0 = q_[0]; W##1 = q_[1]; A##0 = q_[16]; A##1 = q_[17]; B##0 = q_[32]; B##1 = q_[33]; \
        K##0 = q_[48]; K##1 = q_[49]; Rr##0 = q_[64]; Rr##1 = q_[65]; V = *(const LAS f2*)(vbb + (t_) * 64); } while (0)
#define LO2(v_) __builtin_shufflevector(v_, v_, 0, 1)
#define HI2(v_) __builtin_shufflevector(v_, v_, 2, 3)
#define FMA2(a_, b_, c_) __builtin_elementwise_fma(a_, b_, c_)
            f32x4 vw0, vw1, va0, va1, vb0, vb1, vk0, vk1, vr0, vr1; f2 vv;
            LDV(0, vw, va, vb, vk, vr, vv);
#pragma unroll 2
            for (int tk = 0; tk < SC; ++tk) {
                f32x4 nw0, nw1, na0, na1, nb0, nb1, nk0, nk1, nr0, nr1; f2 nv;
                { const int tn = (tk + 1 < SC) ? tk + 1 : tk; LDV(tn, nw, na, nb, nk, nr, nv); }
                f2 p0 = s0[0] * LO2(va0), p1 = s1[0] * LO2(va0);
                p0 = FMA2(s0[1], HI2(va0), p0); p1 = FMA2(s1[1], HI2(va0), p1); p0 = FMA2(s0[2], LO2(va1), p0); p1 = FMA2(s1[2], LO2(va1), p1); p0 = FMA2(s0[3], HI2(va1), p0); p1 = FMA2(s1[3], HI2(va1), p1);
                const float sa0 = dpp_sum8(p0.x + p0.y), sa1 = dpp_sum8(p1.x + p1.y);
                const f2 sa0v = {sa0, sa0}, sa1v = {sa1, sa1}, v0v = {vv.x, vv.x}, v1v = {vv.y, vv.y};
                s0[0] = FMA2(v0v, LO2(vk0), FMA2(sa0v, LO2(vb0), s0[0] * LO2(vw0))); s1[0] = FMA2(v1v, LO2(vk0), FMA2(sa1v, LO2(vb0), s1[0] * LO2(vw0)));
                s0[1] = FMA2(v0v, HI2(vk0), FMA2(sa0v, HI2(vb0), s0[1] * HI2(vw0))); s1[1] = FMA2(v1v, HI2(vk0), FMA2(sa1v, HI2(vb0), s1[1] * HI2(vw0)));
                s0[2] = FMA2(v0v, LO2(vk1), FMA2(sa0v, LO2(vb1), s0[2] * LO2(vw1))); s1[2] = FMA2(v1v, LO2(vk1), FMA2(sa1v, LO2(vb1), s1[2] * LO2(vw1)));
                s0[3] = FMA2(v0v, HI2(vk1), FMA2(sa0v, HI2(vb1), s0[3] * HI2(vw1))); s1[3] = FMA2(v1v, HI2(vk1), FMA2(sa1v, HI2(vb1), s1[3] * HI2(vw1)));
                f2 q0 = s0[0] * LO2(vr0), q1 = s1[0] * LO2(vr0);
                q0 = FMA2(s0[1], HI2(vr0), q0); q1 = FMA2(s1[1], HI2(vr0), q1); q0 = FMA2(s0[2], LO2(vr1), q0); q1 = FMA2(s1[2], LO2(vr1), q1); q0 = FMA2(s0[3], HI2(vr1), q0); q1 = FMA2(s1[3], HI2(vr1), q1);
                const float y0 = dpp_sum8(q0.x + q0.y), y1 = dpp_sum8(q1.x + q1.y);
                *(LAS f2*)(ybb + tk * 64) = (f2){y0, y1};
                vw0 = nw0; vw1 = nw1; va0 = na0; va1 = na1; vb0 = nb0; vb1 = nb1; vk0 = nk0; vk1 = nk1; vr0 = nr0; vr1 = nr1; vv = nv;
            }
#undef LDV
#undef LO2
#undef HI2
#undef FMA2
#if defined(MK_REP) && MK_REP == 302
            }
#endif
            __syncthreads();
        }
    }
}

constexpr int IX_HIST = 0, IX_MASK = 65536, IX_MROW = 129  , IX_CAND = IX_MASK + 8448, IX_MISC = IX_CAND + 16384, IX_CAP = 128;
struct IxSel { int B0; unsigned Klo, Khi; };
__device__ __forceinline__ unsigned ix_key(float x) { const unsigned h = (unsigned)__builtin_bit_cast(unsigned short, (_Float16)x); return (h & 0x8000u) ? (~h & 0xffffu) : (h | 0x8000u); }
__device__ __forceinline__ void ix_blockA(const bool DIAG, const bf16x8 a0, const bf16x8 a1, const bf16x8 (&qf)[9][2], const float (&hw)[8], int s0, int quad, int n, int tq,
                                          LAS unsigned* hist, unsigned short* KS) {
    f32x4 acc[9];
#pragma unroll
    for (int h = 0; h < 9; ++h) { acc[h] = (f32x4){0.f, 0.f, 0.f, 0.f}; acc[h] = __builtin_amdgcn_mfma_f32_16x16x32_bf16(a0, qf[h][0], acc[h], 0, 0, 0); }
#pragma unroll
    for (int h = 0; h < 9; ++h) acc[h] = __builtin_amdgcn_mfma_f32_16x16x32_bf16(a1, qf[h][1], acc[h], 0, 0, 0);
    __builtin_amdgcn_sched_barrier(0);
    f32x4 idx = acc[8];
#pragma unroll
    for (int h = 0; h < 8; ++h)
#pragma unroll
        for (int j = 0; j < 4; ++j) idx[j] = __builtin_fmaf(hw[h], __builtin_fabsf(acc[h][j]), idx[j]);
    const int sb = s0 + quad * 4; unsigned k[4];
#pragma unroll
    for (int j = 0; j < 4; ++j) { k[j] = ix_key(idx[j]); if (!DIAG || sb + j <= tq) __hip_atomic_fetch_add(&hist[n * 1024 + (k[j] >> 6)], 1u, __ATOMIC_RELAXED, __HIP_MEMORY_SCOPE_WORKGROUP); }
    *(u32x2*)(KS + s0 * 16 + n * 16 + quad * 4) = (u32x2){k[0] | (k[1] << 16), k[2] | (k[3] << 16)};
}
template <int MODE>
__device__ __forceinline__ void ix_blockK(const bool DIAG, const u32x2 kw, int s0, int quad, int n, int tq, const IxSel& S, LAS unsigned* hist, LAS unsigned* mrow, LAS int* ccnt, LAS int* candk, LAS int* cands) {
    const int sb = s0 + quad * 4; const unsigned k[4] = {kw.x & 0xffffu, kw.x >> 16, kw.y & 0xffffu, kw.y >> 16};
    if (MODE == 1) {
#pragma unroll
        for (int j = 0; j < 4; ++j) if ((!DIAG || sb + j <= tq) && (int)(k[j] >> 6) == S.B0) __hip_atomic_fetch_add(&hist[n * 1024 + (k[j] & 63u)], 1u, __ATOMIC_RELAXED, __HIP_MEMORY_SCOPE_WORKGROUP);
    } else {
        unsigned m = 0u, cm = 0u;
#pragma unroll
        for (int j = 0; j < 4; ++j) { const bool ok = !DIAG || sb + j <= tq; if (ok && k[j] > S.Khi) m |= 1u << j; if (ok && k[j] >= S.Klo && k[j] <= S.Khi) cm |= 1u << j; }
        {
            unsigned t = m << (4 * quad);
            { auto r = __builtin_amdgcn_permlane16_swap(t, t, false, false); t = r[0] | r[1]; }
            { auto r = __builtin_amdgcn_permlane32_swap(t, t, false, false); t = r[0] | r[1]; }
            if (quad == 0) ((LAS unsigned short*)mrow)[n * (IX_MROW * 2) + (s0 >> 4)] = (unsigned short)t; }
        if (cm) {
            int sl = __hip_atomic_fetch_add(&ccnt[n], (int)__builtin_popcount(cm), __ATOMIC_RELAXED, __HIP_MEMORY_SCOPE_WORKGROUP);
#pragma unroll
            for (int j = 0; j < 4; ++j) if ((cm >> j) & 1u) { if (sl < IX_CAP) { candk[n * IX_CAP + sl] = (int)k[j]; cands[n * IX_CAP + sl] = sb + j; } ++sl; } }
    }
}
__device__ __forceinline__ void ix_passA(const bf16_t* KNb, const bf16x8 (&qf)[9][2], const float (&hw)[8], int qg, int wave, int quad, int n, int tq, LAS unsigned* hist, unsigned short* KS) {
    if (wave > qg) return;
    const int nb = (qg - wave) / NWAVES + 1;
    const bf16_t* kp0 = KNb + (size_t)(wave * 16 + n) * 64 + quad * 8;
    constexpr size_t KSTEP = (size_t)NWAVES * 16 * 64;
#define IX_LD(i_, x0_, x1_) do { const int ii_ = (i_) < nb ? (i_) : nb - 1; const bf16_t* q_ = kp0 + (size_t)ii_ * KSTEP; x0_ = *(const bf16x8*)q_; x1_ = *(const bf16x8*)(q_ + 32); } while (0)
#define IX_DO(i_, x0_, x1_) do { if ((i_) < nb) { const int kb_ = wave + NWAVES * (i_); const bf16x8 a0_ = x0_, a1_ = x1_; IX_LD((i_) + 4, x0_, x1_); \
        ix_blockA(kb_ == qg, a0_, a1_, qf, hw, kb_ * 16, quad, n, tq, hist, KS); } } while (0)
    bf16x8 r00, r01, r10, r11, r20, r21, r30, r31;
    IX_LD(0, r00, r01); IX_LD(1, r10, r11); IX_LD(2, r20, r21); IX_LD(3, r30, r31);
#pragma unroll 1
    for (int i = 0; i < nb; i += 4) { IX_DO(i, r00, r01); IX_DO(i + 1, r10, r11); IX_DO(i + 2, r20, r21); IX_DO(i + 3, r30, r31); }
#undef IX_LD
#undef IX_DO
}
template <int MODE>
__device__ __forceinline__ void ix_passK(const unsigned short* KS, int qg, int wave, int quad, int n, int tq, const IxSel& S, LAS unsigned* hist, LAS unsigned* mrow, LAS int* ccnt, LAS int* candk, LAS int* cands) {
    if (wave > qg) return;
    const int nb = (qg - wave) / NWAVES + 1;
    const unsigned short* kp0 = KS + wave * 256 + n * 16 + quad * 4;
#define IX_LD(i_, x_) do { const int ii_ = (i_) < nb ? (i_) : nb - 1; x_ = *(const u32x2*)(kp0 + ii_ * (NWAVES * 256)); } while (0)
#define IX_DO(i_, x_) do { if ((i_) < nb) { const int kb_ = wave + NWAVES * (i_); const u32x2 kw_ = x_; IX_LD((i_) + 4, x_); \
        ix_blockK<MODE>(kb_ == qg, kw_, kb_ * 16, quad, n, tq, S, hist, mrow, ccnt, candk, cands); } } while (0)
    u32x2 r0, r1, r2, r3;
    IX_LD(0, r0); IX_LD(1, r1); IX_LD(2, r2); IX_LD(3, r3);
#pragma unroll 1
    for (int i = 0; i < nb; i += 4) { IX_DO(i, r0); IX_DO(i + 1, r1); IX_DO(i + 2, r2); IX_DO(i + 3, r3); }
#undef IX_LD
#undef IX_DO
}
__device__ __forceinline__ void ix_search(int tid, LAS unsigned* hist, LAS int* segsum, LAS int* needv, LAS int* outB, LAS int* outG, LAS int* outC) {
    const int qn = tid >> 5, seg = tid & 31;
    { int sum = 0; for (int w = 0; w < 32; ++w) sum += (int)hist[qn * 1024 + seg * 32 + w]; segsum[qn * 32 + seg] = sum; }
    __syncthreads();
    { const int need = needv[qn]; int above = 0; for (int s2 = seg + 1; s2 < 32; ++s2) above += segsum[qn * 32 + s2]; const int mine = segsum[qn * 32 + seg];
      if (above < need && above + mine >= need) { int cum = above;
          for (int bin = seg * 32 + 31; bin >= seg * 32; --bin) { const int cnt = (int)hist[qn * 1024 + bin];
              if (cum + cnt >= need) { outB[qn] = bin; outG[qn] = cum; outC[qn] = cnt; break; } cum += cnt; } } }
    __syncthreads();
}
__device__ __forceinline__ void indexer_unit(const Params& p, LAS unsigned char* lds, int b, int qg, int mode = 0) {
    const int tid = mk_tid(), lane = tid & 63, wave = tid >> 6;
    LAS unsigned* hist = (LAS unsigned*)(lds + IX_HIST);
    LAS unsigned* mrow = (LAS unsigned*)(lds + IX_MASK);
    LAS float* candv = (LAS float*)(lds + IX_CAND);
    LAS int* cands = (LAS int*)(lds + IX_CAND + 8192);
    LAS int* ccnt = (LAS int*)(lds + IX_MISC);
    LAS int* thrB = ccnt + 16; LAS int* thrG = ccnt + 32;
    LAS int* segsum = ccnt + 64;
    LAS int* needv = ccnt + 64 + 512; LAS int* thrC = needv + 16; LAS int* thrB1 = needv + 32; LAS int* thrG1 = needv + 48; LAS int* thrC1 = needv + 64;
    unsigned* MASK = (unsigned*)(p.ws + WS_MASK);
    const int t0 = qg * 16; const size_t rowb = (size_t)b * SEQ;
    if (qg < 16) {
        for (int i = tid; i < 2048; i += NTHREADS) { const int n = i >> 7, w = i & 127, tq = t0 + n; const int s0 = 32 * w;
            const unsigned m = tq >= s0 + 31 ? 0xffffffffu : (tq < s0 ? 0u : ((2u << (tq - s0)) - 1u));
            MASK[(rowb + t0) * 128 + i] = m; }
        return;
    }
    for (int i = tid; i < 16384 + 16 * IX_MROW; i += NTHREADS) hist[i] = 0u;
    if (tid < 16) { ccnt[tid] = 0; needv[tid] = 256; }
    const bf16_t* QI = (const bf16_t*)(p.ws + WS_QI); const bf16_t* KNb = (const bf16_t*)(p.ws + WS_KN) + rowb * 64; const float* MISC = (const float*)(p.ws + WS_MISC);
    const int n = lane & 15, quad = lane >> 4, tq = t0 + n;
    bf16x8 qf[9][2]; float hw[8];
#pragma unroll
    for (int h = 0; h < 8; ++h) { hw[h] = MISC[(rowb + tq) * 80 + 64 + h] * (0.5f * 0.125f * 0.35355339059327373f);
#pragma unroll
        for (int ks = 0; ks < 2; ++ks) qf[h][ks] = *(const bf16x8*)(QI + (rowb + tq) * 512 + h * 64 + ks * 32 + quad * 8); }
    { float s2 = 0.f;
#pragma unroll
      for (int h = 0; h < 8; ++h) { float qq = 0.f;
#pragma unroll
          for (int ks = 0; ks < 2; ++ks)
#pragma unroll
              for (int i = 0; i < 8; ++i) { const float e = bf2f((bf16_t)qf[h][ks][i]); qq = __builtin_fmaf(e, e, qq); }
          s2 = __builtin_fmaf(hw[h] * hw[h], qq, s2); }
      s2 = xrow_sum(s2);
      const float rs = rsqrtf(fmaxf(s2, 1e-30f));
#pragma unroll
      for (int h = 0; h < 8; ++h) hw[h] *= rs; }
#pragma unroll
    for (int ks = 0; ks < 2; ++ks)
#pragma unroll
        for (int i = 0; i < 8; i += 2) { float e0 = 0.f, e1 = 0.f;
#pragma unroll
            for (int h = 0; h < 8; ++h) { e0 = __builtin_fmaf(hw[h], bf2f((bf16_t)qf[h][ks][i]), e0); e1 = __builtin_fmaf(hw[h], bf2f((bf16_t)qf[h][ks][i + 1]), e1); }
            qf[8][ks][i] = (short)f2bf(e0); qf[8][ks][i + 1] = (short)f2bf(e1); }
    __syncthreads();
    unsigned short* KS = (unsigned short*)(p.ws + WS_AP) + (size_t)blockIdx.x * 65536;
    if (mode == 2) { if (hw[0] == 123.f && qf[8][0][0] == 77) MASK[0] = 1u; return; }
    ix_passA(KNb, qf, hw, qg, wave, quad, n, tq, hist, KS);
    __syncthreads();
    if (mode == 3) return;
    ix_search(tid, hist, segsum, needv, thrB, thrG, thrC);
    if (mode == 1) return;
    IxSel S; S.B0 = thrB[n]; S.Klo = (unsigned)S.B0 << 6; S.Khi = S.Klo | 63u;
    int refined;
    { int mx = 0;
#pragma unroll
      for (int q = 0; q < 16; ++q) mx = max(mx, thrC[q]);
      refined = mx > IX_CAP / 2; }
    if (refined) {
        __syncthreads();
        for (int i = tid; i < 16384; i += NTHREADS) hist[i] = 0u;
        if (tid < 16) needv[tid] = 256 - thrG[tid];
        __syncthreads();
        ix_passK<1>(KS, qg, wave, quad, n, tq, S, hist, mrow, ccnt, (LAS int*)candv, cands);
        __syncthreads();
        ix_search(tid, hist, segsum, needv, thrB1, thrG1, thrC1);
        S.Klo = ((unsigned)S.B0 << 6) | (unsigned)thrB1[n]; S.Khi = S.Klo;
    }
    ix_passK<2>(KS, qg, wave, quad, n, tq, S, hist, mrow, ccnt, (LAS int*)candv, cands);
    __syncthreads();
    if (mode == 4) return;
    { const int qn = tid >> 5, sub = tid & 31; const int nc = min(ccnt[qn], IX_CAP), need = 256 - thrG[qn] - (refined ? thrG1[qn] : 0); const LAS int* candk = (const LAS int*)candv;
#ifdef MK_CHK
      if (ccnt[qn] > MK_CHK) ((unsigned*)(p.ws + WS_CTL))[50] = 2u;
#endif
      for (int c = sub; c < nc; c += 32) { const int v = candk[qn * IX_CAP + c]; const int s = cands[qn * IX_CAP + c]; int rank = 0;
          const int vs = (v << 12) | (4095 - s);
#pragma unroll 8
          for (int c2 = 0; c2 < ((nc + 7) & ~7); ++c2) { const int w2 = c2 < nc ? ((candk[qn * IX_CAP + c2] << 12) | (4095 - cands[qn * IX_CAP + c2])) : 0; rank += (w2 > vs) ? 1 : 0; }
          if (rank < need) __hip_atomic_fetch_or(&mrow[qn * IX_MROW + (s >> 5)], 1u << (s & 31), __ATOMIC_RELAXED, __HIP_MEMORY_SCOPE_WORKGROUP); } }
    __syncthreads();
    for (int i = tid; i < 2048; i += NTHREADS) MASK[(rowb + t0) * 128 + i] = mrow[(i >> 7) * IX_MROW + (i & 127)];
    __syncthreads();
}

__device__ __forceinline__ void phase_ln_router(const Params& p, LAS unsigned char* lds, bool dry = false) {
    const int tid = mk_tid(), lane = tid & 63, wave = tid >> 6;
    LAS float* WR = (LAS float*)lds;
    LAS int* lcnt = (LAS int*)(lds + 147456);
    LAS int* lbase = lcnt + 32;
    LAS int* tke = lcnt + 64;
    LAS int* tks = lcnt + 64 + 512;
    for (int i = tid; i < 36 * 1024; i += NTHREADS) { const int o = i >> 10, k = i & 1023; WR[i] = o < 4 ? p.in[21][k * 4 + o] : p.in[23][k * 32 + (o - 4)]; }
    float* H = p.out; bf16_t* H1B = (bf16_t*)(p.ws + WS_H1B);
    int* EID = (int*)(p.ws + WS_EID); float* GATE = (float*)(p.ws + WS_GATE); int* SLOT = (int*)(p.ws + WS_SLOT); unsigned* gcnt = (unsigned*)(p.ws + WS_CTL);
    const float* g1 = p.in[19]; const float* b1 = p.in[20];
    for (int tile = blockIdx.x; tile < T / 256; tile += gridDim.x) {
        if (tid < 32) lcnt[tid] = 0;
        __syncthreads();
        for (int it = 0; it < 32; ++it) {
            const int tl = wave * 32 + it, tok = tile * 256 + tl;
            f32x4* hr = (f32x4*)(H + (size_t)tok * DM) + lane;
            f32x4 v[4]; float s = 0.f;
#pragma unroll
            for (int j = 0; j < 4; ++j) { v[j] = hr[64 * j]; s += (v[j].x + v[j].y) + (v[j].z + v[j].w); }
            const float mean = wave_sum(s) * (1.f / DM); float s2 = 0.f;
#pragma unroll
            for (int j = 0; j < 4; ++j) { v[j] = v[j] - mean; s2 += (v[j].x * v[j].x + v[j].y * v[j].y) + (v[j].z * v[j].z + v[j].w * v[j].w); }
            const float rstd = rsqrtf(wave_sum(s2) * (1.f / DM) + 1e-5f);
#pragma unroll
            for (int j = 0; j < 4; ++j) { const f32x4 g = ((const f32x4*)g1)[lane + 64 * j], bb = ((const f32x4*)b1)[lane + 64 * j]; v[j] = v[j] * rstd * g + bb;
                ((unsigned long long*)(H1B + (size_t)tok * DM))[lane + 64 * j] = (unsigned long long)pk2(v[j].x, v[j].y) | ((unsigned long long)pk2(v[j].z, v[j].w) << 32); }
            float lg[36];
#pragma unroll
            for (int o = 0; o < 36; ++o) { float a = 0.f;
#pragma unroll
                for (int j = 0; j < 4; ++j) { const f32x4 w = ((const LAS f32x4*)(WR + o * 1024))[lane + 64 * j]; a += (v[j].x * w.x + v[j].y * w.y) + (v[j].z * w.z + v[j].w * w.w); }
                lg[o] = wave_sum(a); }
            float gl[4];
#pragma unroll
            for (int o = 0; o < 4; ++o) gl[o] = lg[o] + p.in[22][o];
            float gm = gl[0]; int gs = 0;
#pragma unroll
            for (int o = 1; o < 4; ++o) if (gl[o] > gm) { gm = gl[o]; gs = o; }
            float gden = 0.f;
#pragma unroll
            for (int o = 0; o < 4; ++o) gden += __expf(gl[o] - gm);
            const float pg = 1.f / gden;
            float el[8];
#pragma unroll
            for (int o = 0; o < 8; ++o) { float x = 0.f;
#pragma unroll
                for (int g = 0; g < 4; ++g) if (g == gs) x = lg[4 + g * 8 + o] + p.in[24][g * 8 + o];
                el[o] = x; }
            float m1 = el[0]; int i1 = 0;
#pragma unroll
            for (int o = 1; o < 8; ++o) if (el[o] > m1) { m1 = el[o]; i1 = o; }
            float m2 = -INFINITY; int i2 = 0;
#pragma unroll
            for (int o = 0; o < 8; ++o) if (o != i1 && el[o] > m2) { m2 = el[o]; i2 = o; }
            const float e2 = __expf(m2 - m1); const float ga = pg / (1.f + e2), gb = pg * e2 / (1.f + e2);
            if (lane == 0) { const int ea = gs * 8 + i1, eb = gs * 8 + i2;
                EID[tok * 2] = ea; EID[tok * 2 + 1] = eb; GATE[tok * 2] = ga; GATE[tok * 2 + 1] = gb;
                if (!dry)
                tke[tl * 2] = ea; tke[tl * 2 + 1] = eb; tks[tl * 2] = __hip_atomic_fetch_add(&lcnt[ea], 1, __ATOMIC_RELAXED, __HIP_MEMORY_SCOPE_WORKGROUP); tks[tl * 2 + 1] = __hip_atomic_fetch_add(&lcnt[eb], 1, __ATOMIC_RELAXED, __HIP_MEMORY_SCOPE_WORKGROUP); }
        }
        __syncthreads();
        if (tid < 32 && !dry) lbase[tid] = (int)__hip_atomic_fetch_add(&gcnt[tid], (unsigned)lcnt[tid], __ATOMIC_RELAXED, __HIP_MEMORY_SCOPE_AGENT);
        __syncthreads();
        if (!dry) SLOT[tile * 512 + tid] = lbase[tke[tid]] + tks[tid];
        __syncthreads();
    }
}

__device__ __forceinline__ void phase_permute(const Params& p, LAS int* tab) {
    const int tid = mk_tid(), lane = tid & 63, wave = tid >> 6;
    const int gw = blockIdx.x * NWAVES + wave, NGW = gridDim.x * NWAVES;
    const int* EID = (const int*)(p.ws + WS_EID); const int* SLOT = (const int*)(p.ws + WS_SLOT);
    const u32x4* H1B = (const u32x4*)(p.ws + WS_H1B); u32x4* XS = (u32x4*)(p.ws + WS_XS);
    for (int i = gw; i < T * 2; i += NGW) { const int tok = i >> 1; const int dst = tab[1024 + EID[i]] + SLOT[i];
        const u32x4 a = H1B[(size_t)tok * 128 + lane], b2 = H1B[(size_t)tok * 128 + 64 + lane];
        XS[(size_t)dst * 128 + lane] = a; XS[(size_t)dst * 128 + 64 + lane] = b2; }
}

__device__ __forceinline__ void phase_final(const Params& p, LAS int* tab, bool dry = false) {
    const int tid = mk_tid(), lane = tid & 63, wave = tid >> 6;
    const int gw = blockIdx.x * NWAVES + wave, NGW = gridDim.x * NWAVES;
    const int* EID = (const int*)(p.ws + WS_EID); const int* SLOT = (const int*)(p.ws + WS_SLOT); const float* GATE = (const float*)(p.ws + WS_GATE);
    const bf16_t* YS = (const bf16_t*)(p.ws + WS_XS); const float alpha = 1.189207115002721f;
    const float* g2 = p.in[28]; const float* b2 = p.in[29];
#ifdef MK_CHK
#ifndef MK_CHKSEL
#define MK_CHKSEL 7
#endif
    { const volatile unsigned* cw = (const volatile unsigned*)(p.ws + WS_CTL); const bool bad = ((MK_CHKSEL & 1) && cw[50] == 1u) || ((MK_CHKSEL & 4) && cw[50] == 2u) || ((MK_CHKSEL & 2) && cw[51] != 0u);
      if (bad && blockIdx.x == 0 && tid == 0) p.out[0] = __builtin_nanf(""); }
#endif
    for (int tok = gw; tok < T; tok += NGW) {
        const int r0 = tab[1024 + EID[tok * 2]] + SLOT[tok * 2], r1 = tab[1024 + EID[tok * 2 + 1]] + SLOT[tok * 2 + 1]; const float ga = GATE[tok * 2], gb = GATE[tok * 2 + 1];
        f32x4* hr = (f32x4*)(p.out + (size_t)tok * DM) + lane; f32x4 v[4]; float s = 0.f;
        const unsigned long long* hb = (const unsigned long long*)((const bf16_t*)(p.ws + WS_H1B) + (size_t)tok * DM);
#pragma unroll
        for (int j = 0; j < 4; ++j) { const unsigned long long hw_ = hb[lane + 64 * j]; const unsigned h0 = (unsigned)hw_, h1_ = (unsigned)(hw_ >> 32); const f32x4 hv = {bflo(h0), bfhi(h0), bflo(h1_), bfhi(h1_)};
            const unsigned long long ya = ((const unsigned long long*)(YS + (size_t)r0 * DM))[lane + 64 * j], yb = ((const unsigned long long*)(YS + (size_t)r1 * DM))[lane + 64 * j];
            const unsigned a0 = (unsigned)ya, a1 = (unsigned)(ya >> 32), c0 = (unsigned)yb, c1 = (unsigned)(yb >> 32);
            v[j].x = alpha * hv.x + ga * bflo(a0) + gb * bflo(c0); v[j].y = alpha * hv.y + ga * bfhi(a0) + gb * bfhi(c0);
            v[j].z = alpha * hv.z + ga * bflo(a1) + gb * bflo(c1); v[j].w = alpha * hv.w + ga * bfhi(a1) + gb * bfhi(c1);
            s += (v[j].x + v[j].y) + (v[j].z + v[j].w); }
        const float mean = wave_sum(s) * (1.f / DM); float s2 = 0.f;
#pragma unroll
        for (int j = 0; j < 4; ++j) { v[j] = v[j] - mean; s2 += (v[j].x * v[j].x + v[j].y * v[j].y) + (v[j].z * v[j].z + v[j].w * v[j].w); }
        const float rstd = rsqrtf(wave_sum(s2) * (1.f / DM) + 1e-5f);
#pragma unroll
        for (int j = 0; j < 4; ++j) { const f32x4 g = ((const f32x4*)g2)[lane + 64 * j], bb = ((const f32x4*)b2)[lane + 64 * j]; const f32x4 o = v[j] * rstd * g + bb; if (!dry) hr[64 * j] = o; }
    }
}


#ifdef MK_CHK
#ifndef MK_CHK_MISM
#define MK_CHK_MISM 16
#endif
#ifndef MK_CHK_ATT
#define MK_CHK_ATT 1e-3f
#endif
__device__ __forceinline__ void phase_check(const Params& p, LAS unsigned char* lds) {
    const int tid = mk_tid(), blk = blockIdx.x;
    LAS float* sc = (LAS float*)lds;
    LAS int* red = (LAS int*)(lds + 16384);
    LAS float* redf = (LAS float*)(lds + 16384 + 64);
    LAS float* ov = (LAS float*)(lds + 16384 + 128);
    const int b = blk & 15, t = ((blk >> 4) * 263 + 290 + 37 * blk) & 4095, h = (blk >> 2) & 7;
    const size_t rowb = (size_t)b * SEQ, row = rowb + t;
    const bf16_t* QI = (const bf16_t*)(p.ws + WS_QI); const bf16_t* KN = (const bf16_t*)(p.ws + WS_KN); const float* MISC = (const float*)(p.ws + WS_MISC);
    const unsigned* MASK = (const unsigned*)(p.ws + WS_MASK) + row * 128;
    unsigned* ctl = (unsigned*)(p.ws + WS_CTL);
    if (tid < 8) red[tid] = 0; if (tid < 4) redf[tid] = 0.f; if (tid < 64) ov[tid] = 0.f;
    for (int s_ = tid; s_ <= t; s_ += NTHREADS) { float acc = 0.f;
        for (int hh = 0; hh < 8; ++hh) { float d = 0.f; for (int k = 0; k < 64; ++k) d += bf2f(QI[row * 512 + hh * 64 + k]) * bf2f(KN[(rowb + s_) * 64 + k]);
            acc += (MISC[row * 80 + 64 + hh] * 0.35355339059327373f) * fmaxf(d * 0.125f, 0.f); }
        sc[s_] = acc; }
    __syncthreads();
    int mism = 0, pc = 0;
    for (int s_ = tid; s_ <= t; s_ += NTHREADS) { const float v = sc[s_]; int rank = 0;
        for (int s2 = 0; s2 <= t; ++s2) { const float v2 = sc[s2]; rank += (v2 > v || (v2 == v && s2 < s_)) ? 1 : 0; }
        const int ref = rank < 256 ? 1 : 0, got = (int)((MASK[s_ >> 5] >> (s_ & 31)) & 1u); mism += ref != got; pc += got; }
    for (int s_ = t + 1 + tid; s_ < 4096; s_ += NTHREADS) pc += 4096 * (int)((MASK[s_ >> 5] >> (s_ & 31)) & 1u);
    __hip_atomic_fetch_add(&red[0], mism, __ATOMIC_RELAXED, __HIP_MEMORY_SCOPE_WORKGROUP); __hip_atomic_fetch_add(&red[1], pc, __ATOMIC_RELAXED, __HIP_MEMORY_SCOPE_WORKGROUP);
    __syncthreads();
    if (tid == 0) { const int want = t + 1 < 256 ? t + 1 : 256; if (red[1] != want) ctl[50] = 2u; else if (red[0] > MK_CHK_MISM) ctl[50] = 1u; }
    const bf16_t* Q = (const bf16_t*)(p.ws + WS_Q); const bf16_t* K = (const bf16_t*)(p.ws + WS_K); const bf16_t* V = (const bf16_t*)(p.ws + WS_V); const bf16_t* YB = (const bf16_t*)(p.ws + WS_YB);
    __syncthreads();
    for (int s_ = tid; s_ <= t; s_ += NTHREADS) { float l = -INFINITY;
        if ((MASK[s_ >> 5] >> (s_ & 31)) & 1u) { float d = 0.f; for (int k = 0; k < 64; ++k) d += bf2f(Q[row * 512 + h * 64 + k]) * bf2f(K[(rowb + s_) * 512 + h * 64 + k]);
            const int dist = t - s_; int bk = dist; if (dist >= 16) { bk = 16 + (int)(log2f((float)dist * 0.0625f) * (16.f / 3.f)); bk = bk > 31 ? 31 : bk; }
            l = d + p.in[16][bk * 8 + h] * 1.4426950408889634f; }
        sc[s_] = l; }
    __syncthreads();
    float mx = -INFINITY; for (int s_ = 0; s_ <= t; ++s_) mx = fmaxf(mx, sc[s_]);
    float den = 0.f; for (int s_ = 0; s_ <= t; ++s_) den += exp2f(sc[s_] - mx);
    { const int d = tid & 63, part = tid >> 6; float o = 0.f;
      for (int s_ = part; s_ <= t; s_ += 8) { const float l = sc[s_]; if (l > -INFINITY) o += exp2f(l - mx) * bf2f(V[(rowb + s_) * 512 + h * 64 + d]); }
      __hip_atomic_fetch_add(&ov[d], o / den, __ATOMIC_RELAXED, __HIP_MEMORY_SCOPE_WORKGROUP); }
    __syncthreads();
    if (tid < 64) { const float ref = ov[tid], got = bf2f(YB[row * 512 + h * 64 + tid]); const float df = ref - got;
        __hip_atomic_fetch_add(&redf[0], df * df, __ATOMIC_RELAXED, __HIP_MEMORY_SCOPE_WORKGROUP); __hip_atomic_fetch_add(&redf[1], ref * ref, __ATOMIC_RELAXED, __HIP_MEMORY_SCOPE_WORKGROUP); }
    __syncthreads();
    if (tid == 0) { if (!(redf[0] <= MK_CHK_ATT * redf[1] + 1e-12f)) ctl[51] = 1u; }
    __syncthreads();
}
#endif
constexpr int NPHASE = 14;
template <int PH> __device__ __forceinline__ void run_phase(const Params& p, unsigned char* lds_g) {
    LAS unsigned char* lds = (LAS unsigned char*)lds_g;
    const int G = gridDim.x, c = blockIdx.x;
    if constexpr (PH == 0) phase_prologue(p, lds);
    if constexpr (PH == 1) { Gemm g{(const bf16_t*)((char*)p.out + DO_XBF), (const bf16_t*)(p.ws + WS_WTIN), T, 6144, 1024}; pg8::StaticOrder S; S.init(T, 6144, G, c);
        EpiIn E{p.ws}; pg8::gemm_phase<EpiIn, pg8::StaticOrder, true, true>(lds, g, S, E); }
    if constexpr (PH == 2) phase_prep(p);
    if constexpr (PH == 3) { Gemm g{(const bf16_t*)(p.ws + WS_AP), (const bf16_t*)(p.ws + WS_WTLORA), T, 1536, 256}; pg8::StaticOrder S; S.init(T, 1536, G, c);
        EpiLora E{(char*)p.out}; pg8::gemm_phase<EpiLora, pg8::StaticOrder, true, true>(lds, g, S, E); }
    if constexpr (PH == 4) {
        for (int bh = c; bh < 128; bh += G) scan_item(p, lds, bh);
        LAS unsigned* qs = (LAS unsigned*)(lds + LDS_TOTAL - 32);
        for (int qi = 0; qi < 8; ++qi) { const int xq = (c + qi) & 7; unsigned* qctr = (unsigned*)(p.ws + WS_CTL) + 40 + xq;
            for (;;) { __syncthreads(); if (mk_tid() == 0) qs[0] = __hip_atomic_fetch_add(qctr, 1u, __ATOMIC_RELAXED, __HIP_MEMORY_SCOPE_AGENT); __syncthreads();
                const unsigned u = qs[0]; if (u >= 512u) break; indexer_unit(p, lds, 2 * xq + (int)(u & 1u), 255 - (int)(u >> 1)); } }
    }
    if constexpr (PH == 6) {
        LAS float* bd = (LAS float*)(lds + attn_body::LDS_BIAS);
        for (int i = mk_tid(); i < 8 * 128; i += NTHREADS) { const int h = i >> 7, d = i & 127; int bk = d;
            if (d >= 16) { bk = 16 + (int)(log2f((float)d * 0.0625f) * (16.f / 3.f)); bk = bk > 31 ? 31 : bk; }
            bd[i] = (p.in[16][bk * 8 + h] - p.in[16][31 * 8 + h]) * 1.4426950408889634f; }
        __syncthreads();
        for (int v = c; v < 256; v += G) { const int bh = v >> 1, od = v & 1;
            for (int i = 0; i < 8; ++i) { const int pr = 2 * (i >> 1) + od; const int qb = (i & 1) ? 15 - pr : pr;
                attn_body::attn_unit<8>(bh >> 3, bh & 7, qb, (const attn_body::bf16*)(p.ws + WS_Q), (const attn_body::bf16*)(p.ws + WS_K), (const attn_body::bf16*)(p.ws + WS_V),
                                        (attn_body::bf16*)(p.ws + WS_YB), (const unsigned long long*)(p.ws + WS_MASK), (char*)lds_g); } }
    }
    if constexpr (PH == 7) { Gemm g{(const bf16_t*)((char*)p.out + DO_YA), (const bf16_t*)(p.ws + WS_WTA), T, 1024, 512}; pg8::StaticOrder S; S.init(T, 1024, G, c);
        EpiGateMul E{(const bf16_t*)(p.ws + WS_SGA), (bf16_t*)(p.ws + WS_MA), nullptr}; pg8::gemm_phase<EpiGateMul, pg8::StaticOrder, true, true>(lds, g, S, E); }
    if constexpr (PH == 8) { Gemm g{(const bf16_t*)(p.ws + WS_YB), (const bf16_t*)(p.ws + WS_WTB), T, 1024, 512}; pg8::StaticOrder S; S.init(T, 1024, G, c);
        EpiGateMul E{(const bf16_t*)(p.ws + WS_SGB), (bf16_t*)(p.ws + WS_SGA), (const bf16_t*)(p.ws + WS_MA)}; pg8::gemm_phase<EpiGateMul, pg8::StaticOrder, true, true>(lds, g, S, E); }
    if constexpr (PH == 9) { Gemm g{(const bf16_t*)(p.ws + WS_SGA), (const bf16_t*)(p.ws + WS_WTOUT), T, 1024, 1024}; pg8::StaticOrder S; S.init(T, 1024, G, c);
        EpiResid E{p.in[0], p.out, 1.189207115002721f}; pg8::gemm_phase<EpiResid, pg8::StaticOrder, true, true>(lds, g, S, E); }
    if constexpr (PH == 10) phase_ln_router(p, lds);
    if constexpr (PH == 11) { LAS int* tab = (LAS int*)(lds + LDS_TAB); moe_tables(p, tab); phase_permute(p, tab); }
    if constexpr (PH == 12) { LAS int* tab = (LAS int*)(lds + LDS_TAB); moe_tables(p, tab);
        { Gemm g{(const bf16_t*)(p.ws + WS_XS), (const bf16_t*)(p.ws + WS_WTGU), NROWS_PAD, 32 * 1024, 1024}; MoeOrder S{tab, G, c};
          EpiSwiglu E{(bf16_t*)(p.ws + WS_ACT)}; pg8::gemm_phase<EpiSwiglu, MoeOrder, true, true>(lds, g, S, E); } }
    if constexpr (PH == 13) { LAS int* tab = (LAS int*)(lds + LDS_TAB); moe_tables(p, tab);
        { Gemm g{(const bf16_t*)(p.ws + WS_ACT), (const bf16_t*)(p.ws + WS_WTDN), NROWS_PAD, 32 * 1024, 512}; MoeOrder S{tab, G, c};
          EpiDown E{(bf16_t*)(p.ws + WS_XS)}; pg8::gemm_phase<EpiDown, MoeOrder, true, true>(lds, g, S, E); } }
    if constexpr (PH == 14) { LAS int* tab = (LAS int*)(lds + LDS_TAB); moe_tables(p, tab); phase_final(p, tab); }
}

template <int PH> __global__ void __launch_bounds__(NTHREADS, 2) k_phase(Params p) {
    extern __shared__ __attribute__((aligned(16))) unsigned char lds[];
    run_phase<PH>(p, lds);
}
__global__ void __launch_bounds__(NTHREADS, 2) k_all(Params p) {
    extern __shared__ __attribute__((aligned(16))) unsigned char lds[];
    cooperative_groups::grid_group grid = cooperative_groups::this_grid();
    unsigned* barw = (unsigned*)(p.ws + WS_CTL) + 16384;
    volatile LAS unsigned* bst = (volatile LAS unsigned*)((LAS unsigned char*)lds + LDS_TOTAL - 16);
    if (mk_tid() < 2) bst[mk_tid()] = 0u;
    if (blockIdx.x == 0) for (int i = mk_tid(); i < XCD_BAR_WORDS; i += NTHREADS) barw[i] = 0u;
    __syncthreads();
#ifndef MK_REP
#define MK_REP -1
#endif
#define MK_DRY() (((volatile unsigned*)(p.ws + WS_CTL))[62] == 0u)
#define MK_PH(n) do { run_phase<n>(p, lds); xcd_barrier(bar); if (MK_REP == (n)) { run_phase<n>(p, lds); xcd_barrier(bar); } } while (0)
    run_phase<0>(p, lds); grid.sync();
    const XcdBarrier bar = xcd_barrier_post(barw, bst);
    MK_PH(1); MK_PH(2); MK_PH(3); MK_PH(4);
    if (MK_REP == 44) { if (blockIdx.x == 0 && mk_tid() < 8) __hip_atomic_store((unsigned*)(p.ws + WS_CTL) + 40 + mk_tid(), 0u, __ATOMIC_RELAXED, __HIP_MEMORY_SCOPE_AGENT); xcd_barrier(bar); run_phase<4>(p, lds); xcd_barrier(bar); }
    MK_PH(6);
#ifdef MK_CHK
    phase_check(p, (LAS unsigned char*)lds); xcd_barrier(bar);
#endif
    run_phase<7>(p, lds); if (MK_REP == 7) run_phase<7>(p, lds);
    MK_PH(8); MK_PH(9); MK_PH(10); MK_PH(11); MK_PH(12); MK_PH(13);
    if (MK_REP >= 401 && MK_REP <= 409) { if (blockIdx.x == 0 && mk_tid() < 8) __hip_atomic_store((unsigned*)(p.ws + WS_CTL) + 40 + mk_tid(), 0u, __ATOMIC_RELAXED, __HIP_MEMORY_SCOPE_AGENT); xcd_barrier(bar);
        { LAS unsigned* qs = (LAS unsigned*)((LAS unsigned char*)lds + LDS_TOTAL - 32); const int c = blockIdx.x;
          for (int qi = 0; qi < 8; ++qi) { const int xq = (c + qi) & 7; unsigned* qctr = (unsigned*)(p.ws + WS_CTL) + 40 + xq;
            for (;;) { __syncthreads(); if (mk_tid() == 0) qs[0] = __hip_atomic_fetch_add(qctr, 1u, __ATOMIC_RELAXED, __HIP_MEMORY_SCOPE_AGENT); __syncthreads();
                const unsigned u = qs[0]; if (u >= 512u) break; indexer_unit(p, (LAS unsigned char*)lds, 2 * xq + (int)(u & 1u), 255 - (int)(u >> 1), MK_REP - 401); } } }
        xcd_barrier(bar); }
    if (MK_REP == 200) { for (int i = 0; i < 20; ++i) xcd_barrier(bar); }
    run_phase<14>(p, lds);
    if (MK_REP == 14) { xcd_barrier(bar); run_phase<14>(p, lds); }
}
}

extern "C" void kernel_launch(void* const* d_in, const int* in_sizes, int n_in, void* d_out, int out_size,
                              void* d_ws, size_t ws_size, hipStream_t stream) {
    mk::Params p{};
    for (int i = 0; i < 30; ++i) p.in[i] = (const float*)d_in[i];
    p.out = (float*)d_out; p.ws = (char*)d_ws;
    if (ws_size < mk::WS_END) { fprintf(stderr, "workspace too small: %zu\n", ws_size); return; }
    static int grid_blocks = 0;
    if (!grid_blocks) {
        int dev = 0, cus = 0, per_cu = 0;
        (void)hipGetDevice(&dev);
        (void)hipDeviceGetAttribute(&cus, hipDeviceAttributeMultiprocessorCount, dev);
        (void)hipFuncSetAttribute((const void*)mk::k_all, hipFuncAttributeMaxDynamicSharedMemorySize, mk::LDS_TOTAL);
        (void)hipOccupancyMaxActiveBlocksPerMultiprocessor(&per_cu, mk::k_all, mk::NTHREADS, mk::LDS_TOTAL);
        grid_blocks = cus * (per_cu > 1 ? 1 : per_cu);
    }
    void* args[] = {&p};
    hipError_t e = hipLaunchCooperativeKernel((void*)mk::k_all, dim3(grid_blocks), dim3(mk::NTHREADS), args, mk::LDS_TOTAL, stream);
    if (e != hipSuccess) fprintf(stderr, "cooperative launch failed: %s (grid %d)\n", hipGetErrorString(e), grid_blocks);
}
```

```cpp
#include <hip/hip_runtime.h>
#include <hip/hip_bf16.h>
#include <hip/hip_cooperative_groups.h>
#include <cstdio>
#include <cstdint>
#include <cmath>
__device__ __forceinline__ int mk_tid() { int t = threadIdx.x; asm volatile("" : "+v"(t)); return t; }
#define LAS __attribute__((address_space(3)))
#define XB_TMO      128
#define XB_XCNT(j)  (256  + 64 * (j))
#define XB_XSUB(j)  (1280 + 64 * (j))
#define XB_XGEN(j)  (2304 + 64 * (j))
#define XB_TOP      3328
#define XB_TOPGEN   3392
#define XCD_BAR_WORDS 3456
#define XB_SPIN_CAP (1u << 18)

__device__ __forceinline__ unsigned xb_ld(unsigned* p)              { return __hip_atomic_load(p, __ATOMIC_RELAXED, __HIP_MEMORY_SCOPE_AGENT); }
__device__ __forceinline__ unsigned xb_add(unsigned* p, unsigned v) { return __hip_atomic_fetch_add(p, v, __ATOMIC_RELAXED, __HIP_MEMORY_SCOPE_AGENT); }
__device__ __forceinline__ unsigned xb_xcc_id() { return (unsigned)__builtin_amdgcn_s_getreg((3 << 11) | 20) & 0xFu; }
#define XB_SPIN(cond, bar) do { unsigned _sp = 0; while (cond) { __builtin_amdgcn_s_sleep(1); \
    if ((++_sp & 255u) == 0u) { if (xb_ld(&(bar)[XB_TMO])) break; if (_sp > XB_SPIN_CAP) { atomicAdd(&(bar)[XB_TMO], 1u); break; } } } } while (0)

struct XcdBarrier {
    unsigned* bar; unsigned x;
    volatile LAS unsigned* st;
};

__device__ __forceinline__ XcdBarrier xcd_barrier_post(unsigned* bar, volatile LAS unsigned* st) {
    XcdBarrier b; b.bar = bar; b.x = xb_xcc_id(); b.st = st;
    if (mk_tid() == 0) (void)xb_add(&bar[XB_XCNT(b.x)], 1u);
    return b;
}
__device__ __forceinline__ void xcd_barrier_complete(unsigned* bar, unsigned x, unsigned& nloc, unsigned& nx) {
    const unsigned G = gridDim.x * gridDim.y * gridDim.z;
    unsigned sum, cnt, mine, sp = 0u;
    for (;;) {
        sum = 0u; cnt = 0u; mine = 0u;
#pragma unroll
        for (unsigned j = 0; j < 16; ++j) { const unsigned c = xb_ld(&bar[XB_XCNT(j)]); sum += c; cnt += (c > 0u) ? 1u : 0u; mine = (j == x) ? c : mine; }
        if (sum == G) break;
        __builtin_amdgcn_s_sleep(1);
        if ((++sp & 255u) == 0u) { if (xb_ld(&bar[XB_TMO])) break; if (sp > XB_SPIN_CAP) { atomicAdd(&bar[XB_TMO], 1u); break; } }
    }
    nloc = mine > 0u ? mine : 1u; nx = cnt > 0u ? cnt : 1u;
}

__device__ __forceinline__ void xcd_barrier(const XcdBarrier& b) {
    asm volatile("s_waitcnt vmcnt(0)" ::: "memory");
    __syncthreads();
    if (mk_tid() == 0) {
        unsigned* bar = b.bar;
        __builtin_amdgcn_s_waitcnt(0);
        unsigned nloc = b.st[0], nx = b.st[1];
        if (nloc == 0u) { xcd_barrier_complete(bar, b.x, nloc, nx); b.st[0] = nloc; b.st[1] = nx; }
        const unsigned old = xb_add(&bar[XB_XSUB(b.x)], 1u);
        const unsigned gen = old / nloc;
        if (old + 1u == (gen + 1u) * nloc) {
            __builtin_amdgcn_fence(__ATOMIC_RELEASE, "agent");
            asm volatile("s_waitcnt vmcnt(0)" ::: "memory");
            const unsigned og = xb_add(&bar[XB_TOP], 1u);
            const unsigned tg = og / nx;
            if (og + 1u == (tg + 1u) * nx) xb_add(&bar[XB_TOPGEN], 1u);
            else XB_SPIN(xb_ld(&bar[XB_TOPGEN]) == tg, bar);
            __builtin_amdgcn_fence(__ATOMIC_ACQUIRE, "agent");
            xb_add(&bar[XB_XGEN(b.x)], 1u);
            asm volatile("s_waitcnt vmcnt(0)" ::: "memory");
        } else {
            XB_SPIN(xb_ld(&bar[XB_XGEN(b.x)]) == gen, bar);
            __builtin_amdgcn_fence(__ATOMIC_ACQUIRE, "agent");
            asm volatile("s_waitcnt vmcnt(0)" ::: "memory");
        }
    }
    __syncthreads();
}

namespace pg8 {
#define PG8_LAS __attribute__((address_space(3)))
typedef unsigned short bf16_t;
typedef short bf16x8 __attribute__((ext_vector_type(8)));
typedef float f32x4 __attribute__((ext_vector_type(4)));
typedef unsigned u32x4 __attribute__((ext_vector_type(4)));
constexpr int BM = 256, BK = 64, HALF = 128, HTB = HALF * BK * 2  , STAGE_BYTES = 8 * HTB, NXCD = 8, WGM = 8;

__host__ __device__ __forceinline__ int lds_byte(int r, int c) { const int st = (r >> 4) * 2 + (c >> 5), rr = r & 15, cc = c & 31, ob = rr * 64 + cc * 2; return st * 1024 + (ob ^ (((ob >> 9) & 1) << 5)); }
__host__ __device__ __forceinline__ void stage_rc(int b, int& R, int& C) { const int st = b / 1024, sb = b % 1024, swz = sb ^ (((sb >> 9) & 1) << 5); R = (st >> 1) * 16 + swz / 64; C = (st & 1) * 32 + (swz % 64) / 2; }
__host__ __device__ __forceinline__ int perm32(int rho) { const int n = rho >> 4, i = rho & 15; return 8 * (i >> 2) + 4 * n + (i & 3); }

struct Unit { int pm, pn; };
struct Gemm { const bf16_t* A; const bf16_t* Bt; int M, N, K; };

struct StaticOrder {
    int nM, nN, nwg, G, c;
    __host__ __device__ void init(int M, int N, int G_, int c_) { nM = M / BM; nN = N / BM; nwg = nM * nN; G = G_; c = c_; }
    __host__ __device__ bool next(int i, Unit& u) const {
        const long L = (long)i * G + c; if (L >= nwg) return false;
        int wgid = (int)L; { const int q = nwg / NXCD, r = nwg % NXCD, xcd = wgid % NXCD, off = wgid / NXCD; wgid = (xcd < r ? xcd * (q + 1) : r * (q + 1) + (xcd - r) * q) + off; }
        const int nig = WGM * nN, gid = wgid / nig, fm = gid * WGM, gsz = (nM - fm) < WGM ? (nM - fm) : WGM;
        u.pm = fm + ((wgid % nig) % gsz); u.pn = (wgid % nig) / gsz; return true;
    }
    __device__ __forceinline__ void a_ready(const Unit&) const {}
    __device__ __forceinline__ void done(const Unit&) const {}
};

__device__ __forceinline__ unsigned cvt_pk_bf16(float lo, float hi) { unsigned r; asm volatile("v_cvt_pk_bf16_f32 %0, %1, %2" : "=v"(r) : "v"(lo), "v"(hi)); return r; }

template <class Epi, class Sched, bool ALIGN_EPI = false, bool SP2 = false, bool GATHER = false>
__device__ __forceinline__ void gemm_phase(PG8_LAS unsigned char* lds, const Gemm g, const Sched& S, const Epi& E) {
    const int tid = mk_tid(), wid = __builtin_amdgcn_readfirstlane(tid >> 6), lane = tid & 63, wr = wid >> 2, wc = wid & 3, fr = lane & 15, fq = lane >> 4;
    const int K = g.K, nt = K / BK;
    unsigned voffA[2], voffB[2];
#pragma unroll
    for (int i = 0; i < 2; ++i) { int R, C; stage_rc(tid * 16 + i * 8192, R, C); const int Rb = Epi::PERM ? ((R & ~31) + perm32(R & 31)) : R;
        voffA[i] = (unsigned)(R * K + C) * 2u; voffB[i] = (unsigned)(Rb * K + C) * 2u; }
    const size_t kstep = (size_t)(BK * 2);
    const size_t hstep = (size_t)HALF * K * 2;
    const size_t tstep = 2 * hstep;
    const unsigned ldsw = (unsigned)wid * 1024u;
    const int aoff = lds_byte(wr * 64 + fr, fq * 8), boff = lds_byte(wc * 32 + fr, fq * 8);
#define PG8_SA(b, h) (((b) * 2 + (h)) * HTB)
#define PG8_SB(b, h) ((4 + (b) * 2 + (h)) * HTB)
#define PG8_STAGE(bufoff, gbase, voff) do { _Pragma("unroll") for (int _i = 0; _i < 2; ++_i) \
        __builtin_amdgcn_global_load_lds((const unsigned*)((const char*)(gbase) + (voff)[_i]), (PG8_LAS unsigned*)(lds + (bufoff) + ldsw + _i * 8192), 16, 0, 0); } while (0)
#define PG8_LDA(dst, b, h) do { _Pragma("unroll") for (int m = 0; m < 4; ++m) _Pragma("unroll") for (int k = 0; k < 2; ++k) dst[m][k] = *(const PG8_LAS bf16x8*)(lds + PG8_SA(b, h) + aoff + m * 2048 + k * 1024); } while (0)
#define PG8_LDB(dst, b, h) do { _Pragma("unroll") for (int n = 0; n < 2; ++n) _Pragma("unroll") for (int k = 0; k < 2; ++k) dst[n][k] = *(const PG8_LAS bf16x8*)(lds + PG8_SB(b, h) + boff + n * 2048 + k * 1024); } while (0)
#define PG8_MMA(ai, bj, At, Bt) do { __builtin_amdgcn_s_setprio(1); _Pragma("unroll") for (int m = 0; m < 4; ++m) _Pragma("unroll") for (int n = 0; n < 2; ++n) _Pragma("unroll") for (int k = 0; k < 2; ++k) \
        acc[ai][bj][m][n] = __builtin_amdgcn_mfma_f32_16x16x32_bf16(Bt[n][k], At[m][k], acc[ai][bj][m][n], 0, 0, 0); __builtin_amdgcn_s_setprio(0); } while (0)
#define PG8_WAIT_V(n) asm volatile("s_waitcnt vmcnt(" #n ")" ::: "memory")
#define PG8_WAIT_L(n) asm volatile("s_waitcnt lgkmcnt(" #n ")" ::: "memory")
#define PG8_BAR __builtin_amdgcn_s_barrier()
#define PG8_SCHED __builtin_amdgcn_sched_barrier(0)
    Unit cur, nxt; int ui = 0;
    if (!S.next(0, cur)) return;
    f32x4 acc[2][2][4][2];
#pragma unroll
    for (int a = 0; a < 2; ++a)
#pragma unroll
        for (int b = 0; b < 2; ++b)
#pragma unroll
            for (int m = 0; m < 4; ++m)
#pragma unroll
                for (int n = 0; n < 2; ++n) acc[a][b][m][n] = (f32x4){0.f, 0.f, 0.f, 0.f};
    bf16x8 At[4][2], B0[2][2], B1[2][2];
    static_assert(!GATHER || SP2, "row gather is wired into the SP2 loop only");
    const char* cA = GATHER ? (const char*)g.A : (const char*)g.A + (size_t)cur.pm * tstep; const char* cB = (const char*)g.Bt + (size_t)cur.pn * tstep;
    unsigned vA0[2] = {0u, 0u}, vA1[2] = {0u, 0u}, nvA0[2] = {0u, 0u}, nvA1[2] = {0u, 0u};
#define PG8_GOFF(u_, o0_, o1_) do { _Pragma("unroll") for (int i = 0; i < 2; ++i) { int R_, C_; stage_rc(tid * 16 + i * 8192, R_, C_); \
        o0_[i] = (unsigned)(S.srcrow(u_, R_) * K + C_) * 2u; o1_[i] = (unsigned)(S.srcrow(u_, HALF + R_) * K + C_) * 2u; } } while (0)
    if constexpr (GATHER) { PG8_GOFF(cur, vA0, vA1); nvA0[0] = vA0[0]; nvA0[1] = vA0[1]; nvA1[0] = vA1[0]; nvA1[1] = vA1[1]; }
#define PG8_STAGE_A(bufoff, base, half, OFF0, OFF1) do { if constexpr (GATHER) { if (half) PG8_STAGE(bufoff, base, OFF1); else PG8_STAGE(bufoff, base, OFF0); } \
        else { PG8_STAGE(bufoff, (base) + ((half) ? hstep : (size_t)0), voffA); } } while (0)
    S.a_ready(cur);
    if constexpr (SP2) {
        PG8_STAGE(PG8_SB(0, 0), cB, voffB); PG8_STAGE(PG8_SB(0, 1), cB + hstep, voffB); PG8_STAGE_A(PG8_SA(0, 0), cA, 0, vA0, vA1); PG8_STAGE_A(PG8_SA(0, 1), cA, 1, vA0, vA1);
        if (wr == 1) PG8_BAR;
        PG8_WAIT_V(2); PG8_BAR;
        PG8_STAGE(PG8_SB(1, 0), cB + kstep, voffB); PG8_STAGE_A(PG8_SA(1, 0), cA + kstep, 0, vA0, vA1); PG8_STAGE(PG8_SB(1, 1), cB + hstep + kstep, voffB);
        PG8_WAIT_V(6); PG8_BAR;
    } else {
        PG8_STAGE(PG8_SB(0, 0), cB, voffB); PG8_STAGE(PG8_SA(0, 0), cA, voffA); PG8_STAGE(PG8_SB(0, 1), cB + hstep, voffB); PG8_STAGE(PG8_SA(0, 1), cA + hstep, voffA);
        if (wr == 1) PG8_BAR;
        PG8_WAIT_V(4); PG8_BAR;
        PG8_STAGE(PG8_SB(1, 0), cB + kstep, voffB); PG8_STAGE(PG8_SA(1, 0), cA + kstep, voffA); PG8_STAGE(PG8_SB(1, 1), cB + hstep + kstep, voffB);
        PG8_WAIT_V(6); PG8_BAR;
    }
    for (;;) {
        const bool has_next = S.next(ui + 1, nxt);
        const char* nA = GATHER ? cA : (has_next ? (const char*)g.A + (size_t)nxt.pm * tstep : cA); const char* nB = has_next ? (const char*)g.Bt + (size_t)nxt.pn * tstep : cB;
        if constexpr (GATHER) { if (has_next) PG8_GOFF(nxt, nvA0, nvA1); }
        for (int t = 0; t < nt; t += 2) {
            const bool last = (t == nt - 2);
            const char* a1 = cA + (size_t)(t + 1) * kstep;
            const char* a2 = last ? nA : cA + (size_t)(t + 2) * kstep; const char* b2 = last ? nB : cB + (size_t)(t + 2) * kstep;
            const char* a3 = a2 + kstep; const char* b3 = b2 + kstep;
            if (last && has_next) S.a_ready(nxt);
            if constexpr (SP2) {
            unsigned sA0[2] = {0u, 0u}, sA1[2] = {0u, 0u};
            if constexpr (GATHER) { sA0[0] = last ? nvA0[0] : vA0[0]; sA0[1] = last ? nvA0[1] : vA0[1]; sA1[0] = last ? nvA1[0] : vA1[0]; sA1[1] = last ? nvA1[1] : vA1[1]; }
            PG8_LDB(B0, 0, 0); PG8_LDB(B1, 0, 1); PG8_SCHED; PG8_LDA(At, 0, 0); PG8_STAGE_A(PG8_SA(1, 1), a1, 1, vA0, vA1);
            PG8_WAIT_V(8); PG8_WAIT_L(0); PG8_BAR; PG8_MMA(0, 0, At, B0); PG8_MMA(0, 1, At, B1); PG8_BAR; PG8_SCHED;
            PG8_LDA(At, 0, 1); PG8_STAGE(PG8_SB(0, 0), b2, voffB); PG8_STAGE(PG8_SB(0, 1), b2 + hstep, voffB); PG8_STAGE_A(PG8_SA(0, 0), a2, 0, sA0, sA1);
            PG8_WAIT_V(8); PG8_WAIT_L(0); PG8_BAR; PG8_MMA(1, 0, At, B0); PG8_MMA(1, 1, At, B1); PG8_BAR; PG8_SCHED;
            PG8_LDB(B0, 1, 0); PG8_LDB(B1, 1, 1); PG8_SCHED; PG8_LDA(At, 1, 0); PG8_STAGE_A(PG8_SA(0, 1), a2, 1, sA0, sA1);
            PG8_WAIT_V(8); PG8_WAIT_L(0); PG8_BAR; PG8_MMA(0, 0, At, B0); PG8_MMA(0, 1, At, B1); PG8_BAR; PG8_SCHED;
            PG8_LDA(At, 1, 1); PG8_STAGE(PG8_SB(1, 0), b3, voffB); PG8_STAGE(PG8_SB(1, 1), b3 + hstep, voffB); PG8_STAGE_A(PG8_SA(1, 0), a3, 0, sA0, sA1);
            PG8_WAIT_V(8); PG8_WAIT_L(0); PG8_BAR; PG8_MMA(1, 0, At, B0); PG8_MMA(1, 1, At, B1); PG8_BAR; PG8_SCHED;
            } else {
            PG8_LDB(B0, 0, 0); PG8_SCHED; PG8_LDA(At, 0, 0); PG8_STAGE(PG8_SA(1, 1), a1 + hstep, voffA);
            PG8_WAIT_L(8); PG8_BAR; PG8_WAIT_L(0); PG8_MMA(0, 0, At, B0); PG8_BAR; PG8_SCHED;
            PG8_LDB(B1, 0, 1); PG8_STAGE(PG8_SB(0, 0), b2, voffB);
            PG8_BAR; PG8_WAIT_L(0); PG8_MMA(0, 1, At, B1); PG8_BAR;
            PG8_LDA(At, 0, 1); PG8_STAGE(PG8_SA(0, 0), a2, voffA);
            PG8_BAR; PG8_WAIT_L(0); PG8_MMA(1, 0, At, B0); PG8_BAR; PG8_SCHED;
            PG8_STAGE(PG8_SB(0, 1), b2 + hstep, voffB);
            PG8_WAIT_V(6); PG8_BAR; PG8_MMA(1, 1, At, B1); PG8_BAR;
            PG8_LDB(B0, 1, 0); PG8_SCHED; PG8_LDA(At, 1, 0); PG8_STAGE(PG8_SA(0, 1), a2 + hstep, voffA);
            PG8_WAIT_L(8); PG8_BAR; PG8_WAIT_L(0); PG8_MMA(0, 0, At, B0); PG8_BAR; PG8_SCHED;
            PG8_LDB(B1, 1, 1); PG8_STAGE(PG8_SB(1, 0), b3, voffB);
            PG8_BAR; PG8_WAIT_L(0); PG8_MMA(0, 1, At, B1); PG8_BAR;
            PG8_LDA(At, 1, 1); PG8_STAGE(PG8_SA(1, 0), a3, voffA);
            PG8_BAR; PG8_WAIT_L(0); PG8_MMA(1, 0, At, B0); PG8_BAR; PG8_SCHED;
            PG8_STAGE(PG8_SB(1, 1), b3 + hstep, voffB);
            PG8_WAIT_V(6); PG8_BAR; PG8_MMA(1, 1, At, B1); PG8_BAR;
            }
        }
        if constexpr (ALIGN_EPI) { if (wr == 0) PG8_BAR; }
        if constexpr (!Epi::AFTER_DRAIN) { E(acc, cur, wr, wc, fr, fq); S.done(cur); }
        if (!has_next) break;
#pragma unroll
        for (int a = 0; a < 2; ++a)
#pragma unroll
            for (int b = 0; b < 2; ++b)
#pragma unroll
                for (int m = 0; m < 4; ++m)
#pragma unroll
                    for (int n = 0; n < 2; ++n) acc[a][b][m][n] = (f32x4){0.f, 0.f, 0.f, 0.f};
        cur = nxt; cA = nA; cB = nB; ++ui;
#pragma unroll
        for (int i = 0; i < 2; ++i) { vA0[i] = nvA0[i]; vA1[i] = nvA1[i]; }
        (void)sizeof(vA0);
        if constexpr (ALIGN_EPI) { if (wr == 1) PG8_BAR; }
    }
    PG8_WAIT_V(0);
    if constexpr (!ALIGN_EPI) { if (wr == 0) PG8_BAR; }
    PG8_BAR;
    if constexpr (Epi::AFTER_DRAIN) { E.fused(acc, cur, wr, wc, fr, fq, lds, wid, lane); S.done(cur); }
#undef PG8_SA
#undef PG8_GOFF
#undef PG8_STAGE_A
#undef PG8_SB
#undef PG8_STAGE
#undef PG8_LDA
#undef PG8_LDB
#undef PG8_MMA
#undef PG8_WAIT_V
#undef PG8_WAIT_L
#undef PG8_BAR
#undef PG8_SCHED
}
}
namespace attn_body {
using bf16=__hip_bfloat16;
using bf16x8=__attribute__((ext_vector_type(8)))short;
using s16x4=__attribute__((ext_vector_type(4)))short;
using f32x16=__attribute__((ext_vector_type(16)))float;
using u32x4=__attribute__((ext_vector_type(4)))unsigned;
constexpr int BATCH=16,NHEAD=8,SEQ=4096,D=64,DM=NHEAD*D;
constexpr int NW=8,QBLK=32,QB=QBLK*NW,KVBLK=64,NQB=SEQ/QB;
constexpr int ATTN_PITCH=DM, ATTN_UNIT_ROWS=QB;
__device__ __forceinline__ int crow(int r,int hi){return (r&3)+8*(r>>2)+4*hi;}
#define SBAR() __builtin_amdgcn_sched_barrier(0)
__device__ __forceinline__ void biasw(f32x16&p0,f32x16&p1,int dbase,const __attribute__((address_space(3))) float*bdl){
  #pragma unroll
  for(int r=0;r<16;++r){const int pos=(r&3)+8*(r>>2);
    int d0=dbase-pos, d1=d0-32; d0=d0<0?0:(d0>127?127:d0); d1=d1<0?0:(d1>127?127:d1); p0[r]+=bdl[d0]; p1[r]+=bdl[d1]; }
}
#define MPOS(r) (((r)&3)+8*((r)>>2))
__device__ __forceinline__ float mand(float p,unsigned w,int pos){ return __builtin_bit_cast(float,__builtin_bit_cast(unsigned,p)&(unsigned)__builtin_amdgcn_sbfe((int)w,pos,1)); }

constexpr int NSLOT=3, SLOTB=8192;
constexpr int LDS_K=0, LDS_V=NSLOT*SLOTB, LDS_WS=2*NSLOT*SLOTB, LDS_OST=LDS_WS+NW*64*4, LDS_BIAS=LDS_OST+NW*4096, LDS_BYTES=LDS_BIAS+NHEAD*128*4;
constexpr float C2=0.125f*1.4426950408889634f;
__device__ __forceinline__ void glds16(const void*gsrc,unsigned lds_dst){unsigned keep;
  asm volatile("s_mov_b32 %0, m0\n\ts_mov_b32 m0, %2\n\ts_nop 0\n\tglobal_load_lds_dwordx4 %1, off\n\ts_mov_b32 m0, %0":"=&s"(keep):"v"(gsrc),"s"(lds_dst):"memory");}
__device__ __forceinline__ float max3f(float a,float b,float c){float r;asm("v_max3_f32 %0, %1, %2, %3":"=v"(r):"v"(a),"v"(b),"v"(c));return r;}
__device__ __forceinline__ float max2f(float a,float b){float r;asm("v_max_f32_e32 %0, %1, %2":"=v"(r):"v"(a),"v"(b));return r;}
__device__ __forceinline__ float fadd_s(float a,float b){float r;asm("v_add_f32_e32 %0, %1, %2":"=v"(r):"v"(a),"v"(b));return r;}
__device__ __forceinline__ float fsub_s(float a,float b){float r;asm("v_sub_f32_e32 %0, %1, %2":"=v"(r):"v"(a),"v"(b));return r;}
typedef float f32x2_t __attribute__((ext_vector_type(2))); typedef __bf16 bf16x2_t __attribute__((ext_vector_type(2)));
__device__ __forceinline__ unsigned cvtpk_s(float lo,float hi){f32x2_t v={lo,hi};bf16x2_t b=__builtin_convertvector(v,bf16x2_t);return __builtin_bit_cast(unsigned,b);}
#define WAIT_BAR(N) asm volatile("s_waitcnt vmcnt(" #N ") lgkmcnt(0)\n\ts_barrier":::"memory")

__device__ __forceinline__ void qkt(f32x16&p0,f32x16&p1,const char*Kslot,const bf16x8*qr,const f32x16&negm,int r32,int hi){
  const char*kb=Kslot+hi*1024+r32*16;
  #pragma unroll
  for(int d0=0;d0<4;++d0){
    const bf16x8 b0=*reinterpret_cast<const bf16x8*>(kb+d0*2048);
    const bf16x8 b1=*reinterpret_cast<const bf16x8*>(kb+d0*2048+512);
    if(d0==0){p0=__builtin_amdgcn_mfma_f32_32x32x16_bf16(b0,qr[0],negm,0,0,0);p1=__builtin_amdgcn_mfma_f32_32x32x16_bf16(b1,qr[0],negm,0,0,0);}
    else{p0=__builtin_amdgcn_mfma_f32_32x32x16_bf16(b0,qr[d0],p0,0,0,0);p1=__builtin_amdgcn_mfma_f32_32x32x16_bf16(b1,qr[d0],p1,0,0,0);}}
}
typedef __attribute__((address_space(3))) const char* lds_cptr;
typedef short v4i16_t __attribute__((ext_vector_type(4)));
__device__ __forceinline__ void kload8(bf16x8*kf,lds_cptr kp){
  kf[0]=*(const __attribute__((address_space(3))) bf16x8*)(kp);      kf[1]=*(const __attribute__((address_space(3))) bf16x8*)(kp+512);
  kf[2]=*(const __attribute__((address_space(3))) bf16x8*)(kp+2048); kf[3]=*(const __attribute__((address_space(3))) bf16x8*)(kp+2560);
  kf[4]=*(const __attribute__((address_space(3))) bf16x8*)(kp+4096); kf[5]=*(const __attribute__((address_space(3))) bf16x8*)(kp+4608);
  kf[6]=*(const __attribute__((address_space(3))) bf16x8*)(kp+6144); kf[7]=*(const __attribute__((address_space(3))) bf16x8*)(kp+6656);
}
__device__ __forceinline__ void kload2(bf16x8*kf,lds_cptr kp,int j){ kf[2*j]=*(const __attribute__((address_space(3))) bf16x8*)(kp+j*2048); kf[2*j+1]=*(const __attribute__((address_space(3))) bf16x8*)(kp+j*2048+512); }
__device__ __forceinline__ s16x4 vtr(lds_cptr p){ return __builtin_bit_cast(s16x4,__builtin_amdgcn_ds_read_tr16_b64_v4i16((__attribute__((address_space(3))) v4i16_t*)p)); }
__device__ __forceinline__ float rowmax(const f32x16&p0,const f32x16&p1){
  float a=max3f(p0[0],p0[1],p1[0]),b=max3f(p0[2],p0[3],p1[1]);a=max3f(a,p1[2],p1[3]);
  #pragma unroll
  for(int r=4;r<16;r+=4){a=max3f(a,p0[r],p0[r+1]);b=max3f(b,p0[r+2],p0[r+3]);a=max3f(a,p1[r],p1[r+1]);b=max3f(b,p1[r+2],p1[r+3]);}
  const float m=max2f(a,b);
  auto rr=__builtin_amdgcn_permlane32_swap(__float_as_uint(m),__float_as_uint(m),false,false);
  return max2f(__uint_as_float(rr[0]),__uint_as_float(rr[1]));
}
__device__ __forceinline__ void pv(f32x16*o,int vb,bf16x8 pa0,bf16x8 pa1,bf16x8 pa2,bf16x8 pa3){
  #pragma unroll
  for(int d0=0;d0<2;++d0){s16x4 lo[4],hi[4];
    #pragma unroll
    for(int ks=0;ks<4;++ks){
      asm volatile("ds_read_b64_tr_b16 %0,%1 offset:%c2":"=&v"(lo[ks]):"v"(vb),"i"(d0*4096+ks*1024):"memory");
      asm volatile("ds_read_b64_tr_b16 %0,%1 offset:%c2":"=&v"(hi[ks]):"v"(vb),"i"(d0*4096+ks*1024+512):"memory");}
    asm volatile("s_waitcnt lgkmcnt(0)":::"memory");SBAR();
    #define PK(k) (bf16x8){lo[k][0],lo[k][1],lo[k][2],lo[k][3],hi[k][0],hi[k][1],hi[k][2],hi[k][3]}
    o[d0]=__builtin_amdgcn_mfma_f32_32x32x16_bf16(pa0,PK(0),o[d0],0,0,0);
    o[d0]=__builtin_amdgcn_mfma_f32_32x32x16_bf16(pa1,PK(1),o[d0],0,0,0);
    o[d0]=__builtin_amdgcn_mfma_f32_32x32x16_bf16(pa2,PK(2),o[d0],0,0,0);
    o[d0]=__builtin_amdgcn_mfma_f32_32x32x16_bf16(pa3,PK(3),o[d0],0,0,0);
    #undef PK
  }
}

#ifndef ATTN_STORE16
#define ATTN_STORE16(p,v) (*(u32x4*)(p)=(v))
#endif
template<int THRL> __device__ __forceinline__ void attn_unit(int b,int h,int qb,const bf16*Q,const bf16*__restrict__ K,const bf16*__restrict__ V,bf16*O,const unsigned long long*MK,char*shm){
  const int tid=mk_tid(),lane=tid&63,r32=lane&31,hi=lane>>5; const int wid=__builtin_amdgcn_readfirstlane(tid>>6);
  const long rowbase=(long)b*SEQ; const int q0=qb*QB;
  const bf16*Qw=Q+(rowbase+q0+wid*QBLK)*DM+h*D;
  const bf16*Kh=K+rowbase*DM+h*D,*Vh=V+rowbase*DM+h*D;
  const lds_cptr shm3=(lds_cptr)shm;
  const unsigned lds0=(unsigned)(uintptr_t)shm;
  float*wsf=(float*)(shm+LDS_WS)+wid*64;
  const bf16*ksrc=Kh+(long)lane*DM+wid*8;
  const bf16*vsrc=Vh+(long)(16*(wid&3)+(lane>>2))*DM+(wid>>2)*32+(lane&3)*8;
  const unsigned kdst=lds0+LDS_K+wid*1024, vdst=lds0+LDS_V+wid*1024;
  #define DMA_K(t,slot) glds16(ksrc+(long)(t)*KVBLK*DM,(unsigned)__builtin_amdgcn_readfirstlane(kdst+(slot)))
  #define DMA_V(t,slot) glds16(vsrc+(long)(t)*KVBLK*DM,(unsigned)__builtin_amdgcn_readfirstlane(vdst+(slot)))
  const int vb0=(int)(lds0+LDS_V)+((lane>>4)&1)*32+(lane&3)*8+(4*hi+((lane&15)>>2))*64;
  const char*Kbase=shm+LDS_K; bf16x8 kf[8];
  const lds_cptr kp0=shm3+LDS_K+hi*1024+r32*16; const lds_cptr vp0=shm3+LDS_V+((lane>>4)&1)*32+(lane&3)*8+(4*hi+((lane&15)>>2))*64;
  const int NT=(q0+QB)/KVBLK;
  const int qrel=wid*QBLK+r32;
  const unsigned long long*mkp=MK+(rowbase+q0+qrel)*64;
  const __attribute__((address_space(3))) float*bdl=(const __attribute__((address_space(3))) float*)(shm3+LDS_BIAS)+h*128;
  unsigned long long mwA,mwB;
  #define MLOAD(M,t) asm volatile("global_load_dwordx2 %0, %1, off":"=&v"(M):"v"(mkp+(t)):"memory")
  #define MPIN(M) asm volatile("":"+v"(M))
  MLOAD(mwA,0);MLOAD(mwB,1);
  DMA_K(0,0);DMA_V(0,0);DMA_K(1,SLOTB);
  bf16x8 qr[4];
  #pragma unroll
  for(int d0=0;d0<4;++d0)qr[d0]=*reinterpret_cast<const bf16x8*>(&Qw[(long)r32*DM+d0*16+hi*8]);
  float mhat=0.f,l_reg=0.f;f32x16 o[2];o[0]=f32x16{};o[1]=f32x16{};const f32x16 negm=f32x16{};
  #define CMASK(P0,P1,t,M) do{ if((t)>=NT-6)biasw(P0,P1,q0+qrel-64*(t)-4*hi,bdl); }while(0)
  bool resc=false;
  #define START(P0,P1) do{ const float rm=rowmax(P0,P1); resc=false; mhat=__builtin_fmaxf(rm,0.f); \
    _Pragma("unroll") for(int r=0;r<16;++r)P0[r]=mand(__builtin_amdgcn_exp2f(P0[r]-mhat),((unsigned)mwA)>>(4*hi),MPOS(r)); }while(0)
  #define RESC() do{ if(resc){ asm volatile("s_waitcnt lgkmcnt(0)":::"memory"); \
      _Pragma("unroll") for(int d_=0;d_<2;++d_) _Pragma("unroll") for(int r=0;r<16;++r)o[d_][r]*=wsf[crow(r,hi)]; } }while(0)
  f32x16 pA0,pA1,pB0,pB1;
  int sl_prev=0,sl_cur=0,sl_next=SLOTB;
  #define ROT() do{sl_prev=sl_cur;sl_cur=sl_next;sl_next=(sl_next==(NSLOT-1)*SLOTB)?0:sl_next+SLOTB;}while(0)
  DMA_K(2,2*SLOTB);
  WAIT_BAR(3); MPIN(mwA); MPIN(mwB);
  qkt(pA0,pA1,Kbase,qr,negm,r32,hi);asm volatile("s_nop 15\n\ts_nop 7":"+v"(pA0),"+v"(pA1));CMASK(pA0,pA1,0,mwA);
  START(pA0,pA1);
  _Pragma("unroll") for(int r=0;r<16;++r)pA1[r]=mand(__builtin_amdgcn_exp2f(pA1[r]-mhat),((unsigned)(mwA>>32))>>(4*hi),MPOS(r));
  WAIT_BAR(0);
  DMA_K(3,0);DMA_V(1,SLOTB);
  ROT();
  kload8(kf,kp0+sl_cur);
  WAIT_BAR(2);
  s16x4 vlo[8],vhi[8]; u32x4 pw0,pw1,pw2,pw3;
  #define PKW(P,B) cvtpk_s(P[B],P[B+1])
  #define PAF(k) __builtin_bit_cast(bf16x8,pw##k)
  #define VFR(i) (bf16x8){vlo[i][0],vlo[i][1],vlo[i][2],vlo[i][3],vhi[i][0],vhi[i][1],vhi[i][2],vhi[i][3]}
  #define PIN(x) asm volatile("":"+v"(x))
  #define MX3(a,b,c) __builtin_fmaxf(__builtin_fmaxf((a),(b)),(c))
  #define GAPA(MF,A0,A1,A2,A3,W0,W1,PW) do{ MF; sacc+=A0; sacc+=A1; sacc+=A2; sacc+=A3; PIN(sacc); W0; W1; PIN(PW); SBAR(); }while(0)
  #define EX(v) __builtin_amdgcn_exp2f(v)
  #define GAPB(MF,X,B,W) do{ MF; X[B]=mand(EX(X[B]-mhat),W,MPOS(B)); X[B+1]=mand(EX(X[B+1]-mhat),W,MPOS(B+1)); X[B+2]=mand(EX(X[B+2]-mhat),W,MPOS(B+2)); X[B+3]=mand(EX(X[B+3]-mhat),W,MPOS(B+3)); PIN(X); SBAR(); }while(0)
  #define VRD(i) do{ vlo[i]=vtr(vp_+(((i)>>2)*4096+((i)&3)*1024)); vhi[i]=vtr(vp_+(((i)>>2)*4096+((i)&3)*1024+512)); }while(0)
  #define KRD(G,j) do{ if(G){ kload2(kf,kp0+sl_next,j); SBAR(); } }while(0)
  #define STEP(C0,C1,P0,P1,t,GK,GV,GL,MC,MN) do{ SBAR(); if(GV){MLOAD(MN,(t)+1);} \
    const lds_cptr vp_=vp0+sl_prev; \
    VRD(0); SBAR(); float sacc=(P0[0]+P0[1]); \
    GAPA(C0=__builtin_amdgcn_mfma_f32_32x32x16_bf16(kf[0],qr[0],negm,0,0,0), P0[2],P0[3],P0[4],P0[5],     pw0[0]=PKW(P0,0), pw0[1]=PKW(P0,2), pw0); \
    VRD(4); SBAR(); GAPA(C1=__builtin_amdgcn_mfma_f32_32x32x16_bf16(kf[1],qr[0],negm,0,0,0), P0[6],P0[7],P0[8],P0[9],     pw0[2]=PKW(P0,4), pw0[3]=PKW(P0,6), pw0); \
    VRD(1); SBAR(); GAPA(C0=__builtin_amdgcn_mfma_f32_32x32x16_bf16(kf[2],qr[1],C0,0,0,0),   P0[10],P0[11],P0[12],P0[13], pw1[0]=PKW(P0,8), pw1[1]=PKW(P0,10), pw1); \
    VRD(5); SBAR(); GAPA(C1=__builtin_amdgcn_mfma_f32_32x32x16_bf16(kf[3],qr[1],C1,0,0,0),   P0[14],P0[15],P1[0],P1[1],   pw1[2]=PKW(P0,12),pw1[3]=PKW(P0,14), pw1); \
    VRD(2); SBAR(); GAPA(C0=__builtin_amdgcn_mfma_f32_32x32x16_bf16(kf[4],qr[2],C0,0,0,0),   P1[2],P1[3],P1[4],P1[5],     pw2[0]=PKW(P1,0), pw2[1]=PKW(P1,2), pw2); \
    VRD(6); SBAR(); GAPA(C1=__builtin_amdgcn_mfma_f32_32x32x16_bf16(kf[5],qr[2],C1,0,0,0),   P1[6],P1[7],P1[8],P1[9],     pw2[2]=PKW(P1,4), pw2[3]=PKW(P1,6), pw2); \
    VRD(3); SBAR(); GAPA(C0=__builtin_amdgcn_mfma_f32_32x32x16_bf16(kf[6],qr[3],C0,0,0,0),   P1[10],P1[11],P1[12],P1[13], pw3[0]=PKW(P1,8), pw3[1]=PKW(P1,10), pw3); \
    VRD(7); SBAR(); GAPA(C1=__builtin_amdgcn_mfma_f32_32x32x16_bf16(kf[7],qr[3],C1,0,0,0),   P1[14],P1[15],0.f,0.f,       pw3[2]=PKW(P1,12),pw3[3]=PKW(P1,14), pw3); \
    l_reg+=sacc; \
    if(GK){DMA_K((t)+3,sl_cur);} if(GV){DMA_V((t)+1,sl_next);} \
    CMASK(C0,C1,t,MC); const unsigned mlo_=((unsigned)(MC))>>(4*hi), mhi_=((unsigned)((MC)>>32))>>(4*hi); \
    { float a=MX3(C0[0],C0[1],C1[0]),b=MX3(C0[2],C0[3],C1[1]); a=MX3(a,C1[2],C1[3]); \
      _Pragma("unroll") for(int r=4;r<16;r+=4){a=MX3(a,C0[r],C0[r+1]);b=MX3(b,C0[r+2],C0[r+3]);a=MX3(a,C1[r],C1[r+1]);b=MX3(b,C1[r+2],C1[r+3]);} \
      float rm=__builtin_fmaxf(a,b); { auto rr=__builtin_amdgcn_permlane32_swap(__float_as_uint(rm),__float_as_uint(rm),false,false); rm=__builtin_fmaxf(__uint_as_float(rr[0]),__uint_as_float(rr[1])); } \
      resc=false; const float rd=rm-mhat; \
      if(__builtin_expect(__any(rd>(float)THRL),0)){ const float dl=__builtin_fmaxf(rd,0.f); mhat+=dl; \
        const float f=__builtin_amdgcn_exp2f(-dl); l_reg*=f; if(hi==0)wsf[r32]=f; resc=true; } } \
    SBAR(); \
    GAPB(o[0]=__builtin_amdgcn_mfma_f32_32x32x16_bf16(PAF(0),VFR(0),o[0],0,0,0), C0,0,mlo_); \
    GAPB(o[1]=__builtin_amdgcn_mfma_f32_32x32x16_bf16(PAF(0),VFR(4),o[1],0,0,0), C0,4,mlo_); \
    KRD(GL,0); GAPB(o[0]=__builtin_amdgcn_mfma_f32_32x32x16_bf16(PAF(1),VFR(1),o[0],0,0,0), C0,8,mlo_); \
    KRD(GL,1); GAPB(o[1]=__builtin_amdgcn_mfma_f32_32x32x16_bf16(PAF(1),VFR(5),o[1],0,0,0), C0,12,mlo_); \
    KRD(GL,2); GAPB(o[0]=__builtin_amdgcn_mfma_f32_32x32x16_bf16(PAF(2),VFR(2),o[0],0,0,0), C1,0,mhi_); \
    KRD(GL,3); GAPB(o[1]=__builtin_amdgcn_mfma_f32_32x32x16_bf16(PAF(2),VFR(6),o[1],0,0,0), C1,4,mhi_); \
    GAPB(o[0]=__builtin_amdgcn_mfma_f32_32x32x16_bf16(PAF(3),VFR(3),o[0],0,0,0), C1,8,mhi_); \
    GAPB(o[1]=__builtin_amdgcn_mfma_f32_32x32x16_bf16(PAF(3),VFR(7),o[1],0,0,0), C1,12,mhi_); \
    }while(0)
  int t=1;
  #undef CMASK
  #define CMASK(P0,P1,t,M) do{}while(0)
  for(;t+7<NT;t+=2){
    STEP(pB0,pB1,pA0,pA1,t,true,true,true,mwB,mwA);     WAIT_BAR(2); MPIN(mwA); RESC(); ROT();
    STEP(pA0,pA1,pB0,pB1,t+1,true,true,true,mwA,mwB);   WAIT_BAR(2); MPIN(mwB); RESC(); ROT();
  }
  #undef CMASK
  #define CMASK(P0,P1,t,M) do{ if((t)>=NT-6)biasw(P0,P1,q0+qrel-64*(t)-4*hi,bdl); }while(0)
  #define ENDW(tt) do{ if((tt)+3<NT){WAIT_BAR(2);} else if((tt)+2<NT){WAIT_BAR(1);} else {WAIT_BAR(0);} }while(0)
  for(;t+1<NT;t+=2){
    STEP(pB0,pB1,pA0,pA1,t,(t+3<NT),(t+1<NT),(t+1<NT),mwB,mwA);       ENDW(t);   MPIN(mwA); RESC(); ROT();
    STEP(pA0,pA1,pB0,pB1,t+1,(t+4<NT),(t+2<NT),(t+2<NT),mwA,mwB);     ENDW(t+1); MPIN(mwB); RESC(); ROT();
  }
  STEP(pB0,pB1,pA0,pA1,NT-1,false,false,false,mwB,mwA); RESC();
  { float sacc=pB0[0]+pB0[1]; _Pragma("unroll") for(int r=2;r<16;++r)sacc+=pB0[r]; _Pragma("unroll") for(int r=0;r<16;++r)sacc+=pB1[r]; l_reg+=sacc;
    pw0=(u32x4){PKW(pB0,0),PKW(pB0,2),PKW(pB0,4),PKW(pB0,6)};pw1=(u32x4){PKW(pB0,8),PKW(pB0,10),PKW(pB0,12),PKW(pB0,14)};pw2=(u32x4){PKW(pB1,0),PKW(pB1,2),PKW(pB1,4),PKW(pB1,6)};pw3=(u32x4){PKW(pB1,8),PKW(pB1,10),PKW(pB1,12),PKW(pB1,14)};
    SBAR(); pv(o,vb0+sl_cur,PAF(0),PAF(1),PAF(2),PAF(3)); }
  #undef PKW
  #undef PAF
  #undef VFR
  #undef PIN
  #undef MX3
  #undef GAPA
  #undef GAPB
  #undef EX
  #undef VRD
  #undef KRD
  #undef STEP
  #undef ENDW
  {auto rr=__builtin_amdgcn_permlane32_swap(__float_as_uint(l_reg),__float_as_uint(l_reg),false,false);l_reg=__uint_as_float(rr[0])+__uint_as_float(rr[1]);}
  if(hi==0)wsf[32+r32]=l_reg;asm volatile("s_waitcnt lgkmcnt(0)":::"memory");
  float rli[16];
  #pragma unroll
  for(int r=0;r<16;++r)rli[r]=__builtin_amdgcn_rcpf(wsf[32+crow(r,hi)]);
  bf16*Ow=O+(rowbase+q0+wid*QBLK)*DM+h*D;
  { bf16*stg=(bf16*)(shm+LDS_OST)+wid*2048;
    #pragma unroll
    for(int r=0;r<16;++r){const int orow=crow(r,hi);
      #pragma unroll
      for(int d0=0;d0<2;++d0)stg[orow*64+d0*32+r32]=__float2bfloat16(o[d0][r]*rli[r]);}
    asm volatile("s_waitcnt lgkmcnt(0)":::"memory");
    #pragma unroll
    for(int i=0;i<4;++i){const int row=i*8+(lane>>3),ch=lane&7; const u32x4 v=*(const u32x4*)(stg+row*64+ch*8); ATTN_STORE16(Ow+(long)row*DM+ch*8,v);} }
  asm volatile("s_waitcnt lgkmcnt(0)\n\ts_barrier":::"memory");
  #undef DMA_K
  #undef MLOAD
  #undef MPIN
  #undef DMA_V
  #undef CMASK
  #undef START
  #undef RESC
  #undef ROT
}
constexpr int ATTN_LDS_BYTES=LDS_BYTES;
#undef SBAR
#undef WAIT_BAR
}
namespace mk {
using pg8::bf16_t; using pg8::f32x4; using pg8::u32x4; using pg8::bf16x8; using pg8::Unit; using pg8::Gemm;
constexpr int T = 65536, SEQ = 4096, NBATCH = 16, DM = 1024;
constexpr int NTHREADS = 512, NWAVES = 8;
constexpr size_t MiB = 1u << 20;
constexpr size_t WS_CTL = 0;
constexpr size_t WS_EID = 1 * MiB, WS_GATE = 2 * MiB, WS_SLOT = 3 * MiB;
constexpr size_t WS_WTIN = 4 * MiB;
constexpr size_t WS_WTA = 16 * MiB, WS_WTB = 17 * MiB, WS_WTOUT = 18 * MiB, WS_WTLORA = 20 * MiB;
constexpr size_t WS_WTGU = 21 * MiB;
constexpr size_t WS_WTDN = 85 * MiB;
constexpr size_t WS_KN = 117 * MiB;
constexpr size_t WS_MISC = 125 * MiB;
constexpr size_t WS_AP = 145 * MiB;
constexpr size_t WS_MASK = 177 * MiB;
constexpr size_t WS_YB = 209 * MiB;
constexpr size_t WS_RW = 273 * MiB;
constexpr size_t WS_Q = 497 * MiB, WS_K = 561 * MiB, WS_V = 625 * MiB, WS_QI = 689 * MiB;
constexpr size_t WS_SGA = 753 * MiB, WS_SGB = 881 * MiB;
constexpr size_t WS_END = 1009 * MiB;
constexpr size_t WS_H1B = WS_RW;
constexpr size_t WS_TOKMAP = WS_Q;
constexpr size_t WS_MA = WS_Q;
constexpr size_t WS_XS = WS_Q;
constexpr size_t WS_ACT = 769 * MiB;
constexpr int NROWS_PAD = 131072 + 32 * 256;
static_assert(WS_XS + (size_t)NROWS_PAD * 2048 <= WS_ACT && WS_ACT + (size_t)NROWS_PAD * 1024 <= WS_END, "overlay map");
constexpr size_t DO_XBF = 0;
constexpr size_t DO_OMW = 0, DO_ASIG = 64 * MiB, DO_G = 128 * MiB, DO_YA = 192 * MiB;

constexpr int LDS_TOTAL = 155648;
constexpr int LDS_TAB = 131072;

struct Params { const float* in[30]; float* out; char* ws; };
typedef unsigned u32x2 __attribute__((ext_vector_type(2)));

__device__ __forceinline__ float xrow_sum(float x) {
    float a = x, b = x; asm volatile("s_nop 1\n\tv_permlane16_swap_b32 %0, %1" : "+v"(a), "+v"(b)); x = a + b;
    a = x; b = x; asm volatile("s_nop 1\n\tv_permlane32_swap_b32 %0, %1" : "+v"(a), "+v"(b)); return a + b;
}
__device__ __forceinline__ float wave_sum(float x) {
    x += __builtin_bit_cast(float, __builtin_amdgcn_mov_dpp(__builtin_bit_cast(int, x), 0xB1, 0xF, 0xF, true));
    x += __builtin_bit_cast(float, __builtin_amdgcn_mov_dpp(__builtin_bit_cast(int, x), 0x4E, 0xF, 0xF, true));
    x += __builtin_bit_cast(float, __builtin_amdgcn_mov_dpp(__builtin_bit_cast(int, x), 0x141, 0xF, 0xF, true));
    x += __builtin_bit_cast(float, __builtin_amdgcn_mov_dpp(__builtin_bit_cast(int, x), 0x140, 0xF, 0xF, true));
    return xrow_sum(x);
}
typedef float mkf2_t __attribute__((ext_vector_type(2))); typedef __bf16 mkb2_t __attribute__((ext_vector_type(2)));
__device__ __forceinline__ unsigned pk2(float lo, float hi) { const mkf2_t v = {lo, hi}; const mkb2_t b = __builtin_convertvector(v, mkb2_t); return __builtin_bit_cast(unsigned, b); }
__device__ __forceinline__ unsigned f2bf(float f) { return pk2(f, 0.f) & 0xffffu; }
__device__ __forceinline__ float bf2f(bf16_t v) { return __builtin_bit_cast(float, (unsigned)v << 16); }
__device__ __forceinline__ float bflo(unsigned w) { return __builtin_bit_cast(float, w << 16); }
__device__ __forceinline__ float bfhi(unsigned w) { return __builtin_bit_cast(float, w & 0xffff0000u); }
__device__ __forceinline__ float sigmoidf_(float x) { return __builtin_amdgcn_rcpf(1.f + __expf(-x)); }

template <class Src>
__device__ __forceinline__ void transpose_item(const Src& S, int K, bf16_t* dst, LAS float* scr, int k0, int n0, int lane) {
#pragma unroll 8
    for (int i = 0; i < 32; ++i) { const int kk = 2 * i + (lane >> 5); scr[kk * 33 + (lane & 31)] = S(k0 + kk, n0 + (lane & 31)); }
    asm volatile("s_waitcnt lgkmcnt(0)" ::: "memory");
    const int c = lane & 7;
#pragma unroll
    for (int j = 0; j < 4; ++j) { const int n = (lane >> 3) + 8 * j; const LAS float* s = scr + (8 * c) * 33 + n;
        u32x4 o; o.x = pk2(s[0 * 33], s[1 * 33]); o.y = pk2(s[2 * 33], s[3 * 33]); o.z = pk2(s[4 * 33], s[5 * 33]); o.w = pk2(s[6 * 33], s[7 * 33]);
        *(u32x4*)(dst + (size_t)(n0 + n) * K + k0 + 8 * c) = o; }
    asm volatile("s_waitcnt lgkmcnt(0)" ::: "memory");
}
struct SrcWin { const float* w; __device__ __forceinline__ float operator()(int k, int n) const {
    int c; if (n < 3840) c = n; else if (n < 5888) c = n + 72; else if (n < 5960) c = n - 5888 + 3840; else return 0.f;
    return w[(size_t)k * 5960 + c]; } };
struct SrcPlain { const float* w; int N; __device__ __forceinline__ float operator()(int k, int n) const { return w[(size_t)k * N + n]; } };
struct SrcGU { const float* g; long ud; __device__ __forceinline__ float operator()(int k, int n) const {
    const int pn = n >> 8, c = n & 255, bj = c >> 7;
    const int hj = 128 * pn + (c & 127); return g[(long)k * 512 + hj + (bj ? ud : 0l)]; } };

__device__ __forceinline__ void phase_prologue(const Params& p, LAS unsigned char* lds) {
    const int tid = mk_tid(), lane = tid & 63, wave = tid >> 6;
    const int gw = blockIdx.x * NWAVES + wave, NGW = gridDim.x * NWAVES;
    LAS float* scr = (LAS float*)(lds + wave * 16384);
    char* ws = p.ws;
    if (blockIdx.x == 0 && tid < 64) ((unsigned*)(ws + WS_CTL))[tid] = 0u;
    constexpr int I_IN = 16 * 192, I_A = 8 * 32, I_B = 8 * 32, I_O = 16 * 32, I_GU = 32 * 16 * 32, I_DN = 32 * 8 * 32;
    constexpr int NITEMS = I_IN + I_A + I_B + I_O + I_GU + I_DN;
    for (int it = gw; it < NITEMS; it += NGW) {
        int r = it;
        if (r < I_IN) { SrcWin S{p.in[1]}; transpose_item(S, 1024, (bf16_t*)(ws + WS_WTIN), scr, (r / 192) * 64, (r % 192) * 32, lane); continue; } r -= I_IN;
        if (r < I_A) { SrcPlain S{p.in[13], 1024}; transpose_item(S, 512, (bf16_t*)(ws + WS_WTA), scr, (r / 32) * 64, (r % 32) * 32, lane); continue; } r -= I_A;
        if (r < I_B) { SrcPlain S{p.in[17], 1024}; transpose_item(S, 512, (bf16_t*)(ws + WS_WTB), scr, (r / 32) * 64, (r % 32) * 32, lane); continue; } r -= I_B;
        if (r < I_O) { SrcPlain S{p.in[18], 1024}; transpose_item(S, 1024, (bf16_t*)(ws + WS_WTOUT), scr, (r / 32) * 64, (r % 32) * 32, lane); continue; } r -= I_O;
        if (r < I_GU) { const int e = r / 512, q = r % 512; SrcGU S{p.in[25] + (size_t)e * 1024 * 512, (long)(p.in[26] - p.in[25])};
            transpose_item(S, 1024, (bf16_t*)(ws + WS_WTGU) + (size_t)e * 1024 * 1024, scr, (q / 32) * 64, (q % 32) * 32, lane); continue; } r -= I_GU;
        { const int e = r / 256, q = r % 256; SrcPlain S{p.in[27] + (size_t)e * 512 * 1024, 1024};
            transpose_item(S, 512, (bf16_t*)(ws + WS_WTDN) + (size_t)e * 1024 * 512, scr, (q / 32) * 64, (q % 32) * 32, lane); }
    }
    { bf16_t* wl = (bf16_t*)(ws + WS_WTLORA); const int gt = blockIdx.x * NTHREADS + tid, NGT = gridDim.x * NTHREADS;
      for (int i = gt; i < 1536 * 256; i += NGT) { const int n = i >> 8, k = i & 255; float v = 0.f;
          if (n < 512) { if (k < 64) v = p.in[4][k * 512 + n]; }
          else if (n < 1024) { if (k >= 64 && k < 128) v = p.in[6][(k - 64) * 512 + (n - 512)]; }
          else { if (k >= 128) v = p.in[7][(k - 128) * 512 + (n - 1024)]; }
          wl[i] = (bf16_t)f2bf(v); } }
    { const f32x4* x4 = (const f32x4*)p.in[0]; unsigned long long* o8 = (unsigned long long*)((char*)p.out + DO_XBF);
      const size_t gt = (size_t)blockIdx.x * NTHREADS + tid, NGT = (size_t)gridDim.x * NTHREADS;
      for (size_t i = gt; i < (size_t)T * DM / 4; i += 4 * NGT) { f32x4 v[4];
#pragma unroll
          for (int q = 0; q < 4; ++q) v[q] = (i + q * NGT < (size_t)T * DM / 4) ? x4[i + q * NGT] : (f32x4){0.f, 0.f, 0.f, 0.f};
#pragma unroll
          for (int q = 0; q < 4; ++q) if (i + q * NGT < (size_t)T * DM / 4) o8[i + q * NGT] = (unsigned long long)pk2(v[q].x, v[q].y) | ((unsigned long long)pk2(v[q].z, v[q].w) << 32); } }
}

struct EpiIn {
    static constexpr bool PERM = true, AFTER_DRAIN = false;
    char* ws;
    __device__ __forceinline__ void operator()(const f32x4 (&acc)[2][2][4][2], const Unit& u, int wr, int wc, int fr, int fq) const {
        asm volatile("" : "+v"(fr), "+v"(fq));
        const int pn = u.pn, row0 = u.pm * 256 + wr * 64 + fr, cl = wc * 32 + 8 * fq;
        if (pn == 23) {
            if (cl < 72) { float* dst = (float*)(ws + WS_MISC);
#pragma unroll
                for (int ai = 0; ai < 2; ++ai)
#pragma unroll
                    for (int m = 0; m < 4; ++m) { float* d = dst + (size_t)(row0 + ai * 128 + m * 16) * 80 + cl; *(f32x4*)d = acc[ai][0][m][0]; *(f32x4*)(d + 4) = acc[ai][0][m][1]; } }
            return;
        }
        bf16_t* base; int ld, colt, mode = 0;
        if (pn < 7) { base = (bf16_t*)(ws + WS_RW); ld = 1792; colt = pn * 256; }
        else if (pn < 9) { base = (bf16_t*)(ws + WS_Q); ld = 512; colt = (pn - 7) * 256; mode = 2; }
        else if (pn < 11) { base = (bf16_t*)(ws + WS_K); ld = 512; colt = (pn - 9) * 256; }
        else if (pn < 13) { base = (bf16_t*)(ws + WS_V); ld = 512; colt = (pn - 11) * 256; }
        else if (pn < 15) { base = (bf16_t*)(ws + WS_QI); ld = 512; colt = (pn - 13) * 256; }
        else if (pn < 19) { base = (bf16_t*)(ws + WS_SGA); ld = 1024; colt = (pn - 15) * 256; mode = 1; }
        else { base = (bf16_t*)(ws + WS_SGB); ld = 1024; colt = (pn - 19) * 256; mode = 1; }
#pragma unroll
        for (int ai = 0; ai < 2; ++ai)
#pragma unroll
            for (int m = 0; m < 4; ++m) { bf16_t* rowp = base + (size_t)(row0 + ai * 128 + m * 16) * ld + colt + cl;
#pragma unroll
                for (int bj = 0; bj < 2; ++bj) { f32x4 v0 = acc[ai][bj][m][0], v1 = acc[ai][bj][m][1];
                    if (mode == 1) {
#pragma unroll
                        for (int i = 0; i < 4; ++i) { v0[i] = sigmoidf_(v0[i]); v1[i] = sigmoidf_(v1[i]); } }
                    else if (mode == 2) { v0 = v0 * attn_body::C2; v1 = v1 * attn_body::C2; }
                    u32x4 w; w.x = pk2(v0[0], v0[1]); w.y = pk2(v0[2], v0[3]); w.z = pk2(v1[0], v1[1]); w.w = pk2(v1[2], v1[3]);
                    *(u32x4*)(rowp + bj * 128) = w; } }
    }
};
struct EpiLora {
    static constexpr bool PERM = true, AFTER_DRAIN = false;
    char* dout;
    __device__ __forceinline__ void operator()(const f32x4 (&acc)[2][2][4][2], const Unit& u, int wr, int wc, int fr, int fq) const {
        asm volatile("" : "+v"(fr), "+v"(fq));
        const int pn = u.pn, seg = pn >> 1, row0 = u.pm * 256 + wr * 64 + fr, col0 = (pn & 1) * 256 + wc * 32 + 8 * fq;
        bf16_t* base = (bf16_t*)(dout + (size_t)seg * (64 * MiB));
#pragma unroll
        for (int ai = 0; ai < 2; ++ai)
#pragma unroll
            for (int m = 0; m < 4; ++m)
#pragma unroll
                for (int bj = 0; bj < 2; ++bj) { const f32x4 v0 = acc[ai][bj][m][0], v1 = acc[ai][bj][m][1]; u32x4 w;
                    w.x = pk2(v0[0], v0[1]); w.y = pk2(v0[2], v0[3]); w.z = pk2(v1[0], v1[1]); w.w = pk2(v1[2], v1[3]);
                    *(u32x4*)(base + (size_t)(row0 + ai * 128 + m * 16) * 512 + col0 + bj * 128) = w; }
    }
};
struct EpiGateMul {
    static constexpr bool PERM = true, AFTER_DRAIN = false;
    const bf16_t* gate; bf16_t* dst; const bf16_t* addsrc;
    __device__ __forceinline__ void operator()(const f32x4 (&acc)[2][2][4][2], const Unit& u, int wr, int wc, int fr, int fq) const {
        asm volatile("" : "+v"(fr), "+v"(fq));
        const int row0 = u.pm * 256 + wr * 64 + fr, col0 = u.pn * 256 + wc * 32 + 8 * fq;
#pragma unroll
        for (int ai = 0; ai < 2; ++ai)
#pragma unroll
            for (int m = 0; m < 4; ++m)
#pragma unroll
                for (int bj = 0; bj < 2; ++bj) { const size_t off = (size_t)(row0 + ai * 128 + m * 16) * 1024 + col0 + bj * 128;
                    const u32x4 g = *(const u32x4*)(gate + off); u32x4 d = {0u, 0u, 0u, 0u}; if (addsrc) d = *(const u32x4*)(addsrc + off);
                    const f32x4 v0 = acc[ai][bj][m][0], v1 = acc[ai][bj][m][1]; u32x4 w;
                    w.x = pk2(bflo(d.x) + bflo(g.x) * v0[0], bfhi(d.x) + bfhi(g.x) * v0[1]); w.y = pk2(bflo(d.y) + bflo(g.y) * v0[2], bfhi(d.y) + bfhi(g.y) * v0[3]);
                    w.z = pk2(bflo(d.z) + bflo(g.z) * v1[0], bfhi(d.z) + bfhi(g.z) * v1[1]); w.w = pk2(bflo(d.w) + bflo(g.w) * v1[2], bfhi(d.w) + bfhi(g.w) * v1[3]);
                    *(u32x4*)(dst + off) = w; }
    }
};
struct EpiResid {
    static constexpr bool PERM = true, AFTER_DRAIN = false;
    const float* x; bf16_t* out; float alpha;
    __device__ __forceinline__ void operator()(const f32x4 (&acc)[2][2][4][2], const Unit& u, int wr, int wc, int fr, int fq) const {
        asm volatile("" : "+v"(fr), "+v"(fq));
        const int row0 = u.pm * 256 + wr * 64 + fr, col0 = u.pn * 256 + wc * 32 + 8 * fq;
#pragma unroll
        for (int ai = 0; ai < 2; ++ai)
#pragma unroll
            for (int m = 0; m < 4; ++m)
#pragma unroll
                for (int bj = 0; bj < 2; ++bj) { const size_t off = (size_t)(row0 + ai * 128 + m * 16) * 1024 + col0 + bj * 128;
                    const f32x4 x0 = *(const f32x4*)(x + off), x1 = *(const f32x4*)(x + off + 4);
                    const f32x4 v0 = x0 * alpha + acc[ai][bj][m][0], v1 = x1 * alpha + acc[ai][bj][m][1]; u32x4 w; w.x = pk2(v0[0], v0[1]); w.y = pk2(v0[2], v0[3]); w.z = pk2(v1[0], v1[1]); w.w = pk2(v1[2], v1[3]);
                    *(u32x4*)(out + off) = w; }
    }
};
struct EpiSwiglu {
    static constexpr bool PERM = true, AFTER_DRAIN = false;
    bf16_t* act;
    __device__ __forceinline__ void operator()(const f32x4 (&acc)[2][2][4][2], const Unit& u, int wr, int wc, int fr, int fq) const {
        asm volatile("" : "+v"(fr), "+v"(fq));
        const int row0 = u.pm * 256 + wr * 64 + fr, col0 = (u.pn & 3) * 128 + 32 * wc + 8 * fq;
#pragma unroll
        for (int ai = 0; ai < 2; ++ai)
#pragma unroll
            for (int m = 0; m < 4; ++m) { float a[8];
#pragma unroll
                for (int n = 0; n < 2; ++n)
#pragma unroll
                    for (int i = 0; i < 4; ++i) { const float g = acc[ai][0][m][n][i]; a[4 * n + i] = g * sigmoidf_(g) * acc[ai][1][m][n][i]; }
                u32x4 w; w.x = pk2(a[0], a[1]); w.y = pk2(a[2], a[3]); w.z = pk2(a[4], a[5]); w.w = pk2(a[6], a[7]);
                *(u32x4*)(act + (size_t)(row0 + ai * 128 + m * 16) * 512 + col0) = w; }
    }
};
struct EpiDown {
    static constexpr bool PERM = true, AFTER_DRAIN = false;
    bf16_t* ys;
    __device__ __forceinline__ void operator()(const f32x4 (&acc)[2][2][4][2], const Unit& u, int wr, int wc, int fr, int fq) const {
        asm volatile("" : "+v"(fr), "+v"(fq));
        const int row0 = u.pm * 256 + wr * 64 + fr, col0 = (u.pn & 3) * 256 + wc * 32 + 8 * fq;
#pragma unroll
        for (int ai = 0; ai < 2; ++ai)
#pragma unroll
            for (int m = 0; m < 4; ++m)
#pragma unroll
                for (int bj = 0; bj < 2; ++bj) { const f32x4 v0 = acc[ai][bj][m][0], v1 = acc[ai][bj][m][1]; u32x4 w;
                    w.x = pk2(v0[0], v0[1]); w.y = pk2(v0[2], v0[3]); w.z = pk2(v1[0], v1[1]); w.w = pk2(v1[2], v1[3]);
                    *(u32x4*)(ys + (size_t)(row0 + ai * 128 + m * 16) * 1024 + col0 + bj * 128) = w; }
    }
};
struct MoeOrder {
    const LAS int* tab;
    int G, c; const int* tokmap;
    __device__ __forceinline__ int srcrow(const Unit& u, int r) const {
        const int e = u.pn >> 2, slot = u.pm * 256 - tab[1024 + e] + r; return slot < tab[1100 + e] ? tokmap[e * 65536 + slot] : 0; }
    __device__ __forceinline__ bool next(int i, Unit& u) const {
        const int L = i * G + c; const int nt = tab[0]; if (L >= nt * 4) return false;
        const int ti = L >> 2; u.pm = ti; u.pn = tab[1 + ti] * 4 + (L & 3); return true; }
    __device__ __forceinline__ void a_ready(const Unit&) const {}
    __device__ __forceinline__ void done(const Unit&) const {}
};
__device__ __forceinline__ void moe_tables(const Params& p, LAS int* tab) {
    const int tid = mk_tid(); const unsigned* cnt = (const unsigned*)(p.ws + WS_CTL);
    __syncthreads();
    if (tid == 0) { int ts = 0; for (int e = 0; e < 32; ++e) { const int c = (int)cnt[e]; tab[1024 + e] = ts * 256; tab[1100 + e] = c; const int nt = (c + 255) >> 8; for (int j = 0; j < nt; ++j) tab[1 + ts + j] = e; ts += nt; } tab[0] = ts; tab[1024 + 32] = ts * 256; }
    __syncthreads();
}

__device__ __forceinline__ float dpp_sum8(float x) {
    x += __builtin_bit_cast(float, __builtin_amdgcn_mov_dpp(__builtin_bit_cast(int, x), 0xB1, 0xF, 0xF, true));
    x += __builtin_bit_cast(float, __builtin_amdgcn_mov_dpp(__builtin_bit_cast(int, x), 0x4E, 0xF, 0xF, true));
    x += __builtin_bit_cast(float, __builtin_amdgcn_mov_dpp(__builtin_bit_cast(int, x), 0x141, 0xF, 0xF, true));
    return x;
}
__device__ __forceinline__ float dpp_sum16(float x) {
    x += __builtin_bit_cast(float, __builtin_amdgcn_mov_dpp(__builtin_bit_cast(int, x), 0xB1, 0xF, 0xF, true));
    x += __builtin_bit_cast(float, __builtin_amdgcn_mov_dpp(__builtin_bit_cast(int, x), 0x4E, 0xF, 0xF, true));
    x += __builtin_bit_cast(float, __builtin_amdgcn_mov_dpp(__builtin_bit_cast(int, x), 0x141, 0xF, 0xF, true));
    x += __builtin_bit_cast(float, __builtin_amdgcn_mov_dpp(__builtin_bit_cast(int, x), 0x140, 0xF, 0xF, true));
    return x;
}
__device__ __forceinline__ void phase_prep(const Params& p) {
    const int tid = mk_tid(), lane = tid & 63, wave = tid >> 6;
    const int gw = blockIdx.x * NWAVES + wave, NGW = gridDim.x * NWAVES;
    const bf16_t* RW = (const bf16_t*)(p.ws + WS_RW); const float* MISC = (const float*)(p.ws + WS_MISC);
    bf16_t* AP = (bf16_t*)(p.ws + WS_AP); bf16_t* KN = (bf16_t*)(p.ws + WS_KN);
    const int ac = 4 * lane;
    const int rc = ac < 64 ? 512 + ac : (ac < 128 ? 1600 + (ac - 64) : 1664 + (ac - 128));
    const f32x4 mu = *(const f32x4*)(p.in[2] + rc);
    const int kl = lane & 15;
    const f32x4 lg = *(const f32x4*)(p.in[14] + 4 * kl), lb = *(const f32x4*)(p.in[15] + 4 * kl);
#define UNPK4(u_) (f32x4){bflo((u_).x), bfhi((u_).x), bflo((u_).y), bfhi((u_).y)}
    for (int tok0 = gw * 4; tok0 < T; tok0 += NGW * 4) {
        u32x2 cu[4], pv[4]; f32x4 kx[4];
#pragma unroll
        for (int q = 0; q < 4; ++q) { const int tok = tok0 + q; const bf16_t* cur = RW + (size_t)tok * 1792 + rc; const bool hp = (tok & (SEQ - 1)) != 0;
            cu[q] = *(const u32x2*)cur; pv[q] = hp ? *(const u32x2*)(cur - 1792) : (u32x2){0u, 0u};
            kx[q] = *(const f32x4*)(MISC + (size_t)tok * 80 + 4 * kl); }
#pragma unroll
        for (int q = 0; q < 4; ++q) { const int tok = tok0 + q;
            const f32x4 c = UNPK4(cu[q]), pr = UNPK4(pv[q]); const f32x4 x = c + (pr - c) * mu; f32x4 o;
#pragma unroll
            for (int i = 0; i < 4; ++i) o[i] = ac < 64 ? 1.f - 2.f * __builtin_amdgcn_rcpf(1.f + __expf(2.f * x[i])) : (ac < 128 ? x[i] : sigmoidf_(x[i]));
            *(u32x2*)(AP + (size_t)tok * 256 + ac) = (u32x2){pk2(o[0], o[1]), pk2(o[2], o[3])};
            const float mean = dpp_sum16((kx[q].x + kx[q].y) + (kx[q].z + kx[q].w)) * (1.f / 64.f); const f32x4 d = kx[q] - mean;
            const float var = dpp_sum16((d.x * d.x + d.y * d.y) + (d.z * d.z + d.w * d.w)) * (1.f / 64.f);
            const f32x4 kn = d * __builtin_amdgcn_rsqf(var + 1e-5f) * lg + lb;
            if (lane < 16) *(u32x2*)(KN + (size_t)tok * 64 + 4 * kl) = (u32x2){pk2(kn[0], kn[1]), pk2(kn[2], kn[3])}; }
    }
#undef UNPK4
}

typedef _Float16 h8 __attribute__((ext_vector_type(8)));
constexpr int SC = 32;
typedef float f2 __attribute__((ext_vector_type(2)));
struct ScanRaw { u32x2 r, k, v, rp, kp, vp, w, a, g; };
struct ScanKeep { f32x4 v, g; float bonus; };
constexpr int SCL_VEC = 0, SCL_VBUF = SCL_VEC + 2 * SC * 1280, SCL_YBUF = SCL_VBUF + 2 * SC * 256, SCL_DUMMY = SCL_YBUF + 2 * SC * 256, SCL_END = SCL_DUMMY + 8704;
__device__ __forceinline__ void scan_item(const Params& p, LAS unsigned char* lds, int bh) {
    const int b = bh >> 3, h = bh & 7;
    const int tid = mk_tid(), lane = tid & 63, wave = tid >> 6;
    const bf16_t* RW = (const bf16_t*)(p.ws + WS_RW);
    const bf16_t* OMW = (const bf16_t*)((char*)p.out + DO_OMW); const bf16_t* ASIG = (const bf16_t*)((char*)p.out + DO_ASIG); const bf16_t* GG = (const bf16_t*)((char*)p.out + DO_G);
    bf16_t* YA = (bf16_t*)((char*)p.out + DO_YA);
    const size_t row0 = (size_t)b * SEQ;
    constexpr int NCH = SEQ / SC;
    __syncthreads();
    if (wave >= 4) {
        const int hw_ = wave - 4, tokl = lane >> 4, cg = lane & 15, col = h * 64 + 4 * cg;
        const f32x4 mu_r = *(const f32x4*)(p.in[2] + col), mu_k = *(const f32x4*)(p.in[2] + 576 + col), mu_v = *(const f32x4*)(p.in[2] + 1088 + col);
        const f32x4 w0c = *(const f32x4*)(p.in[3] + col), a0c = *(const f32x4*)(p.in[5] + col), kkc = *(const f32x4*)(p.in[8] + col), kac = *(const f32x4*)(p.in[9] + col);
        const f32x4 rkc = *(const f32x4*)(p.in[10] + col), lxg = *(const f32x4*)(p.in[11] + col), lxb = *(const f32x4*)(p.in[12] + col);
        ScanRaw R[2]; ScanKeep K0[2], K1[2];
#define SCAN_LOAD(c_, q_) do { const int t_ = (c_) * SC + hw_ * 8 + (q_) * 4 + tokl; const size_t rw_ = row0 + t_; const bf16_t* cur_ = RW + rw_ * 1792 + col; const bf16_t* prv_ = cur_ - 1792; \
        R[q_].r = *(const u32x2*)cur_; R[q_].k = *(const u32x2*)(cur_ + 576); R[q_].v = *(const u32x2*)(cur_ + 1088); \
        if (t_ > 0) { R[q_].rp = *(const u32x2*)prv_; R[q_].kp = *(const u32x2*)(prv_ + 576); R[q_].vp = *(const u32x2*)(prv_ + 1088); } else { R[q_].rp = (u32x2){0u, 0u}; R[q_].kp = R[q_].rp; R[q_].vp = R[q_].rp; } \
        R[q_].w = *(const u32x2*)(OMW + rw_ * 512 + col); R[q_].a = *(const u32x2*)(ASIG + rw_ * 512 + col); R[q_].g = *(const u32x2*)(GG + rw_ * 512 + col); } while (0)
#define UNPK(u_) (f32x4){bflo((u_).x), bfhi((u_).x), bflo((u_).y), bfhi((u_).y)}
#define SCAN_PREP(c_, q_) do { const int tk_ = hw_ * 8 + (q_) * 4 + tokl; const int bf_ = (c_) & 1; \
        f32x4 r = UNPK(R[q_].r), k = UNPK(R[q_].k), v = UNPK(R[q_].v); const f32x4 rp = UNPK(R[q_].rp), kp = UNPK(R[q_].kp), vp = UNPK(R[q_].vp); \
        r += (rp - r) * mu_r; k += (kp - k) * mu_k; v += (vp - v) * mu_v; \
        const f32x4 wr = UNPK(R[q_].w) + w0c, ar = UNPK(R[q_].a) + a0c; f32x4 a, omw; \
        _Pragma("unroll") for (int i = 0; i < 4; ++i) { a[i] = sigmoidf_(ar[i]); \
            const float z = -wr[i]; const float sp = z > 20.f ? z : __logf(1.f + __expf(z)); const float e = __expf(-sp - 0.5f); \
            omw[i] = e < 0.1f ? e * (1.f - e * (0.5f - e * ((1.f / 6.f) - e * ((1.f / 24.f) - e * (1.f / 120.f))))) : 1.f - __expf(-e); } \
        const f32x4 kkr = k * kkc; const float n2 = dpp_sum16((kkr.x * kkr.x + kkr.y * kkr.y) + (kkr.z * kkr.z + kkr.w * kkr.w)); \
        const f32x4 kk = kkr * __builtin_amdgcn_rsqf(fmaxf(n2, 1e-24f)); const f32x4 k2 = k * ((a - 1.f) * kac + 1.f); \
        const f32x4 rb = r * k2 * rkc; K0[q_].bonus = dpp_sum16((rb.x + rb.y) + (rb.z + rb.w)); K0[q_].v = v; K0[q_].g = UNPK(R[q_].g); \
        LAS float* vp_ = (LAS float*)(lds + SCL_VEC) + (bf_ * SC + tk_) * 320 + 4 * cg; \
        *(LAS f32x4*)(vp_) = 1.f - omw; *(LAS f32x4*)(vp_ + 64) = -kk; *(LAS f32x4*)(vp_ + 128) = kk * a; *(LAS f32x4*)(vp_ + 192) = k2; *(LAS f32x4*)(vp_ + 256) = r; \
        *(LAS f32x4*)((LAS float*)(lds + SCL_VBUF) + (bf_ * SC + tk_) * 64 + 4 * cg) = v; } while (0)
#define SCAN_POST(c_, q_) do { const int tk_ = hw_ * 8 + (q_) * 4 + tokl; const int bf_ = (c_) & 1; \
        const f32x4 y = *(const LAS f32x4*)((LAS float*)(lds + SCL_YBUF) + (bf_ * SC + tk_) * 64 + 4 * cg); \
        const float mean = dpp_sum16((y.x + y.y) + (y.z + y.w)) * (1.f / 64.f); const f32x4 d = y - mean; \
        const float var = dpp_sum16((d.x * d.x + d.y * d.y) + (d.z * d.z + d.w * d.w)) * (1.f / 64.f); const float rs = __builtin_amdgcn_rsqf(var + 64e-5f); \
        const f32x4 o = (d * rs * lxg + lxb + K1[q_].v * K1[q_].bonus) * K1[q_].g; \
        *(u32x2*)(YA + (row0 + (size_t)(c_) * SC + tk_) * 512 + col) = (u32x2){pk2(o.x, o.y), pk2(o.z, o.w)}; } while (0)
        SCAN_LOAD(0, 0); SCAN_LOAD(0, 1);
        SCAN_PREP(0, 0); SCAN_PREP(0, 1);
        SCAN_LOAD(1, 0); SCAN_LOAD(1, 1);
        K1[0] = K0[0]; K1[1] = K0[1];
        __syncthreads();
        for (int c = 0; c <= NCH; ++c) {
            if (c >= 1) { SCAN_POST(c - 1, 0); SCAN_POST(c - 1, 1); }
            K1[0] = K0[0]; K1[1] = K0[1];
            if (c + 1 < NCH) { SCAN_PREP(c + 1, 0); SCAN_PREP(c + 1, 1); }
            if (c + 2 < NCH) { SCAN_LOAD(c + 2, 0); SCAN_LOAD(c + 2, 1); }
            if (c < NCH) __syncthreads();
        }
#undef SCAN_LOAD
#undef UNPK
#undef SCAN_PREP
#undef SCAN_POST
    } else {
        const int rp = lane >> 3, jg = lane & 7, i0 = wave * 16 + rp * 2;
        const int yoff = (jg == 0) ? i0 : (SCL_DUMMY - SCL_YBUF) / 4 + 2 * lane;
        f2 s0[4], s1[4];
#pragma unroll
        for (int j = 0; j < 4; ++j) { s0[j] = (f2){0.f, 0.f}; s1[j] = s0[j]; }
        __syncthreads();
        for (int c = 0; c < NCH; ++c) {
            const int bf = c & 1;
            const LAS float* vecb = (const LAS float*)(lds + SCL_VEC) + bf * SC * 320; const LAS float* vbb = (const LAS float*)(lds + SCL_VBUF) + bf * SC * 64 + i0;
            LAS float* ybb = (LAS float*)(lds + SCL_YBUF) + ((jg == 0) ? bf * SC * 64 : 0) + yoff;
#if defined(MK_REP) && MK_REP == 302
            f2 k0_[4], k1_[4];
#pragma unroll
            for (int j = 0; j < 4; ++j) { k0_[j] = s0[j]; k1_[j] = s1[j]; }
            for (int rep_ = 0; rep_ < 2; ++rep_) {
#pragma unroll
            for (int j = 0; j < 4; ++j) { s0[j] = k0_[j]; s1[j] = k1_[j]; asm volatile("" : "+v"(s0[j]), "+v"(s1[j]) :: "memory"); }
#endif
#define LDV(t_, W, A, B, K, Rr, V) do { const LAS f32x4* q_ = (const LAS f32x4*)(vecb + (t_) * 320) + 2 * jg; W##0 = q_[0]; W##1 = q_[1]; A##0 = q_[16]; A##1 = q_[17]; B##0 = q_[32]; B##1 = q_[33]; \
        K##0 = q_[48]; K##1 = q_[49]; Rr##0 = q_[64]; Rr##1 = q_[65]; V = *(const LAS f2*)(vbb + (t_) * 64); } while (0)
#define LO2(v_) __builtin_shufflevector(v_, v_, 0, 1)
#define HI2(v_) __builtin_shufflevector(v_, v_, 2, 3)
#define FMA2(a_, b_, c_) __builtin_elementwise_fma(a_, b_, c_)
            f32x4 vw0, vw1, va0, va1, vb0, vb1, vk0, vk1, vr0, vr1; f2 vv;
            LDV(0, vw, va, vb, vk, vr, vv);
#pragma unroll 2
            for (int tk = 0; tk < SC; ++tk) {
                f32x4 nw0, nw1, na0, na1, nb0, nb1, nk0, nk1, nr0, nr1; f2 nv;
                { const int tn = (tk + 1 < SC) ? tk + 1 : tk; LDV(tn, nw, na, nb, nk, nr, nv); }
                f2 p0 = s0[0] * LO2(va0), p1 = s1[0] * LO2(va0);
                p0 = FMA2(s0[1], HI2(va0), p0); p1 = FMA2(s1[1], HI2(va0), p1); p0 = FMA2(s0[2], LO2(va1), p0); p1 = FMA2(s1[2], LO2(va1), p1); p0 = FMA2(s0[3], HI2(va1), p0); p1 = FMA2(s1[3], HI2(va1), p1);
                const float sa0 = dpp_sum8(p0.x + p0.y), sa1 = dpp_sum8(p1.x + p1.y);
                const f2 sa0v = {sa0, sa0}, sa1v = {sa1, sa1}, v0v = {vv.x, vv.x}, v1v = {vv.y, vv.y};
                s0[0] = FMA2(v0v, LO2(vk0), FMA2(sa0v, LO2(vb0), s0[0] * LO2(vw0))); s1[0] = FMA2(v1v, LO2(vk0), FMA2(sa1v, LO2(vb0), s1[0] * LO2(vw0)));
                s0[1] = FMA2(v0v, HI2(vk0), FMA2(sa0v, HI2(vb0), s0[1] * HI2(vw0))); s1[1] = FMA2(v1v, HI2(vk0), FMA2(sa1v, HI2(vb0), s1[1] * HI2(vw0)));
                s0[2] = FMA2(v0v, LO2(vk1), FMA2(sa0v, LO2(vb1), s0[2] * LO2(vw1))); s1[2] = FMA2(v1v, LO2(vk1), FMA2(sa1v, LO2(vb1), s1[2] * LO2(vw1)));
                s0[3] = FMA2(v0v, HI2(vk1), FMA2(sa0v, HI2(vb1), s0[3] * HI2(vw1))); s1[3] = FMA2(v1v, HI2(vk1), FMA2(sa1v, HI2(vb1), s1[3] * HI2(vw1)));
                f2 q0 = s0[0] * LO2(vr0), q1 = s1[0] * LO2(vr0);
                q0 = FMA2(s0[1], HI2(vr0), q0); q1 = FMA2(s1[1], HI2(vr0), q1); q0 = FMA2(s0[2], LO2(vr1), q0); q1 = FMA2(s1[2], LO2(vr1), q1); q0 = FMA2(s0[3], HI2(vr1), q0); q1 = FMA2(s1[3], HI2(vr1), q1);
                const float y0 = dpp_sum8(q0.x + q0.y), y1 = dpp_sum8(q1.x + q1.y);
                *(LAS f2*)(ybb + tk * 64) = (f2){y0, y1};
                vw0 = nw0; vw1 = nw1; va0 = na0; va1 = na1; vb0 = nb0; vb1 = nb1; vk0 = nk0; vk1 = nk1; vr0 = nr0; vr1 = nr1; vv = nv;
            }
#undef LDV
#undef LO2
#undef HI2
#undef FMA2
#if defined(MK_REP) && MK_REP == 302
            }
#endif
            __syncthreads();
        }
    }
}

constexpr int IX_TEAM_BYTES = 61440;
constexpr int IX_HIST = 0;
constexpr int IX_MASK = 32768, IX_MROW = 129;
constexpr int IX_CAP = 128, IX_CAND = IX_MASK + 8448;
constexpr int IX_MISC = IX_CAND + 16384;
constexpr int IX_CTL = 2 * IX_TEAM_BYTES;
static_assert(IX_MISC + 3072 <= IX_TEAM_BYTES && IX_CTL + 32 <= LDS_TOTAL - 64, "indexer LDS map");
struct IxTeam { int tw, ttid, lane; LAS unsigned char* lds; LAS unsigned* bar; unsigned gen; };
__device__ __forceinline__ void team_sync(IxTeam& tm) {
    asm volatile("s_waitcnt lgkmcnt(0)" ::: "memory");
    if (tm.lane == 0) {
        const unsigned old = __hip_atomic_fetch_add(&tm.bar[0], 1u, __ATOMIC_RELAXED, __HIP_MEMORY_SCOPE_WORKGROUP);
        if (old == 3u) { __hip_atomic_store(&tm.bar[0], 0u, __ATOMIC_RELAXED, __HIP_MEMORY_SCOPE_WORKGROUP); __hip_atomic_fetch_add(&tm.bar[1], 1u, __ATOMIC_RELAXED, __HIP_MEMORY_SCOPE_WORKGROUP); }
        else { while (__hip_atomic_load(&tm.bar[1], __ATOMIC_RELAXED, __HIP_MEMORY_SCOPE_WORKGROUP) == tm.gen) __builtin_amdgcn_s_sleep(1); }
    }
    tm.gen += 1u;
    asm volatile("s_waitcnt lgkmcnt(0)" ::: "memory");
}
struct IxSel { int B0; unsigned Klo, Khi; };
__device__ __forceinline__ unsigned ix_key(float x) { const unsigned h = (unsigned)__builtin_bit_cast(unsigned short, (_Float16)x); return (h & 0x8000u) ? (~h & 0xffffu) : (h | 0x8000u); }
__device__ __forceinline__ void ix_blockA(const bool DIAG, const bf16x8 a0, const bf16x8 a1, const bf16x8 (&qf)[9][2], const float (&hw)[8], int s0, int quad, int n, int tq,
                                          LAS unsigned* hist, unsigned short* KS) {
    f32x4 acc[9];
#pragma unroll
    for (int h = 0; h < 9; ++h) { acc[h] = (f32x4){0.f, 0.f, 0.f, 0.f}; acc[h] = __builtin_amdgcn_mfma_f32_16x16x32_bf16(a0, qf[h][0], acc[h], 0, 0, 0); }
#pragma unroll
    for (int h = 0; h < 9; ++h) acc[h] = __builtin_amdgcn_mfma_f32_16x16x32_bf16(a1, qf[h][1], acc[h], 0, 0, 0);
    __builtin_amdgcn_sched_barrier(0);
    f32x4 idx = acc[8];
#pragma unroll
    for (int h = 0; h < 8; ++h)
#pragma unroll
        for (int j = 0; j < 4; ++j) idx[j] = __builtin_fmaf(hw[h], __builtin_fabsf(acc[h][j]), idx[j]);
    const int sb = s0 + quad * 4; unsigned k[4];
#pragma unroll
    for (int j = 0; j < 4; ++j) { k[j] = ix_key(idx[j]); if (!DIAG || sb + j <= tq) __hip_atomic_fetch_add(&hist[n * 512 + (k[j] >> 7)], 1u, __ATOMIC_RELAXED, __HIP_MEMORY_SCOPE_WORKGROUP); }
    *(u32x2*)(KS + s0 * 16 + n * 16 + quad * 4) = (u32x2){k[0] | (k[1] << 16), k[2] | (k[3] << 16)};
}
template <int MODE>
__device__ __forceinline__ void ix_blockK(const bool DIAG, const u32x2 kw, int s0, int quad, int n, int tq, const IxSel& S, LAS unsigned* hist, LAS unsigned* mrow, LAS int* ccnt, LAS int* candk, LAS int* cands) {
    const int sb = s0 + quad * 4; const unsigned k[4] = {kw.x & 0xffffu, kw.x >> 16, kw.y & 0xffffu, kw.y >> 16};
    if (MODE == 1) {
#pragma unroll
        for (int j = 0; j < 4; ++j) if ((!DIAG || sb + j <= tq) && (int)(k[j] >> 7) == S.B0) __hip_atomic_fetch_add(&hist[n * 512 + (k[j] & 127u)], 1u, __ATOMIC_RELAXED, __HIP_MEMORY_SCOPE_WORKGROUP);
    } else {
        unsigned m = 0u, cm = 0u;
#pragma unroll
        for (int j = 0; j < 4; ++j) { const bool ok = !DIAG || sb + j <= tq; if (ok && k[j] > S.Khi) m |= 1u << j; if (ok && k[j] >= S.Klo && k[j] <= S.Khi) cm |= 1u << j; }
        {
            unsigned t = m << (4 * quad);
            { auto r = __builtin_amdgcn_permlane16_swap(t, t, false, false); t = r[0] | r[1]; }
            { auto r = __builtin_amdgcn_permlane32_swap(t, t, false, false); t = r[0] | r[1]; }
            if (quad == 0) ((LAS unsigned short*)mrow)[n * (IX_MROW * 2) + (s0 >> 4)] = (unsigned short)t; }
        if (cm) {
            int sl = __hip_atomic_fetch_add(&ccnt[n], (int)__builtin_popcount(cm), __ATOMIC_RELAXED, __HIP_MEMORY_SCOPE_WORKGROUP);
#pragma unroll
            for (int j = 0; j < 4; ++j) if ((cm >> j) & 1u) { if (sl < IX_CAP) { candk[n * IX_CAP + sl] = (int)k[j]; cands[n * IX_CAP + sl] = sb + j; } ++sl; } }
    }
}
constexpr int IX_NW = 4;
__device__ __forceinline__ void ix_passA(const bf16_t* KNb, const bf16x8 (&qf)[9][2], const float (&hw)[8], int qg, int tw, int quad, int n, int tq, LAS unsigned* hist, unsigned short* KS) {
    if (tw > qg) return;
    const int nb = (qg - tw) / IX_NW + 1;
    const bf16_t* kp0 = KNb + (size_t)(tw * 16 + n) * 64 + quad * 8;
    constexpr size_t KSTEP = (size_t)IX_NW * 16 * 64;
#define IX_LD(i_, x0_, x1_) do { const int ii_ = (i_) < nb ? (i_) : nb - 1; const bf16_t* q_ = kp0 + (size_t)ii_ * KSTEP; x0_ = *(const bf16x8*)q_; x1_ = *(const bf16x8*)(q_ + 32); } while (0)
#define IX_DO(i_, x0_, x1_) do { if ((i_) < nb) { const int kb_ = tw + IX_NW * (i_); const bf16x8 a0_ = x0_, a1_ = x1_; IX_LD((i_) + 4, x0_, x1_); \
        ix_blockA(kb_ == qg, a0_, a1_, qf, hw, kb_ * 16, quad, n, tq, hist, KS); } } while (0)
    bf16x8 r00, r01, r10, r11, r20, r21, r30, r31;
    IX_LD(0, r00, r01); IX_LD(1, r10, r11); IX_LD(2, r20, r21); IX_LD(3, r30, r31);
#pragma unroll 1
    for (int i = 0; i < nb; i += 4) { IX_DO(i, r00, r01); IX_DO(i + 1, r10, r11); IX_DO(i + 2, r20, r21); IX_DO(i + 3, r30, r31); }
#undef IX_LD
#undef IX_DO
}
template <int MODE>
__device__ __forceinline__ void ix_passK(const unsigned short* KS, int qg, int tw, int quad, int n, int tq, const IxSel& S, LAS unsigned* hist, LAS unsigned* mrow, LAS int* ccnt, LAS int* candk, LAS int* cands) {
    if (tw > qg) return;
    const int nb = (qg - tw) / IX_NW + 1;
    const unsigned short* kp0 = KS + tw * 256 + n * 16 + quad * 4;
#define IX_LD(i_, x_) do { const int ii_ = (i_) < nb ? (i_) : nb - 1; x_ = *(const u32x2*)(kp0 + ii_ * (IX_NW * 256)); } while (0)
#define IX_DO(i_, x_) do { if ((i_) < nb) { const int kb_ = tw + IX_NW * (i_); const u32x2 kw_ = x_; IX_LD((i_) + 4, x_); \
        ix_blockK<MODE>(kb_ == qg, kw_, kb_ * 16, quad, n, tq, S, hist, mrow, ccnt, candk, cands); } } while (0)
    u32x2 r0, r1, r2, r3;
    IX_LD(0, r0); IX_LD(1, r1); IX_LD(2, r2); IX_LD(3, r3);
#pragma unroll 1
    for (int i = 0; i < nb; i += 4) { IX_DO(i, r0); IX_DO(i + 1, r1); IX_DO(i + 2, r2); IX_DO(i + 3, r3); }
#undef IX_LD
#undef IX_DO
}
__device__ __forceinline__ void ix_search(IxTeam& tm, LAS unsigned* hist, LAS int* segsum, LAS int* needv, LAS int* outB, LAS int* outG, LAS int* outC) {
    const int qn = tm.ttid >> 4, seg = tm.ttid & 15;
    { int sum = 0;
#pragma unroll 4
      for (int w = 0; w < 32; ++w) sum += (int)hist[qn * 512 + seg * 32 + w];
      segsum[qn * 16 + seg] = sum; }
    team_sync(tm);
    { const int need = needv[qn]; int above = 0;
#pragma unroll 1
      for (int s2 = seg + 1; s2 < 16; ++s2) above += segsum[qn * 16 + s2];
      const int mine = segsum[qn * 16 + seg];
      if (above < need && above + mine >= need) { int cum = above;
#pragma unroll 1
          for (int bin = seg * 32 + 31; bin >= seg * 32; --bin) { const int cnt = (int)hist[qn * 512 + bin];
              if (cum + cnt >= need) { outB[qn] = bin; outG[qn] = cum; outC[qn] = cnt; break; } cum += cnt; } } }
    team_sync(tm);
}
__device__ __forceinline__ void indexer_unit(const Params& p, IxTeam& tm, unsigned short* KS, int b, int qg) {
    int ttid = tm.ttid, lane = tm.lane; const int tw = tm.tw; LAS unsigned char* lds = tm.lds;
    asm volatile("" : "+v"(ttid), "+v"(lane));
    LAS unsigned* hist = (LAS unsigned*)(lds + IX_HIST);
    LAS unsigned* mrow = (LAS unsigned*)(lds + IX_MASK);
    LAS int* candk = (LAS int*)(lds + IX_CAND);
    LAS int* cands = (LAS int*)(lds + IX_CAND + 8192);
    LAS int* ccnt = (LAS int*)(lds + IX_MISC);
    LAS int* thrB = ccnt + 16; LAS int* thrG = ccnt + 32; LAS int* thrC = ccnt + 48;
    LAS int* thrB1 = ccnt + 64; LAS int* thrG1 = ccnt + 80; LAS int* thrC1 = ccnt + 96; LAS int* needv = ccnt + 112;
    LAS int* segsum = ccnt + 128;
    unsigned* MASK = (unsigned*)(p.ws + WS_MASK);
    const int t0 = qg * 16; const size_t rowb = (size_t)b * SEQ;
    if (qg < 16) {
        for (int i = ttid; i < 2048; i += 256) { const int n = i >> 7, w = i & 127, tq = t0 + n; const int s0 = 32 * w;
            const unsigned m = tq >= s0 + 31 ? 0xffffffffu : (tq < s0 ? 0u : ((2u << (tq - s0)) - 1u));
            MASK[(rowb + t0) * 128 + i] = m; }
        return;
    }
    for (int i = ttid; i < (8192 + 16 * IX_MROW) / 4; i += 256) ((LAS u32x4*)hist)[i] = (u32x4){0u, 0u, 0u, 0u};
    if (ttid < 16) { ccnt[ttid] = 0; needv[ttid] = 256; }
    const bf16_t* QI = (const bf16_t*)(p.ws + WS_QI); const bf16_t* KNb = (const bf16_t*)(p.ws + WS_KN) + rowb * 64; const float* MISC = (const float*)(p.ws + WS_MISC);
    const int n = lane & 15, quad = lane >> 4, tq = t0 + n;
    bf16x8 qf[9][2]; float hw[8];
#pragma unroll
    for (int h = 0; h < 8; ++h) { hw[h] = MISC[(rowb + tq) * 80 + 64 + h] * (0.5f * 0.125f * 0.35355339059327373f);
#pragma unroll
        for (int ks = 0; ks < 2; ++ks) qf[h][ks] = *(const bf16x8*)(QI + (rowb + tq) * 512 + h * 64 + ks * 32 + quad * 8); }
    { float s2 = 0.f;
#pragma unroll
      for (int h = 0; h < 8; ++h) { float qq = 0.f;
#pragma unroll
          for (int ks = 0; ks < 2; ++ks)
#pragma unroll
              for (int i = 0; i < 8; ++i) { const float e = bf2f((bf16_t)qf[h][ks][i]); qq = __builtin_fmaf(e, e, qq); }
          s2 = __builtin_fmaf(hw[h] * hw[h], qq, s2); }
      s2 = xrow_sum(s2);
      const float rs = rsqrtf(fmaxf(s2, 1e-30f));
#pragma unroll
      for (int h = 0; h < 8; ++h) hw[h] *= rs; }
#pragma unroll
    for (int ks = 0; ks < 2; ++ks)
#pragma unroll
        for (int i = 0; i < 8; i += 2) { float e0 = 0.f, e1 = 0.f;
#pragma unroll
            for (int h = 0; h < 8; ++h) { e0 = __builtin_fmaf(hw[h], bf2f((bf16_t)qf[h][ks][i]), e0); e1 = __builtin_fmaf(hw[h], bf2f((bf16_t)qf[h][ks][i + 1]), e1); }
            qf[8][ks][i] = (short)f2bf(e0); qf[8][ks][i + 1] = (short)f2bf(e1); }
    team_sync(tm);
    ix_passA(KNb, qf, hw, qg, tw, quad, n, tq, hist, KS);
    team_sync(tm);
    ix_search(tm, hist, segsum, needv, thrB, thrG, thrC);
    IxSel S; S.B0 = thrB[n]; S.Klo = (unsigned)S.B0 << 7; S.Khi = S.Klo | 127u;
    int refined;
    { int mx = 0;
#pragma unroll
      for (int q = 0; q < 16; ++q) mx = max(mx, thrC[q]);
      refined = mx > IX_CAP / 2; }
    if (refined) {
        team_sync(tm);
        for (int i = ttid; i < 8192 / 4; i += 256) ((LAS u32x4*)hist)[i] = (u32x4){0u, 0u, 0u, 0u};
        if (ttid < 16) needv[ttid] = 256 - thrG[ttid];
        team_sync(tm);
        ix_passK<1>(KS, qg, tw, quad, n, tq, S, hist, mrow, ccnt, candk, cands);
        team_sync(tm);
        ix_search(tm, hist, segsum, needv, thrB1, thrG1, thrC1);
        S.Klo = ((unsigned)S.B0 << 7) | (unsigned)thrB1[n]; S.Khi = S.Klo;
    }
    ix_passK<2>(KS, qg, tw, quad, n, tq, S, hist, mrow, ccnt, candk, cands);
    team_sync(tm);
    { const int qn = ttid >> 4, sub = ttid & 15; const int nc = min(ccnt[qn], IX_CAP), need = 256 - thrG[qn] - (refined ? thrG1[qn] : 0);
#ifdef MK_CHK
      if (ccnt[qn] > MK_CHK) ((unsigned*)(p.ws + WS_CTL))[50] = 2u;
#endif
      for (int c = sub; c < nc; c += 16) { const int v = candk[qn * IX_CAP + c]; const int s = cands[qn * IX_CAP + c]; int rank = 0;
          const int vs = (v << 12) | (4095 - s);
#pragma unroll 8
          for (int c2 = 0; c2 < ((nc + 7) & ~7); ++c2) { const int w2 = c2 < nc ? ((candk[qn * IX_CAP + c2] << 12) | (4095 - cands[qn * IX_CAP + c2])) : 0; rank += (w2 > vs) ? 1 : 0; }
          if (rank < need) __hip_atomic_fetch_or(&mrow[qn * IX_MROW + (s >> 5)], 1u << (s & 31), __ATOMIC_RELAXED, __HIP_MEMORY_SCOPE_WORKGROUP); } }
    team_sync(tm);
    for (int i = ttid; i < 2048; i += 256) MASK[(rowb + t0) * 128 + i] = mrow[(i >> 7) * IX_MROW + (i & 127)];
    team_sync(tm);
}

__device__ __forceinline__ void phase_ln_router(const Params& p, LAS unsigned char* lds, bool dry = false) {
    const int tid = mk_tid(), lane = tid & 63, wave = tid >> 6;
    LAS float* WR = (LAS float*)lds;
    LAS int* lcnt = (LAS int*)(lds + 147456);
    LAS int* lbase = lcnt + 32;
    LAS unsigned short* tks = (LAS unsigned short*)(lcnt + 64);
    LAS unsigned char* tke = (LAS unsigned char*)(tks + 512);
    LAS float* lgs = (LAS float*)(lds + 147456 + 256 + 1024 + 512) + wave * 144;
    for (int i = tid; i < 1024 * 32; i += NTHREADS) WR[(4 + (i & 31)) * 1024 + (i >> 5)] = p.in[23][i];
    for (int i = tid; i < 1024 * 4; i += NTHREADS) WR[(i & 3) * 1024 + (i >> 2)] = p.in[21][i];
    const bf16_t* H = (const bf16_t*)p.out; bf16_t* H1B = (bf16_t*)(p.ws + WS_H1B);
    int* EID = (int*)(p.ws + WS_EID); float* GATE = (float*)(p.ws + WS_GATE); int* SLOT = (int*)(p.ws + WS_SLOT); unsigned* gcnt = (unsigned*)(p.ws + WS_CTL);
    const float* g1 = p.in[19]; const float* b1 = p.in[20];
    for (int tile = blockIdx.x; tile < T / 256; tile += gridDim.x) {
        if (tid < 32) lcnt[tid] = 0;
        __syncthreads();
        for (int it = 0; it < 8; ++it) {
            const int tl0 = wave * 32 + it * 4, tok0 = tile * 256 + tl0;
            f32x4 v[4][4];
#pragma unroll
            for (int t = 0; t < 4; ++t)
#pragma unroll
                for (int j = 0; j < 4; ++j) { const unsigned long long hw_ = ((const unsigned long long*)(H + (size_t)(tok0 + t) * DM))[lane + 64 * j]; const unsigned h0 = (unsigned)hw_, h1_ = (unsigned)(hw_ >> 32);
                    v[t][j] = (f32x4){bflo(h0), bfhi(h0), bflo(h1_), bfhi(h1_)}; }
#pragma unroll
            for (int t = 0; t < 4; ++t) { float s = 0.f;
#pragma unroll
                for (int j = 0; j < 4; ++j) s += (v[t][j].x + v[t][j].y) + (v[t][j].z + v[t][j].w);
                const float mean = wave_sum(s) * (1.f / DM); float s2 = 0.f;
#pragma unroll
                for (int j = 0; j < 4; ++j) { v[t][j] = v[t][j] - mean; s2 += (v[t][j].x * v[t][j].x + v[t][j].y * v[t][j].y) + (v[t][j].z * v[t][j].z + v[t][j].w * v[t][j].w); }
                const float rstd = __builtin_amdgcn_rsqf(wave_sum(s2) * (1.f / DM) + 1e-5f);
#pragma unroll
                for (int j = 0; j < 4; ++j) { const f32x4 g = ((const f32x4*)g1)[lane + 64 * j], bb = ((const f32x4*)b1)[lane + 64 * j]; v[t][j] = v[t][j] * rstd * g + bb;
                    ((unsigned long long*)(H1B + (size_t)(tok0 + t) * DM))[lane + 64 * j] = (unsigned long long)pk2(v[t][j].x, v[t][j].y) | ((unsigned long long)pk2(v[t][j].z, v[t][j].w) << 32); } }
#pragma unroll 1
            for (int ob = 0; ob < 36; ob += 6) {
                float a[4][6];
#pragma unroll
                for (int o = 0; o < 6; ++o) {
                    f32x4 w[4];
#pragma unroll
                    for (int j = 0; j < 4; ++j) w[j] = ((const LAS f32x4*)(WR + (ob + o) * 1024))[lane + 64 * j];
#pragma unroll
                    for (int t = 0; t < 4; ++t) { float x = 0.f;
#pragma unroll
                        for (int j = 0; j < 4; ++j) x += (v[t][j].x * w[j].x + v[t][j].y * w[j].y) + (v[t][j].z * w[j].z + v[t][j].w * w[j].w);
                        a[t][o] = x; } }
                {
#define DPPF(x_, ctl_) __builtin_bit_cast(float, __builtin_amdgcn_mov_dpp(__builtin_bit_cast(int, x_), ctl_, 0xF, 0xF, true))
                    const bool b0 = lane & 1, b1 = lane & 2;
                    float h1[2][6];
#pragma unroll
                    for (int tt = 0; tt < 2; ++tt)
#pragma unroll
                        for (int o = 0; o < 6; ++o) { const float keep = b0 ? a[2 + tt][o] : a[tt][o], send = b0 ? a[tt][o] : a[2 + tt][o]; h1[tt][o] = keep + DPPF(send, 0xB1); }
                    float h2[6];
#pragma unroll
                    for (int o = 0; o < 6; ++o) { const float keep = b1 ? h1[1][o] : h1[0][o], send = b1 ? h1[0][o] : h1[1][o]; h2[o] = keep + DPPF(send, 0x4E); }
#pragma unroll
                    for (int o = 0; o < 6; ++o) { float x = h2[o]; x += DPPF(x, 0x128); x += DPPF(x, 0x124); h2[o] = xrow_sum(x); }
                    if (lane < 4) { const int t = 2 * (lane & 1) + ((lane >> 1) & 1);
#pragma unroll
                        for (int o = 0; o < 6; ++o) lgs[t * 36 + ob + o] = h2[o]; }
#undef DPPF
                }
            }
            asm volatile("s_waitcnt lgkmcnt(0)" ::: "memory");
            if (lane < 4) {
                const int t = lane, tl = tl0 + t, tok = tok0 + t; const LAS float* lg = lgs + t * 36;
                float gl[4];
#pragma unroll
                for (int o = 0; o < 4; ++o) gl[o] = lg[o] + p.in[22][o];
                float gm = gl[0]; int gs = 0;
#pragma unroll
                for (int o = 1; o < 4; ++o) if (gl[o] > gm) { gm = gl[o]; gs = o; }
                float gden = 0.f;
#pragma unroll
                for (int o = 0; o < 4; ++o) gden += __expf(gl[o] - gm);
                const float pg = 1.f / gden;
                float el[8];
#pragma unroll
                for (int o = 0; o < 8; ++o) el[o] = lg[4 + gs * 8 + o] + p.in[24][gs * 8 + o];
                float m1 = el[0]; int i1 = 0;
#pragma unroll
                for (int o = 1; o < 8; ++o) if (el[o] > m1) { m1 = el[o]; i1 = o; }
                float m2 = -INFINITY; int i2 = 0;
#pragma unroll
                for (int o = 0; o < 8; ++o) if (o != i1 && el[o] > m2) { m2 = el[o]; i2 = o; }
                const float e2 = __expf(m2 - m1); const float ga = pg / (1.f + e2), gb = pg * e2 / (1.f + e2);
                const int ea = gs * 8 + i1, eb = gs * 8 + i2;
                EID[tok * 2] = ea; EID[tok * 2 + 1] = eb; GATE[tok * 2] = ga; GATE[tok * 2 + 1] = gb;
                tke[tl * 2] = (unsigned char)ea; tke[tl * 2 + 1] = (unsigned char)eb;
                tks[tl * 2] = (unsigned short)__hip_atomic_fetch_add(&lcnt[ea], 1, __ATOMIC_RELAXED, __HIP_MEMORY_SCOPE_WORKGROUP);
                tks[tl * 2 + 1] = (unsigned short)__hip_atomic_fetch_add(&lcnt[eb], 1, __ATOMIC_RELAXED, __HIP_MEMORY_SCOPE_WORKGROUP);
            }
        }
        __syncthreads();
        if (tid < 32 && !dry) lbase[tid] = (int)__hip_atomic_fetch_add(&gcnt[tid], (unsigned)lcnt[tid], __ATOMIC_RELAXED, __HIP_MEMORY_SCOPE_AGENT);
        __syncthreads();
        if (!dry) { const int e_ = tke[tid], sl_ = lbase[e_] + (int)tks[tid]; SLOT[tile * 512 + tid] = sl_; ((int*)(p.ws + WS_TOKMAP))[e_ * 65536 + sl_] = tile * 256 + (tid >> 1); }
        __syncthreads();
    }
}

__device__ __forceinline__ void phase_permute(const Params& p, LAS int* tab) {
    const int tid = mk_tid(), lane = tid & 63, wave = tid >> 6;
    const int gw = blockIdx.x * NWAVES + wave, NGW = gridDim.x * NWAVES;
    const int* EID = (const int*)(p.ws + WS_EID); const int* SLOT = (const int*)(p.ws + WS_SLOT);
    const u32x4* H1B = (const u32x4*)(p.ws + WS_H1B); u32x4* XS = (u32x4*)(p.ws + WS_XS);
    for (int i = gw; i < T * 2; i += NGW) { const int tok = i >> 1; const int dst = tab[1024 + EID[i]] + SLOT[i];
        const u32x4 a = H1B[(size_t)tok * 128 + lane], b2 = H1B[(size_t)tok * 128 + 64 + lane];
        XS[(size_t)dst * 128 + lane] = a; XS[(size_t)dst * 128 + 64 + lane] = b2; }
}

__device__ __forceinline__ void phase_final(const Params& p, LAS int* tab, bool dry = false) {
    const int tid = mk_tid(), lane = tid & 63, wave = tid >> 6;
    const int gw = blockIdx.x * NWAVES + wave, NGW = gridDim.x * NWAVES;
    const int* EID = (const int*)(p.ws + WS_EID); const int* SLOT = (const int*)(p.ws + WS_SLOT); const float* GATE = (const float*)(p.ws + WS_GATE);
    const bf16_t* YS = (const bf16_t*)(p.ws + WS_XS); const float alpha = 1.189207115002721f;
    const float* g2 = p.in[28]; const float* b2 = p.in[29];
    float tsscale = 1.f;
#ifdef MK_TS
    { const volatile unsigned long long* ts = (const volatile unsigned long long*)(p.ws + WS_CTL) + 32; float f = (float)ts[1] * (MK_TS == 4 ? 0.5e-5f : 1e-5f); f = f > 1.f ? 1.f : f; tsscale = 1.f + sqrtf(3e-4f * f); }
#endif
#ifdef MK_CHK
#ifndef MK_CHKSEL
#define MK_CHKSEL 7
#endif
    { const volatile unsigned* cw = (const volatile unsigned*)(p.ws + WS_CTL); const bool bad = ((MK_CHKSEL & 1) && cw[50] == 1u) || ((MK_CHKSEL & 4) && cw[50] == 2u) || ((MK_CHKSEL & 2) && cw[51] != 0u);
      if (bad && blockIdx.x == 0 && tid == 0) p.out[0] = __builtin_nanf(""); }
#endif
    for (int tok0 = gw * 2; tok0 < T; tok0 += NGW * 2) {
        int r0[2], r1[2]; float ga[2], gb[2]; unsigned long long hw_[2][4], ya[2][4], yb[2][4];
#pragma unroll
        for (int q = 0; q < 2; ++q) { const int tok = tok0 + q; r0[q] = tab[1024 + EID[tok * 2]] + SLOT[tok * 2]; r1[q] = tab[1024 + EID[tok * 2 + 1]] + SLOT[tok * 2 + 1]; ga[q] = GATE[tok * 2]; gb[q] = GATE[tok * 2 + 1]; }
#pragma unroll
        for (int q = 0; q < 2; ++q) { const int tok = tok0 + q; const unsigned long long* hb = (const unsigned long long*)((const bf16_t*)(p.ws + WS_H1B) + (size_t)tok * DM);
#pragma unroll
            for (int j = 0; j < 4; ++j) { hw_[q][j] = hb[lane + 64 * j]; ya[q][j] = ((const unsigned long long*)(YS + (size_t)r0[q] * DM))[lane + 64 * j]; yb[q][j] = ((const unsigned long long*)(YS + (size_t)r1[q] * DM))[lane + 64 * j]; } }
#pragma unroll
        for (int q = 0; q < 2; ++q) { const int tok = tok0 + q; f32x4* hr = (f32x4*)(p.out + (size_t)tok * DM) + lane; f32x4 v[4]; float s = 0.f;
#pragma unroll
            for (int j = 0; j < 4; ++j) { const unsigned h0 = (unsigned)hw_[q][j], h1_ = (unsigned)(hw_[q][j] >> 32); const f32x4 hv = {bflo(h0), bfhi(h0), bflo(h1_), bfhi(h1_)};
                const unsigned a0 = (unsigned)ya[q][j], a1 = (unsigned)(ya[q][j] >> 32), c0 = (unsigned)yb[q][j], c1 = (unsigned)(yb[q][j] >> 32);
                v[j].x = alpha * hv.x + ga[q] * bflo(a0) + gb[q] * bflo(c0); v[j].y = alpha * hv.y + ga[q] * bfhi(a0) + gb[q] * bfhi(c0);
                v[j].z = alpha * hv.z + ga[q] * bflo(a1) + gb[q] * bflo(c1); v[j].w = alpha * hv.w + ga[q] * bfhi(a1) + gb[q] * bfhi(c1);
                s += (v[j].x + v[j].y) + (v[j].z + v[j].w); }
            const float mean = wave_sum(s) * (1.f / DM); float s2 = 0.f;
#pragma unroll
            for (int j = 0; j < 4; ++j) { v[j] = v[j] - mean; s2 += (v[j].x * v[j].x + v[j].y * v[j].y) + (v[j].z * v[j].z + v[j].w * v[j].w); }
            const float rstd = __builtin_amdgcn_rsqf(wave_sum(s2) * (1.f / DM) + 1e-5f);
#pragma unroll
            for (int j = 0; j < 4; ++j) { const f32x4 g = ((const f32x4*)g2)[lane + 64 * j], bb = ((const f32x4*)b2)[lane + 64 * j]; const f32x4 o = (v[j] * rstd * g + bb) * tsscale; if (!dry) hr[64 * j] = o; } }
    }
}

#ifdef MK_CHK
#ifndef MK_CHK_MISM
#define MK_CHK_MISM 16
#endif
#ifndef MK_CHK_ATT
#define MK_CHK_ATT 1e-3f
#endif
__device__ __forceinline__ void phase_check(const Params& p, LAS unsigned char* lds) {
    const int tid = mk_tid(), blk = blockIdx.x;
    LAS float* sc = (LAS float*)lds;
    LAS int* red = (LAS int*)(lds + 16384);
    LAS float* redf = (LAS float*)(lds + 16384 + 64);
    LAS float* ov = (LAS float*)(lds + 16384 + 128);
    const int b = blk & 15, t = ((blk >> 4) * 263 + 290 + 37 * blk) & 4095, h = (blk >> 2) & 7;
    const size_t rowb = (size_t)b * SEQ, row = rowb + t;
    const bf16_t* QI = (const bf16_t*)(p.ws + WS_QI); const bf16_t* KN = (const bf16_t*)(p.ws + WS_KN); const float* MISC = (const float*)(p.ws + WS_MISC);
    const unsigned* MASK = (const unsigned*)(p.ws + WS_MASK) + row * 128;
    unsigned* ctl = (unsigned*)(p.ws + WS_CTL);
    if (tid < 8) red[tid] = 0; if (tid < 4) redf[tid] = 0.f; if (tid < 64) ov[tid] = 0.f;
    for (int s_ = tid; s_ <= t; s_ += NTHREADS) { float acc = 0.f;
        for (int hh = 0; hh < 8; ++hh) { float d = 0.f; for (int k = 0; k < 64; ++k) d += bf2f(QI[row * 512 + hh * 64 + k]) * bf2f(KN[(rowb + s_) * 64 + k]);
            acc += (MISC[row * 80 + 64 + hh] * 0.35355339059327373f) * fmaxf(d * 0.125f, 0.f); }
        sc[s_] = acc; }
    __syncthreads();
    int mism = 0, pc = 0;
    for (int s_ = tid; s_ <= t; s_ += NTHREADS) { const float v = sc[s_]; int rank = 0;
        for (int s2 = 0; s2 <= t; ++s2) { const float v2 = sc[s2]; rank += (v2 > v || (v2 == v && s2 < s_)) ? 1 : 0; }
        const int ref = rank < 256 ? 1 : 0, got = (int)((MASK[s_ >> 5] >> (s_ & 31)) & 1u); mism += ref != got; pc += got; }
    for (int s_ = t + 1 + tid; s_ < 4096; s_ += NTHREADS) pc += 4096 * (int)((MASK[s_ >> 5] >> (s_ & 31)) & 1u);
    __hip_atomic_fetch_add(&red[0], mism, __ATOMIC_RELAXED, __HIP_MEMORY_SCOPE_WORKGROUP); __hip_atomic_fetch_add(&red[1], pc, __ATOMIC_RELAXED, __HIP_MEMORY_SCOPE_WORKGROUP);
    __syncthreads();
    if (tid == 0) { const int want = t + 1 < 256 ? t + 1 : 256; if (red[1] != want) ctl[50] = 2u; else if (red[0] > MK_CHK_MISM) ctl[50] = 1u; }
    const bf16_t* Q = (const bf16_t*)(p.ws + WS_Q); const bf16_t* K = (const bf16_t*)(p.ws + WS_K); const bf16_t* V = (const bf16_t*)(p.ws + WS_V); const bf16_t* YB = (const bf16_t*)(p.ws + WS_YB);
    __syncthreads();
    for (int s_ = tid; s_ <= t; s_ += NTHREADS) { float l = -INFINITY;
        if ((MASK[s_ >> 5] >> (s_ & 31)) & 1u) { float d = 0.f; for (int k = 0; k < 64; ++k) d += bf2f(Q[row * 512 + h * 64 + k]) * bf2f(K[(rowb + s_) * 512 + h * 64 + k]);
            const int dist = t - s_; int bk = dist; if (dist >= 16) { bk = 16 + (int)(log2f((float)dist * 0.0625f) * (16.f / 3.f)); bk = bk > 31 ? 31 : bk; }
            l = d + p.in[16][bk * 8 + h] * 1.4426950408889634f; }
        sc[s_] = l; }
    __syncthreads();
    float mx = -INFINITY; for (int s_ = 0; s_ <= t; ++s_) mx = fmaxf(mx, sc[s_]);
    float den = 0.f; for (int s_ = 0; s_ <= t; ++s_) den += exp2f(sc[s_] - mx);
    { const int d = tid & 63, part = tid >> 6; float o = 0.f;
      for (int s_ = part; s_ <= t; s_ += 8) { const float l = sc[s_]; if (l > -INFINITY) o += exp2f(l - mx) * bf2f(V[(rowb + s_) * 512 + h * 64 + d]); }
      __hip_atomic_fetch_add(&ov[d], o / den, __ATOMIC_RELAXED, __HIP_MEMORY_SCOPE_WORKGROUP); }
    __syncthreads();
    if (tid < 64) { const float ref = ov[tid], got = bf2f(YB[row * 512 + h * 64 + tid]); const float df = ref - got;
        __hip_atomic_fetch_add(&redf[0], df * df, __ATOMIC_RELAXED, __HIP_MEMORY_SCOPE_WORKGROUP); __hip_atomic_fetch_add(&redf[1], ref * ref, __ATOMIC_RELAXED, __HIP_MEMORY_SCOPE_WORKGROUP); }
    __syncthreads();
    if (tid == 0) { if (!(redf[0] <= MK_CHK_ATT * redf[1] + 1e-12f)) ctl[51] = 1u; }
    __syncthreads();
}
#endif
constexpr int NPHASE = 14;
template <int PH> __device__ __forceinline__ void run_phase(const Params& p, unsigned char* lds_g) {
    LAS unsigned char* lds = (LAS unsigned char*)lds_g;
    const int G = gridDim.x, c = blockIdx.x;
    if constexpr (PH == 0) phase_prologue(p, lds);
    if constexpr (PH == 1) { Gemm g{(const bf16_t*)((char*)p.out + DO_XBF), (const bf16_t*)(p.ws + WS_WTIN), T, 6144, 1024}; pg8::StaticOrder S; S.init(T, 6144, G, c);
        EpiIn E{p.ws}; pg8::gemm_phase<EpiIn, pg8::StaticOrder, true, true>(lds, g, S, E); }
    if constexpr (PH == 2) phase_prep(p);
    if constexpr (PH == 3) { Gemm g{(const bf16_t*)(p.ws + WS_AP), (const bf16_t*)(p.ws + WS_WTLORA), T, 1536, 256}; pg8::StaticOrder S; S.init(T, 1536, G, c);
        EpiLora E{(char*)p.out}; pg8::gemm_phase<EpiLora, pg8::StaticOrder, true, true>(lds, g, S, E); }
    if constexpr (PH == 4) {
        for (int bh = c; bh < 128; bh += G) scan_item(p, lds, bh);
        __syncthreads();
        { const int tid_ = mk_tid(); IxTeam tm; tm.tw = __builtin_amdgcn_readfirstlane((tid_ >> 6) & 3); tm.ttid = tid_ & 255; tm.lane = tid_ & 63; const int team = __builtin_amdgcn_readfirstlane(tid_ >> 8);
          tm.lds = lds + team * IX_TEAM_BYTES; tm.bar = (LAS unsigned*)(lds + IX_CTL + team * 16); tm.gen = 0u;
          if (tm.ttid < 4) tm.bar[tm.ttid] = 0u;
          __syncthreads();
          unsigned short* KS = (unsigned short*)(p.ws + (team ? WS_YB : WS_AP)) + (size_t)blockIdx.x * 65536;
          for (int qi = 0; qi < 8; ++qi) { const int xq = (c + qi) & 7; unsigned* qctr = (unsigned*)(p.ws + WS_CTL) + 40 + xq;
              for (;;) { team_sync(tm); if (tm.ttid == 0) tm.bar[2] = __hip_atomic_fetch_add(qctr, 1u, __ATOMIC_RELAXED, __HIP_MEMORY_SCOPE_AGENT); team_sync(tm);
                  const unsigned u = tm.bar[2]; if (u >= 512u) break; indexer_unit(p, tm, KS, 2 * xq + (int)(u & 1u), 255 - (int)(u >> 1)); } } }
    }
    if constexpr (PH == 6) {
        LAS float* bd = (LAS float*)(lds + attn_body::LDS_BIAS);
        for (int i = mk_tid(); i < 8 * 128; i += NTHREADS) { const int h = i >> 7, d = i & 127; int bk = d;
            if (d >= 16) { bk = 16 + (int)(log2f((float)d * 0.0625f) * (16.f / 3.f)); bk = bk > 31 ? 31 : bk; }
            bd[i] = (p.in[16][bk * 8 + h] - p.in[16][31 * 8 + h]) * 1.4426950408889634f; }
        __syncthreads();
        for (int v = c; v < 256; v += G) { const int bh = v >> 1, od = v & 1;
            for (int i = 0; i < 8; ++i) { const int pr = 2 * (i >> 1) + od; const int qb = (i & 1) ? 15 - pr : pr;
                attn_body::attn_unit<8>(bh >> 3, bh & 7, qb, (const attn_body::bf16*)(p.ws + WS_Q), (const attn_body::bf16*)(p.ws + WS_K), (const attn_body::bf16*)(p.ws + WS_V),
                                        (attn_body::bf16*)(p.ws + WS_YB), (const unsigned long long*)(p.ws + WS_MASK), (char*)lds_g); } }
    }
    if constexpr (PH == 7) { Gemm g{(const bf16_t*)((char*)p.out + DO_YA), (const bf16_t*)(p.ws + WS_WTA), T, 1024, 512}; pg8::StaticOrder S; S.init(T, 1024, G, c);
        EpiGateMul E{(const bf16_t*)(p.ws + WS_SGA), (bf16_t*)(p.ws + WS_MA), nullptr}; pg8::gemm_phase<EpiGateMul, pg8::StaticOrder, true, true>(lds, g, S, E); }
    if constexpr (PH == 8) { Gemm g{(const bf16_t*)(p.ws + WS_YB), (const bf16_t*)(p.ws + WS_WTB), T, 1024, 512}; pg8::StaticOrder S; S.init(T, 1024, G, c);
        EpiGateMul E{(const bf16_t*)(p.ws + WS_SGB), (bf16_t*)(p.ws + WS_SGA), (const bf16_t*)(p.ws + WS_MA)}; pg8::gemm_phase<EpiGateMul, pg8::StaticOrder, true, true>(lds, g, S, E); }
    if constexpr (PH == 9) { Gemm g{(const bf16_t*)(p.ws + WS_SGA), (const bf16_t*)(p.ws + WS_WTOUT), T, 1024, 1024}; pg8::StaticOrder S; S.init(T, 1024, G, c);
        EpiResid E{p.in[0], (bf16_t*)p.out, 1.189207115002721f}; pg8::gemm_phase<EpiResid, pg8::StaticOrder, true, true>(lds, g, S, E); }
    if constexpr (PH == 10) phase_ln_router(p, lds);
    if constexpr (PH == 11) { LAS int* tab = (LAS int*)(lds + LDS_TAB); moe_tables(p, tab); phase_permute(p, tab); }
    if constexpr (PH == 12) { LAS int* tab = (LAS int*)(lds + LDS_TAB); moe_tables(p, tab);
        { Gemm g{(const bf16_t*)(p.ws + WS_H1B), (const bf16_t*)(p.ws + WS_WTGU), NROWS_PAD, 32 * 1024, 1024}; MoeOrder S{tab, G, c, (const int*)(p.ws + WS_TOKMAP)};
          EpiSwiglu E{(bf16_t*)(p.ws + WS_ACT)}; pg8::gemm_phase<EpiSwiglu, MoeOrder, true, true, true>(lds, g, S, E); } }
    if constexpr (PH == 13) { LAS int* tab = (LAS int*)(lds + LDS_TAB); moe_tables(p, tab);
        { Gemm g{(const bf16_t*)(p.ws + WS_ACT), (const bf16_t*)(p.ws + WS_WTDN), NROWS_PAD, 32 * 1024, 512}; MoeOrder S{tab, G, c, nullptr};
          EpiDown E{(bf16_t*)(p.ws + WS_XS)}; pg8::gemm_phase<EpiDown, MoeOrder, true, true>(lds, g, S, E); } }
    if constexpr (PH == 14) { LAS int* tab = (LAS int*)(lds + LDS_TAB); moe_tables(p, tab); phase_final(p, tab); }
}

template <int PH> __global__ void __launch_bounds__(NTHREADS, 2) k_phase(Params p) {
    extern __shared__ __attribute__((aligned(16))) unsigned char lds[];
    run_phase<PH>(p, lds);
}
__global__ void __launch_bounds__(NTHREADS, 2) k_all(Params p) {
    extern __shared__ __attribute__((aligned(16))) unsigned char lds[];
    cooperative_groups::grid_group grid = cooperative_groups::this_grid();
    unsigned* barw = (unsigned*)(p.ws + WS_CTL) + 16384;
    volatile LAS unsigned* bst = (volatile LAS unsigned*)((LAS unsigned char*)lds + LDS_TOTAL - 16);
    if (mk_tid() < 2) bst[mk_tid()] = 0u;
    if (blockIdx.x == 0) for (int i = mk_tid(); i < XCD_BAR_WORDS; i += NTHREADS) barw[i] = 0u;
    __syncthreads();
#ifndef MK_REP
#define MK_REP -1
#endif
#define MK_DRY() (((volatile unsigned*)(p.ws + WS_CTL))[62] == 0u)
#ifdef MK_TS
#define MK_STAMP(n) do { if (blockIdx.x == 0 && mk_tid() == 0) { const unsigned long long t_ = __builtin_amdgcn_s_memrealtime(); volatile unsigned long long* q_ = (volatile unsigned long long*)(p.ws + WS_CTL) + 32; if ((n) == MK_TS) q_[1] = t_ - q_[3]; q_[3] = t_; } } while (0)
#else
#define MK_STAMP(n) do {} while (0)
#endif
#define MK_PH(n) do { run_phase<n>(p, lds); xcd_barrier(bar); MK_STAMP(n); if (MK_REP == (n)) { run_phase<n>(p, lds); xcd_barrier(bar); } } while (0)
#ifdef MK_TS
    if (blockIdx.x == 0 && mk_tid() == 0) { ((volatile unsigned long long*)(p.ws + WS_CTL))[32] = 0; ((volatile unsigned long long*)(p.ws + WS_CTL))[35] = __builtin_amdgcn_s_memrealtime(); }
#endif
    run_phase<0>(p, lds); grid.sync(); MK_STAMP(0);
    const XcdBarrier bar = xcd_barrier_post(barw, bst);
    MK_PH(1); MK_PH(2); MK_PH(3); MK_PH(4);
    if (MK_REP == 44) { if (blockIdx.x == 0 && mk_tid() < 8) __hip_atomic_store((unsigned*)(p.ws + WS_CTL) + 40 + mk_tid(), 0u, __ATOMIC_RELAXED, __HIP_MEMORY_SCOPE_AGENT); xcd_barrier(bar); run_phase<4>(p, lds); xcd_barrier(bar); }
    MK_PH(6);
#ifdef MK_CHK
    phase_check(p, (LAS unsigned char*)lds); xcd_barrier(bar);
#endif
    run_phase<7>(p, lds); if (MK_REP == 7) run_phase<7>(p, lds);
    MK_PH(8); MK_PH(9); MK_PH(10); MK_PH(12); MK_PH(13);
    if (MK_REP == 200) { for (int i = 0; i < 20; ++i) xcd_barrier(bar); }
#ifdef MK_TS
    if (blockIdx.x == 0 && mk_tid() == 0) ((volatile unsigned long long*)(p.ws + WS_CTL))[34] = __builtin_amdgcn_s_memrealtime();
    xcd_barrier(bar);
#endif
    run_phase<14>(p, lds);
    if (MK_REP == 14) { xcd_barrier(bar); run_phase<14>(p, lds); }
}
}

extern "C" void kernel_launch(void* const* d_in, const int* in_sizes, int n_in, void* d_out, int out_size,
                              void* d_ws, size_t ws_size, hipStream_t stream) {
    mk::Params p{};
    for (int i = 0; i < 30; ++i) p.in[i] = (const float*)d_in[i];
    p.out = (float*)d_out; p.ws = (char*)d_ws;
    if (ws_size < mk::WS_END) { fprintf(stderr, "workspace too small: %zu\n", ws_size); return; }
    static int grid_blocks = 0;
    if (!grid_blocks) {
        int dev = 0, cus = 0, per_cu = 0;
        (void)hipGetDevice(&dev);
        (void)hipDeviceGetAttribute(&cus, hipDeviceAttributeMultiprocessorCount, dev);
        (void)hipFuncSetAttribute((const void*)mk::k_all, hipFuncAttributeMaxDynamicSharedMemorySize, mk::LDS_TOTAL);
        (void)hipOccupancyMaxActiveBlocksPerMultiprocessor(&per_cu, mk::k_all, mk::NTHREADS, mk::LDS_TOTAL);
        grid_blocks = cus * (per_cu > 1 ? 1 : per_cu); if (grid_blocks > 256) grid_blocks = 256;
    }
    void* args[] = {&p};
    hipError_t e = hipLaunchCooperativeKernel((void*)mk::k_all, dim3(grid_blocks), dim3(mk::NTHREADS), args, mk::LDS_TOTAL, stream);
    if (e != hipSuccess) fprintf(stderr, "cooperative launch failed: %s (grid %d)\n", hipGetErrorString(e), grid_blocks);
}
```

```cpp
#include <hip/hip_runtime.h>
#include <hip/hip_bf16.h>
#include <hip/hip_cooperative_groups.h>
#include <cstdio>
#include <cstdint>
#include <cmath>
__device__ __forceinline__ int mk_tid() { int t = threadIdx.x; asm volatile("" : "+v"(t)); return t; }
#define LAS __attribute__((address_space(3)))
#define XB_TMO      128
#define XB_XCNT(j)  (256  + 64 * (j))
#define XB_XSUB(j)  (1280 + 64 * (j))
#define XB_XGEN(j)  (2304 + 64 * (j))
#define XB_TOP      3328
#define XB_TOPGEN   3392
#define XCD_BAR_WORDS 3456
#define XB_SPIN_CAP (1u << 18)

__device__ __forceinline__ unsigned xb_ld(unsigned* p)              { return __hip_atomic_load(p, __ATOMIC_RELAXED, __HIP_MEMORY_SCOPE_AGENT); }
__device__ __forceinline__ unsigned xb_add(unsigned* p, unsigned v) { return __hip_atomic_fetch_add(p, v, __ATOMIC_RELAXED, __HIP_MEMORY_SCOPE_AGENT); }
__device__ __forceinline__ unsigned xb_xcc_id() { return (unsigned)__builtin_amdgcn_s_getreg((3 << 11) | 20) & 0xFu; }
#define XB_SPIN(cond, bar) do { unsigned _sp = 0; while (cond) { __builtin_amdgcn_s_sleep(1); \
    if ((++_sp & 255u) == 0u) { if (xb_ld(&(bar)[XB_TMO])) break; if (_sp > XB_SPIN_CAP) { atomicAdd(&(bar)[XB_TMO], 1u); break; } } } } while (0)

struct XcdBarrier {
    unsigned* bar; unsigned x;
    volatile LAS unsigned* st;
};

__device__ __forceinline__ XcdBarrier xcd_barrier_post(unsigned* bar, volatile LAS unsigned* st) {
    XcdBarrier b; b.bar = bar; b.x = xb_xcc_id(); b.st = st;
    if (mk_tid() == 0) (void)xb_add(&bar[XB_XCNT(b.x)], 1u);
    return b;
}
__device__ __forceinline__ void xcd_barrier_complete(unsigned* bar, unsigned x, unsigned& nloc, unsigned& nx) {
    const unsigned G = gridDim.x * gridDim.y * gridDim.z;
    unsigned sum, cnt, mine, sp = 0u;
    for (;;) {
        sum = 0u; cnt = 0u; mine = 0u;
#pragma unroll
        for (unsigned j = 0; j < 16; ++j) { const unsigned c = xb_ld(&bar[XB_XCNT(j)]); sum += c; cnt += (c > 0u) ? 1u : 0u; mine = (j == x) ? c : mine; }
        if (sum == G) break;
        __builtin_amdgcn_s_sleep(1);
        if ((++sp & 255u) == 0u) { if (xb_ld(&bar[XB_TMO])) break; if (sp > XB_SPIN_CAP) { atomicAdd(&bar[XB_TMO], 1u); break; } }
    }
    nloc = mine > 0u ? mine : 1u; nx = cnt > 0u ? cnt : 1u;
}

__device__ __forceinline__ void xcd_barrier(const XcdBarrier& b) {
    asm volatile("s_waitcnt vmcnt(0)" ::: "memory");
    __syncthreads();
    if (mk_tid() == 0) {
        unsigned* bar = b.bar;
        __builtin_amdgcn_s_waitcnt(0);
        unsigned nloc = b.st[0], nx = b.st[1];
        if (nloc == 0u) { xcd_barrier_complete(bar, b.x, nloc, nx); b.st[0] = nloc; b.st[1] = nx; }
        const unsigned old = xb_add(&bar[XB_XSUB(b.x)], 1u);
        const unsigned gen = old / nloc;
        if (old + 1u == (gen + 1u) * nloc) {
            __builtin_amdgcn_fence(__ATOMIC_RELEASE, "agent");
            asm volatile("s_waitcnt vmcnt(0)" ::: "memory");
            const unsigned og = xb_add(&bar[XB_TOP], 1u);
            const unsigned tg = og / nx;
            if (og + 1u == (tg + 1u) * nx) xb_add(&bar[XB_TOPGEN], 1u);
            else XB_SPIN(xb_ld(&bar[XB_TOPGEN]) == tg, bar);
            __builtin_amdgcn_fence(__ATOMIC_ACQUIRE, "agent");
            xb_add(&bar[XB_XGEN(b.x)], 1u);
            asm volatile("s_waitcnt vmcnt(0)" ::: "memory");
        } else {
            XB_SPIN(xb_ld(&bar[XB_XGEN(b.x)]) == gen, bar);
            __builtin_amdgcn_fence(__ATOMIC_ACQUIRE, "agent");
            asm volatile("s_waitcnt vmcnt(0)" ::: "memory");
        }
    }
    __syncthreads();
}

namespace pg8 {
#define PG8_LAS __attribute__((address_space(3)))
typedef unsigned short bf16_t;
typedef short bf16x8 __attribute__((ext_vector_type(8)));
typedef float f32x4 __attribute__((ext_vector_type(4)));
typedef unsigned u32x4 __attribute__((ext_vector_type(4)));
constexpr int BM = 256, BK = 64, HALF = 128, HTB = HALF * BK * 2  , STAGE_BYTES = 8 * HTB, NXCD = 8, WGM = 8;

__host__ __device__ __forceinline__ int lds_byte(int r, int c) { const int st = (r >> 4) * 2 + (c >> 5), rr = r & 15, cc = c & 31, ob = rr * 64 + cc * 2; return st * 1024 + (ob ^ (((ob >> 9) & 1) << 5)); }
__host__ __device__ __forceinline__ void stage_rc(int b, int& R, int& C) { const int st = b / 1024, sb = b % 1024, swz = sb ^ (((sb >> 9) & 1) << 5); R = (st >> 1) * 16 + swz / 64; C = (st & 1) * 32 + (swz % 64) / 2; }
__host__ __device__ __forceinline__ int perm32(int rho) { const int n = rho >> 4, i = rho & 15; return 8 * (i >> 2) + 4 * n + (i & 3); }

struct Unit { int pm, pn; };
struct Gemm { const bf16_t* A; const bf16_t* Bt; int M, N, K; };

struct StaticOrder {
    int nM, nN, nwg, G, c;
    __host__ __device__ void init(int M, int N, int G_, int c_) { nM = M / BM; nN = N / BM; nwg = nM * nN; G = G_; c = c_; }
    __host__ __device__ bool next(int i, Unit& u) const {
        const long L = (long)i * G + c; if (L >= nwg) return false;
        int wgid = (int)L; { const int q = nwg / NXCD, r = nwg % NXCD, xcd = wgid % NXCD, off = wgid / NXCD; wgid = (xcd < r ? xcd * (q + 1) : r * (q + 1) + (xcd - r) * q) + off; }
        const int nig = WGM * nN, gid = wgid / nig, fm = gid * WGM, gsz = (nM - fm) < WGM ? (nM - fm) : WGM;
        u.pm = fm + ((wgid % nig) % gsz); u.pn = (wgid % nig) / gsz; return true;
    }
    __device__ __forceinline__ void a_ready(const Unit&) const {}
    __device__ __forceinline__ void done(const Unit&) const {}
};

__device__ __forceinline__ unsigned cvt_pk_bf16(float lo, float hi) { unsigned r; asm volatile("v_cvt_pk_bf16_f32 %0, %1, %2" : "=v"(r) : "v"(lo), "v"(hi)); return r; }

template <class Epi, class Sched, bool ALIGN_EPI = false, bool SP2 = false, bool GATHER = false>
__device__ __forceinline__ void gemm_phase(PG8_LAS unsigned char* lds, const Gemm g, const Sched& S, const Epi& E) {
    const int tid = mk_tid(), wid = __builtin_amdgcn_readfirstlane(tid >> 6), lane = tid & 63, wr = wid >> 2, wc = wid & 3, fr = lane & 15, fq = lane >> 4;
    const int K = g.K, nt = K / BK;
    unsigned voffA[2], voffB[2];
#pragma unroll
    for (int i = 0; i < 2; ++i) { int R, C; stage_rc(tid * 16 + i * 8192, R, C); const int Rb = Epi::PERM ? ((R & ~31) + perm32(R & 31)) : R;
        voffA[i] = (unsigned)(R * K + C) * 2u; voffB[i] = (unsigned)(Rb * K + C) * 2u; }
    const size_t kstep = (size_t)(BK * 2);
    const size_t hstep = (size_t)HALF * K * 2;
    const size_t tstep = 2 * hstep;
    const unsigned ldsw = (unsigned)wid * 1024u;
    const int aoff = lds_byte(wr * 64 + fr, fq * 8), boff = lds_byte(wc * 32 + fr, fq * 8);
#define PG8_SA(b, h) (((b) * 2 + (h)) * HTB)
#define PG8_SB(b, h) ((4 + (b) * 2 + (h)) * HTB)
#define PG8_STAGE(bufoff, gbase, voff) do { _Pragma("unroll") for (int _i = 0; _i < 2; ++_i) \
        __builtin_amdgcn_global_load_lds((const unsigned*)((const char*)(gbase) + (voff)[_i]), (PG8_LAS unsigned*)(lds + (bufoff) + ldsw + _i * 8192), 16, 0, 0); } while (0)
#define PG8_LDA(dst, b, h) do { _Pragma("unroll") for (int m = 0; m < 4; ++m) _Pragma("unroll") for (int k = 0; k < 2; ++k) dst[m][k] = *(const PG8_LAS bf16x8*)(lds + PG8_SA(b, h) + aoff + m * 2048 + k * 1024); } while (0)
#define PG8_LDB(dst, b, h) do { _Pragma("unroll") for (int n = 0; n < 2; ++n) _Pragma("unroll") for (int k = 0; k < 2; ++k) dst[n][k] = *(const PG8_LAS bf16x8*)(lds + PG8_SB(b, h) + boff + n * 2048 + k * 1024); } while (0)
#define PG8_MMA(ai, bj, At, Bt) do { __builtin_amdgcn_s_setprio(1); _Pragma("unroll") for (int m = 0; m < 4; ++m) _Pragma("unroll") for (int n = 0; n < 2; ++n) _Pragma("unroll") for (int k = 0; k < 2; ++k) \
        acc[ai][bj][m][n] = __builtin_amdgcn_mfma_f32_16x16x32_bf16(Bt[n][k], At[m][k], acc[ai][bj][m][n], 0, 0, 0); __builtin_amdgcn_s_setprio(0); } while (0)
#define PG8_WAIT_V(n) asm volatile("s_waitcnt vmcnt(" #n ")" ::: "memory")
#define PG8_WAIT_L(n) asm volatile("s_waitcnt lgkmcnt(" #n ")" ::: "memory")
#define PG8_BAR __builtin_amdgcn_s_barrier()
#define PG8_SCHED __builtin_amdgcn_sched_barrier(0)
    Unit cur, nxt; int ui = 0;
    if (!S.next(0, cur)) return;
    f32x4 acc[2][2][4][2];
#pragma unroll
    for (int a = 0; a < 2; ++a)
#pragma unroll
        for (int b = 0; b < 2; ++b)
#pragma unroll
            for (int m = 0; m < 4; ++m)
#pragma unroll
                for (int n = 0; n < 2; ++n) acc[a][b][m][n] = (f32x4){0.f, 0.f, 0.f, 0.f};
    bf16x8 At[4][2], B0[2][2], B1[2][2];
    static_assert(!GATHER || SP2, "row gather is wired into the SP2 loop only");
    const char* cA = GATHER ? (const char*)g.A : (const char*)g.A + (size_t)cur.pm * tstep; const char* cB = (const char*)g.Bt + (size_t)cur.pn * tstep;
    unsigned vA0[2] = {0u, 0u}, vA1[2] = {0u, 0u}, nvA0[2] = {0u, 0u}, nvA1[2] = {0u, 0u};
#define PG8_GOFF(u_, o0_, o1_) do { _Pragma("unroll") for (int i = 0; i < 2; ++i) { int R_, C_; stage_rc(tid * 16 + i * 8192, R_, C_); \
        o0_[i] = (unsigned)(S.srcrow(u_, R_) * K + C_) * 2u; o1_[i] = (unsigned)(S.srcrow(u_, HALF + R_) * K + C_) * 2u; } } while (0)
    if constexpr (GATHER) { PG8_GOFF(cur, vA0, vA1); nvA0[0] = vA0[0]; nvA0[1] = vA0[1]; nvA1[0] = vA1[0]; nvA1[1] = vA1[1]; }
#define PG8_STAGE_A(bufoff, base, half, OFF0, OFF1) do { if constexpr (GATHER) { if (half) PG8_STAGE(bufoff, base, OFF1); else PG8_STAGE(bufoff, base, OFF0); } \
        else { PG8_STAGE(bufoff, (base) + ((half) ? hstep : (size_t)0), voffA); } } while (0)
    S.a_ready(cur);
    if constexpr (SP2) {
        PG8_STAGE(PG8_SB(0, 0), cB, voffB); PG8_STAGE(PG8_SB(0, 1), cB + hstep, voffB); PG8_STAGE_A(PG8_SA(0, 0), cA, 0, vA0, vA1); PG8_STAGE_A(PG8_SA(0, 1), cA, 1, vA0, vA1);
        if (wr == 1) PG8_BAR;
        PG8_WAIT_V(2); PG8_BAR;
        PG8_STAGE(PG8_SB(1, 0), cB + kstep, voffB); PG8_STAGE_A(PG8_SA(1, 0), cA + kstep, 0, vA0, vA1); PG8_STAGE(PG8_SB(1, 1), cB + hstep + kstep, voffB);
        PG8_WAIT_V(6); PG8_BAR;
    } else {
        PG8_STAGE(PG8_SB(0, 0), cB, voffB); PG8_STAGE(PG8_SA(0, 0), cA, voffA); PG8_STAGE(PG8_SB(0, 1), cB + hstep, voffB); PG8_STAGE(PG8_SA(0, 1), cA + hstep, voffA);
        if (wr == 1) PG8_BAR;
        PG8_WAIT_V(4); PG8_BAR;
        PG8_STAGE(PG8_SB(1, 0), cB + kstep, voffB); PG8_STAGE(PG8_SA(1, 0), cA + kstep, voffA); PG8_STAGE(PG8_SB(1, 1), cB + hstep + kstep, voffB);
        PG8_WAIT_V(6); PG8_BAR;
    }
    for (;;) {
        const bool has_next = S.next(ui + 1, nxt);
        const char* nA = GATHER ? cA : (has_next ? (const char*)g.A + (size_t)nxt.pm * tstep : cA); const char* nB = has_next ? (const char*)g.Bt + (size_t)nxt.pn * tstep : cB;
        if constexpr (GATHER) { if (has_next) PG8_GOFF(nxt, nvA0, nvA1); }
        for (int t = 0; t < nt; t += 2) {
            const bool last = (t == nt - 2);
            const char* a1 = cA + (size_t)(t + 1) * kstep;
            const char* a2 = last ? nA : cA + (size_t)(t + 2) * kstep; const char* b2 = last ? nB : cB + (size_t)(t + 2) * kstep;
            const char* a3 = a2 + kstep; const char* b3 = b2 + kstep;
            if (last && has_next) S.a_ready(nxt);
            if constexpr (SP2) {
            unsigned sA0[2] = {0u, 0u}, sA1[2] = {0u, 0u};
            if constexpr (GATHER) { sA0[0] = last ? nvA0[0] : vA0[0]; sA0[1] = last ? nvA0[1] : vA0[1]; sA1[0] = last ? nvA1[0] : vA1[0]; sA1[1] = last ? nvA1[1] : vA1[1]; }
            PG8_LDB(B0, 0, 0); PG8_LDB(B1, 0, 1); PG8_SCHED; PG8_LDA(At, 0, 0); PG8_STAGE_A(PG8_SA(1, 1), a1, 1, vA0, vA1);
            PG8_WAIT_V(8); PG8_WAIT_L(0); PG8_BAR; PG8_MMA(0, 0, At, B0); PG8_MMA(0, 1, At, B1); PG8_BAR; PG8_SCHED;
            PG8_LDA(At, 0, 1); PG8_STAGE(PG8_SB(0, 0), b2, voffB); PG8_STAGE(PG8_SB(0, 1), b2 + hstep, voffB); PG8_STAGE_A(PG8_SA(0, 0), a2, 0, sA0, sA1);
            PG8_WAIT_V(8); PG8_WAIT_L(0); PG8_BAR; PG8_MMA(1, 0, At, B0); PG8_MMA(1, 1, At, B1); PG8_BAR; PG8_SCHED;
            PG8_LDB(B0, 1, 0); PG8_LDB(B1, 1, 1); PG8_SCHED; PG8_LDA(At, 1, 0); PG8_STAGE_A(PG8_SA(0, 1), a2, 1, sA0, sA1);
            PG8_WAIT_V(8); PG8_WAIT_L(0); PG8_BAR; PG8_MMA(0, 0, At, B0); PG8_MMA(0, 1, At, B1); PG8_BAR; PG8_SCHED;
            PG8_LDA(At, 1, 1); PG8_STAGE(PG8_SB(1, 0), b3, voffB); PG8_STAGE(PG8_SB(1, 1), b3 + hstep, voffB); PG8_STAGE_A(PG8_SA(1, 0), a3, 0, sA0, sA1);
            PG8_WAIT_V(8); PG8_WAIT_L(0); PG8_BAR; PG8_MMA(1, 0, At, B0); PG8_MMA(1, 1, At, B1); PG8_BAR; PG8_SCHED;
            } else {
            PG8_LDB(B0, 0, 0); PG8_SCHED; PG8_LDA(At, 0, 0); PG8_STAGE(PG8_SA(1, 1), a1 + hstep, voffA);
            PG8_WAIT_L(8); PG8_BAR; PG8_WAIT_L(0); PG8_MMA(0, 0, At, B0); PG8_BAR; PG8_SCHED;
            PG8_LDB(B1, 0, 1); PG8_STAGE(PG8_SB(0, 0), b2, voffB);
            PG8_BAR; PG8_WAIT_L(0); PG8_MMA(0, 1, At, B1); PG8_BAR;
            PG8_LDA(At, 0, 1); PG8_STAGE(PG8_SA(0, 0), a2, voffA);
            PG8_BAR; PG8_WAIT_L(0); PG8_MMA(1, 0, At, B0); PG8_BAR; PG8_SCHED;
            PG8_STAGE(PG8_SB(0, 1), b2 + hstep, voffB);
            PG8_WAIT_V(6); PG8_BAR; PG8_MMA(1, 1, At, B1); PG8_BAR;
            PG8_LDB(B0, 1, 0); PG8_SCHED; PG8_LDA(At, 1, 0); PG8_STAGE(PG8_SA(0, 1), a2 + hstep, voffA);
            PG8_WAIT_L(8); PG8_BAR; PG8_WAIT_L(0); PG8_MMA(0, 0, At, B0); PG8_BAR; PG8_SCHED;
            PG8_LDB(B1, 1, 1); PG8_STAGE(PG8_SB(1, 0), b3, voffB);
            PG8_BAR; PG8_WAIT_L(0); PG8_MMA(0, 1, At, B1); PG8_BAR;
            PG8_LDA(At, 1, 1); PG8_STAGE(PG8_SA(1, 0), a3, voffA);
            PG8_BAR; PG8_WAIT_L(0); PG8_MMA(1, 0, At, B0); PG8_BAR; PG8_SCHED;
            PG8_STAGE(PG8_SB(1, 1), b3 + hstep, voffB);
            PG8_WAIT_V(6); PG8_BAR; PG8_MMA(1, 1, At, B1); PG8_BAR;
            }
        }
        if constexpr (ALIGN_EPI) { if (wr == 0) PG8_BAR; }
        if constexpr (!Epi::AFTER_DRAIN) { E(acc, cur, wr, wc, fr, fq); S.done(cur); }
        if (!has_next) break;
#pragma unroll
        for (int a = 0; a < 2; ++a)
#pragma unroll
            for (int b = 0; b < 2; ++b)
#pragma unroll
                for (int m = 0; m < 4; ++m)
#pragma unroll
                    for (int n = 0; n < 2; ++n) acc[a][b][m][n] = (f32x4){0.f, 0.f, 0.f, 0.f};
        cur = nxt; cA = nA; cB = nB; ++ui;
#pragma unroll
        for (int i = 0; i < 2; ++i) { vA0[i] = nvA0[i]; vA1[i] = nvA1[i]; }
        (void)sizeof(vA0);
        if constexpr (ALIGN_EPI) { if (wr == 1) PG8_BAR; }
    }
    PG8_WAIT_V(0);
    if constexpr (!ALIGN_EPI) { if (wr == 0) PG8_BAR; }
    PG8_BAR;
    if constexpr (Epi::AFTER_DRAIN) { E.fused(acc, cur, wr, wc, fr, fq, lds, wid, lane); S.done(cur); }
#undef PG8_SA
#undef PG8_GOFF
#undef PG8_STAGE_A
#undef PG8_SB
#undef PG8_STAGE
#undef PG8_LDA
#undef PG8_LDB
#undef PG8_MMA
#undef PG8_WAIT_V
#undef PG8_WAIT_L
#undef PG8_BAR
#undef PG8_SCHED
}
}
namespace attn_body {
using bf16=__hip_bfloat16;
using bf16x8=__attribute__((ext_vector_type(8)))short;
using s16x4=__attribute__((ext_vector_type(4)))short;
using f32x16=__attribute__((ext_vector_type(16)))float;
using u32x4=__attribute__((ext_vector_type(4)))unsigned;
constexpr int BATCH=16,NHEAD=8,SEQ=4096,D=64,DM=NHEAD*D;
constexpr int NW=8,QBLK=32,QB=QBLK*NW,KVBLK=64,NQB=SEQ/QB;
constexpr int ATTN_PITCH=DM, ATTN_UNIT_ROWS=QB;
__device__ __forceinline__ int crow(int r,int hi){return (r&3)+8*(r>>2)+4*hi;}
#define SBAR() __builtin_amdgcn_sched_barrier(0)
__device__ __forceinline__ void biasw(f32x16&p0,f32x16&p1,int dbase,const __attribute__((address_space(3))) float*bdl){
  #pragma unroll
  for(int r=0;r<16;++r){const int pos=(r&3)+8*(r>>2);
    int d0=dbase-pos, d1=d0-32; d0=d0<0?0:(d0>127?127:d0); d1=d1<0?0:(d1>127?127:d1); p0[r]+=bdl[d0]; p1[r]+=bdl[d1]; }
}
#define MPOS(r) (((r)&3)+8*((r)>>2))
__device__ __forceinline__ float mand(float p,unsigned w,int pos){ return __builtin_bit_cast(float,__builtin_bit_cast(unsigned,p)&(unsigned)__builtin_amdgcn_sbfe((int)w,pos,1)); }

constexpr int NSLOT=3, SLOTB=8192;
constexpr int LDS_K=0, LDS_V=NSLOT*SLOTB, LDS_WS=2*NSLOT*SLOTB, LDS_OST=LDS_WS+NW*64*4, LDS_BIAS=LDS_OST+NW*4096, LDS_BYTES=LDS_BIAS+NHEAD*128*4;
constexpr float C2=0.125f*1.4426950408889634f;
__device__ __forceinline__ void glds16(const void*gsrc,unsigned lds_dst){unsigned keep;
  asm volatile("s_mov_b32 %0, m0\n\ts_mov_b32 m0, %2\n\ts_nop 0\n\tglobal_load_lds_dwordx4 %1, off\n\ts_mov_b32 m0, %0":"=&s"(keep):"v"(gsrc),"s"(lds_dst):"memory");}
__device__ __forceinline__ float max3f(float a,float b,float c){float r;asm("v_max3_f32 %0, %1, %2, %3":"=v"(r):"v"(a),"v"(b),"v"(c));return r;}
__device__ __forceinline__ float max2f(float a,float b){float r;asm("v_max_f32_e32 %0, %1, %2":"=v"(r):"v"(a),"v"(b));return r;}
__device__ __forceinline__ float fadd_s(float a,float b){float r;asm("v_add_f32_e32 %0, %1, %2":"=v"(r):"v"(a),"v"(b));return r;}
__device__ __forceinline__ float fsub_s(float a,float b){float r;asm("v_sub_f32_e32 %0, %1, %2":"=v"(r):"v"(a),"v"(b));return r;}
typedef float f32x2_t __attribute__((ext_vector_type(2))); typedef __bf16 bf16x2_t __attribute__((ext_vector_type(2)));
__device__ __forceinline__ unsigned cvtpk_s(float lo,float hi){f32x2_t v={lo,hi};bf16x2_t b=__builtin_convertvector(v,bf16x2_t);return __builtin_bit_cast(unsigned,b);}
#define WAIT_BAR(N) asm volatile("s_waitcnt vmcnt(" #N ") lgkmcnt(0)\n\ts_barrier":::"memory")

__device__ __forceinline__ void qkt(f32x16&p0,f32x16&p1,const char*Kslot,const bf16x8*qr,const f32x16&negm,int r32,int hi){
  const char*kb=Kslot+hi*1024+r32*16;
  #pragma unroll
  for(int d0=0;d0<4;++d0){
    const bf16x8 b0=*reinterpret_cast<const bf16x8*>(kb+d0*2048);
    const bf16x8 b1=*reinterpret_cast<const bf16x8*>(kb+d0*2048+512);
    if(d0==0){p0=__builtin_amdgcn_mfma_f32_32x32x16_bf16(b0,qr[0],negm,0,0,0);p1=__builtin_amdgcn_mfma_f32_32x32x16_bf16(b1,qr[0],negm,0,0,0);}
    else{p0=__builtin_amdgcn_mfma_f32_32x32x16_bf16(b0,qr[d0],p0,0,0,0);p1=__builtin_amdgcn_mfma_f32_32x32x16_bf16(b1,qr[d0],p1,0,0,0);}}
}
typedef __attribute__((address_space(3))) const char* lds_cptr;
typedef short v4i16_t __attribute__((ext_vector_type(4)));
__device__ __forceinline__ void kload8(bf16x8*kf,lds_cptr kp){
  kf[0]=*(const __attribute__((address_space(3))) bf16x8*)(kp);      kf[1]=*(const __attribute__((address_space(3))) bf16x8*)(kp+512);
  kf[2]=*(const __attribute__((address_space(3))) bf16x8*)(kp+2048); kf[3]=*(const __attribute__((address_space(3))) bf16x8*)(kp+2560);
  kf[4]=*(const __attribute__((address_space(3))) bf16x8*)(kp+4096); kf[5]=*(const __attribute__((address_space(3))) bf16x8*)(kp+4608);
  kf[6]=*(const __attribute__((address_space(3))) bf16x8*)(kp+6144); kf[7]=*(const __attribute__((address_space(3))) bf16x8*)(kp+6656);
}
__device__ __forceinline__ void kload2(bf16x8*kf,lds_cptr kp,int j){ kf[2*j]=*(const __attribute__((address_space(3))) bf16x8*)(kp+j*2048); kf[2*j+1]=*(const __attribute__((address_space(3))) bf16x8*)(kp+j*2048+512); }
__device__ __forceinline__ s16x4 vtr(lds_cptr p){ return __builtin_bit_cast(s16x4,__builtin_amdgcn_ds_read_tr16_b64_v4i16((__attribute__((address_space(3))) v4i16_t*)p)); }
__device__ __forceinline__ float rowmax(const f32x16&p0,const f32x16&p1){
  float a=max3f(p0[0],p0[1],p1[0]),b=max3f(p0[2],p0[3],p1[1]);a=max3f(a,p1[2],p1[3]);
  #pragma unroll
  for(int r=4;r<16;r+=4){a=max3f(a,p0[r],p0[r+1]);b=max3f(b,p0[r+2],p0[r+3]);a=max3f(a,p1[r],p1[r+1]);b=max3f(b,p1[r+2],p1[r+3]);}
  const float m=max2f(a,b);
  auto rr=__builtin_amdgcn_permlane32_swap(__float_as_uint(m),__float_as_uint(m),false,false);
  return max2f(__uint_as_float(rr[0]),__uint_as_float(rr[1]));
}
__device__ __forceinline__ void pv(f32x16*o,int vb,bf16x8 pa0,bf16x8 pa1,bf16x8 pa2,bf16x8 pa3){
  #pragma unroll
  for(int d0=0;d0<2;++d0){s16x4 lo[4],hi[4];
    #pragma unroll
    for(int ks=0;ks<4;++ks){
      asm volatile("ds_read_b64_tr_b16 %0,%1 offset:%c2":"=&v"(lo[ks]):"v"(vb),"i"(d0*4096+ks*1024):"memory");
      asm volatile("ds_read_b64_tr_b16 %0,%1 offset:%c2":"=&v"(hi[ks]):"v"(vb),"i"(d0*4096+ks*1024+512):"memory");}
    asm volatile("s_waitcnt lgkmcnt(0)":::"memory");SBAR();
    #define PK(k) (bf16x8){lo[k][0],lo[k][1],lo[k][2],lo[k][3],hi[k][0],hi[k][1],hi[k][2],hi[k][3]}
    o[d0]=__builtin_amdgcn_mfma_f32_32x32x16_bf16(pa0,PK(0),o[d0],0,0,0);
    o[d0]=__builtin_amdgcn_mfma_f32_32x32x16_bf16(pa1,PK(1),o[d0],0,0,0);
    o[d0]=__builtin_amdgcn_mfma_f32_32x32x16_bf16(pa2,PK(2),o[d0],0,0,0);
    o[d0]=__builtin_amdgcn_mfma_f32_32x32x16_bf16(pa3,PK(3),o[d0],0,0,0);
    #undef PK
  }
}

#ifndef ATTN_STORE16
#define ATTN_STORE16(p,v) (*(u32x4*)(p)=(v))
#endif
template<int THRL> __device__ __forceinline__ void attn_unit(int b,int h,int qb,const bf16*Q,const bf16*__restrict__ K,const bf16*__restrict__ V,bf16*O,const unsigned long long*MK,char*shm){
  const int tid=mk_tid(),lane=tid&63,r32=lane&31,hi=lane>>5; const int wid=__builtin_amdgcn_readfirstlane(tid>>6);
  const long rowbase=(long)b*SEQ; const int q0=qb*QB;
  const bf16*Qw=Q+(rowbase+q0+wid*QBLK)*DM+h*D;
  const bf16*Kh=K+rowbase*DM+h*D,*Vh=V+rowbase*DM+h*D;
  const lds_cptr shm3=(lds_cptr)shm;
  const unsigned lds0=(unsigned)(uintptr_t)shm;
  float*wsf=(float*)(shm+LDS_WS)+wid*64;
  const bf16*ksrc=Kh+(long)lane*DM+wid*8;
  const bf16*vsrc=Vh+(long)(16*(wid&3)+(lane>>2))*DM+(wid>>2)*32+(lane&3)*8;
  const unsigned kdst=lds0+LDS_K+wid*1024, vdst=lds0+LDS_V+wid*1024;
  #define DMA_K(t,slot) glds16(ksrc+(long)(t)*KVBLK*DM,(unsigned)__builtin_amdgcn_readfirstlane(kdst+(slot)))
  #define DMA_V(t,slot) glds16(vsrc+(long)(t)*KVBLK*DM,(unsigned)__builtin_amdgcn_readfirstlane(vdst+(slot)))
  const int vb0=(int)(lds0+LDS_V)+((lane>>4)&1)*32+(lane&3)*8+(4*hi+((lane&15)>>2))*64;
  const char*Kbase=shm+LDS_K; bf16x8 kf[8];
  const lds_cptr kp0=shm3+LDS_K+hi*1024+r32*16; const lds_cptr vp0=shm3+LDS_V+((lane>>4)&1)*32+(lane&3)*8+(4*hi+((lane&15)>>2))*64;
  const int NT=(q0+QB)/KVBLK;
  const int qrel=wid*QBLK+r32;
  const unsigned long long*mkp=MK+(rowbase+q0+qrel)*64;
  const __attribute__((address_space(3))) float*bdl=(const __attribute__((address_space(3))) float*)(shm3+LDS_BIAS)+h*128;
  unsigned long long mwA,mwB;
  #define MLOAD(M,t) asm volatile("global_load_dwordx2 %0, %1, off":"=&v"(M):"v"(mkp+(t)):"memory")
  #define MPIN(M) asm volatile("":"+v"(M))
  MLOAD(mwA,0);MLOAD(mwB,1);
  DMA_K(0,0);DMA_V(0,0);DMA_K(1,SLOTB);
  bf16x8 qr[4];
  #pragma unroll
  for(int d0=0;d0<4;++d0)qr[d0]=*reinterpret_cast<const bf16x8*>(&Qw[(long)r32*DM+d0*16+hi*8]);
  float mhat=0.f,l_reg=0.f;f32x16 o[2];o[0]=f32x16{};o[1]=f32x16{};const f32x16 negm=f32x16{};
  #define CMASK(P0,P1,t,M) do{ if((t)>=NT-6)biasw(P0,P1,q0+qrel-64*(t)-4*hi,bdl); }while(0)
  bool resc=false;
  #define START(P0,P1) do{ const float rm=rowmax(P0,P1); resc=false; mhat=__builtin_fmaxf(rm,0.f); \
    _Pragma("unroll") for(int r=0;r<16;++r)P0[r]=mand(__builtin_amdgcn_exp2f(P0[r]-mhat),((unsigned)mwA)>>(4*hi),MPOS(r)); }while(0)
  #define RESC() do{ if(resc){ asm volatile("s_waitcnt lgkmcnt(0)":::"memory"); \
      _Pragma("unroll") for(int d_=0;d_<2;++d_) _Pragma("unroll") for(int r=0;r<16;++r)o[d_][r]*=wsf[crow(r,hi)]; } }while(0)
  f32x16 pA0,pA1,pB0,pB1;
  int sl_prev=0,sl_cur=0,sl_next=SLOTB;
  #define ROT() do{sl_prev=sl_cur;sl_cur=sl_next;sl_next=(sl_next==(NSLOT-1)*SLOTB)?0:sl_next+SLOTB;}while(0)
  DMA_K(2,2*SLOTB);
  WAIT_BAR(3); MPIN(mwA); MPIN(mwB);
  qkt(pA0,pA1,Kbase,qr,negm,r32,hi);asm volatile("s_nop 15\n\ts_nop 7":"+v"(pA0),"+v"(pA1));CMASK(pA0,pA1,0,mwA);
  START(pA0,pA1);
  _Pragma("unroll") for(int r=0;r<16;++r)pA1[r]=mand(__builtin_amdgcn_exp2f(pA1[r]-mhat),((unsigned)(mwA>>32))>>(4*hi),MPOS(r));
  WAIT_BAR(0);
  DMA_K(3,0);DMA_V(1,SLOTB);
  ROT();
  kload8(kf,kp0+sl_cur);
  WAIT_BAR(2);
  s16x4 vlo[8],vhi[8]; u32x4 pw0,pw1,pw2,pw3;
  #define PKW(P,B) cvtpk_s(P[B],P[B+1])
  #define PAF(k) __builtin_bit_cast(bf16x8,pw##k)
  #define VFR(i) (bf16x8){vlo[i][0],vlo[i][1],vlo[i][2],vlo[i][3],vhi[i][0],vhi[i][1],vhi[i][2],vhi[i][3]}
  #define PIN(x) asm volatile("":"+v"(x))
  #define MX3(a,b,c) __builtin_fmaxf(__builtin_fmaxf((a),(b)),(c))
  #define GAPA(MF,A0,A1,A2,A3,W0,W1,PW) do{ MF; sacc+=A0; sacc+=A1; sacc+=A2; sacc+=A3; PIN(sacc); W0; W1; PIN(PW); SBAR(); }while(0)
  #define EX(v) __builtin_amdgcn_exp2f(v)
  #define GAPB(MF,X,B,W) do{ MF; X[B]=mand(EX(X[B]-mhat),W,MPOS(B)); X[B+1]=mand(EX(X[B+1]-mhat),W,MPOS(B+1)); X[B+2]=mand(EX(X[B+2]-mhat),W,MPOS(B+2)); X[B+3]=mand(EX(X[B+3]-mhat),W,MPOS(B+3)); PIN(X); SBAR(); }while(0)
  #define VRD(i) do{ vlo[i]=vtr(vp_+(((i)>>2)*4096+((i)&3)*1024)); vhi[i]=vtr(vp_+(((i)>>2)*4096+((i)&3)*1024+512)); }while(0)
  #define KRD(G,j) do{ if(G){ kload2(kf,kp0+sl_next,j); SBAR(); } }while(0)
  #define STEP(C0,C1,P0,P1,t,GK,GV,GL,MC,MN) do{ SBAR(); if(GV){MLOAD(MN,(t)+1);} \
    const lds_cptr vp_=vp0+sl_prev; \
    VRD(0); SBAR(); float sacc=(P0[0]+P0[1]); \
    GAPA(C0=__builtin_amdgcn_mfma_f32_32x32x16_bf16(kf[0],qr[0],negm,0,0,0), P0[2],P0[3],P0[4],P0[5],     pw0[0]=PKW(P0,0), pw0[1]=PKW(P0,2), pw0); \
    VRD(4); SBAR(); GAPA(C1=__builtin_amdgcn_mfma_f32_32x32x16_bf16(kf[1],qr[0],negm,0,0,0), P0[6],P0[7],P0[8],P0[9],     pw0[2]=PKW(P0,4), pw0[3]=PKW(P0,6), pw0); \
    VRD(1); SBAR(); GAPA(C0=__builtin_amdgcn_mfma_f32_32x32x16_bf16(kf[2],qr[1],C0,0,0,0),   P0[10],P0[11],P0[12],P0[13], pw1[0]=PKW(P0,8), pw1[1]=PKW(P0,10), pw1); \
    VRD(5); SBAR(); GAPA(C1=__builtin_amdgcn_mfma_f32_32x32x16_bf16(kf[3],qr[1],C1,0,0,0),   P0[14],P0[15],P1[0],P1[1],   pw1[2]=PKW(P0,12),pw1[3]=PKW(P0,14), pw1); \
    VRD(2); SBAR(); GAPA(C0=__builtin_amdgcn_mfma_f32_32x32x16_bf16(kf[4],qr[2],C0,0,0,0),   P1[2],P1[3],P1[4],P1[5],     pw2[0]=PKW(P1,0), pw2[1]=PKW(P1,2), pw2); \
    VRD(6); SBAR(); GAPA(C1=__builtin_amdgcn_mfma_f32_32x32x16_bf16(kf[5],qr[2],C1,0,0,0),   P1[6],P1[7],P1[8],P1[9],     pw2[2]=PKW(P1,4), pw2[3]=PKW(P1,6), pw2); \
    VRD(3); SBAR(); GAPA(C0=__builtin_amdgcn_mfma_f32_32x32x16_bf16(kf[6],qr[3],C0,0,0,0),   P1[10],P1[11],P1[12],P1[13], pw3[0]=PKW(P1,8), pw3[1]=PKW(P1,10), pw3); \
    VRD(7); SBAR(); GAPA(C1=__builtin_amdgcn_mfma_f32_32x32x16_bf16(kf[7],qr[3],C1,0,0,0),   P1[14],P1[15],0.f,0.f,       pw3[2]=PKW(P1,12),pw3[3]=PKW(P1,14), pw3); \
    l_reg+=sacc; \
    if(GK){DMA_K((t)+3,sl_cur);} if(GV){DMA_V((t)+1,sl_next);} \
    CMASK(C0,C1,t,MC); const unsigned mlo_=((unsigned)(MC))>>(4*hi), mhi_=((unsigned)((MC)>>32))>>(4*hi); \
    { float a=MX3(C0[0],C0[1],C1[0]),b=MX3(C0[2],C0[3],C1[1]); a=MX3(a,C1[2],C1[3]); \
      _Pragma("unroll") for(int r=4;r<16;r+=4){a=MX3(a,C0[r],C0[r+1]);b=MX3(b,C0[r+2],C0[r+3]);a=MX3(a,C1[r],C1[r+1]);b=MX3(b,C1[r+2],C1[r+3]);} \
      float rm=__builtin_fmaxf(a,b); { auto rr=__builtin_amdgcn_permlane32_swap(__float_as_uint(rm),__float_as_uint(rm),false,false); rm=__builtin_fmaxf(__uint_as_float(rr[0]),__uint_as_float(rr[1])); } \
      resc=false; const float rd=rm-mhat; \
      if(__builtin_expect(__any(rd>(float)THRL),0)){ const float dl=__builtin_fmaxf(rd,0.f); mhat+=dl; \
        const float f=__builtin_amdgcn_exp2f(-dl); l_reg*=f; if(hi==0)wsf[r32]=f; resc=true; } } \
    SBAR(); \
    GAPB(o[0]=__builtin_amdgcn_mfma_f32_32x32x16_bf16(PAF(0),VFR(0),o[0],0,0,0), C0,0,mlo_); \
    GAPB(o[1]=__builtin_amdgcn_mfma_f32_32x32x16_bf16(PAF(0),VFR(4),o[1],0,0,0), C0,4,mlo_); \
    KRD(GL,0); GAPB(o[0]=__builtin_amdgcn_mfma_f32_32x32x16_bf16(PAF(1),VFR(1),o[0],0,0,0), C0,8,mlo_); \
    KRD(GL,1); GAPB(o[1]=__builtin_amdgcn_mfma_f32_32x32x16_bf16(PAF(1),VFR(5),o[1],0,0,0), C0,12,mlo_); \
    KRD(GL,2); GAPB(o[0]=__builtin_amdgcn_mfma_f32_32x32x16_bf16(PAF(2),VFR(2),o[0],0,0,0), C1,0,mhi_); \
    KRD(GL,3); GAPB(o[1]=__builtin_amdgcn_mfma_f32_32x32x16_bf16(PAF(2),VFR(6),o[1],0,0,0), C1,4,mhi_); \
    GAPB(o[0]=__builtin_amdgcn_mfma_f32_32x32x16_bf16(PAF(3),VFR(3),o[0],0,0,0), C1,8,mhi_); \
    GAPB(o[1]=__builtin_amdgcn_mfma_f32_32x32x16_bf16(PAF(3),VFR(7),o[1],0,0,0), C1,12,mhi_); \
    }while(0)
  int t=1;
  #undef CMASK
  #define CMASK(P0,P1,t,M) do{}while(0)
  for(;t+7<NT;t+=2){
    STEP(pB0,pB1,pA0,pA1,t,true,true,true,mwB,mwA);     WAIT_BAR(2); MPIN(mwA); RESC(); ROT();
    STEP(pA0,pA1,pB0,pB1,t+1,true,true,true,mwA,mwB);   WAIT_BAR(2); MPIN(mwB); RESC(); ROT();
  }
  #undef CMASK
  #define CMASK(P0,P1,t,M) do{ if((t)>=NT-6)biasw(P0,P1,q0+qrel-64*(t)-4*hi,bdl); }while(0)
  #define ENDW(tt) do{ if((tt)+3<NT){WAIT_BAR(2);} else if((tt)+2<NT){WAIT_BAR(1);} else {WAIT_BAR(0);} }while(0)
  for(;t+1<NT;t+=2){
    STEP(pB0,pB1,pA0,pA1,t,(t+3<NT),(t+1<NT),(t+1<NT),mwB,mwA);       ENDW(t);   MPIN(mwA); RESC(); ROT();
    STEP(pA0,pA1,pB0,pB1,t+1,(t+4<NT),(t+2<NT),(t+2<NT),mwA,mwB);     ENDW(t+1); MPIN(mwB); RESC(); ROT();
  }
  STEP(pB0,pB1,pA0,pA1,NT-1,false,false,false,mwB,mwA); RESC();
  { float sacc=pB0[0]+pB0[1]; _Pragma("unroll") for(int r=2;r<16;++r)sacc+=pB0[r]; _Pragma("unroll") for(int r=0;r<16;++r)sacc+=pB1[r]; l_reg+=sacc;
    pw0=(u32x4){PKW(pB0,0),PKW(pB0,2),PKW(pB0,4),PKW(pB0,6)};pw1=(u32x4){PKW(pB0,8),PKW(pB0,10),PKW(pB0,12),PKW(pB0,14)};pw2=(u32x4){PKW(pB1,0),PKW(pB1,2),PKW(pB1,4),PKW(pB1,6)};pw3=(u32x4){PKW(pB1,8),PKW(pB1,10),PKW(pB1,12),PKW(pB1,14)};
    SBAR(); pv(o,vb0+sl_cur,PAF(0),PAF(1),PAF(2),PAF(3)); }
  #undef PKW
  #undef PAF
  #undef VFR
  #undef PIN
  #undef MX3
  #undef GAPA
  #undef GAPB
  #undef EX
  #undef VRD
  #undef KRD
  #undef STEP
  #undef ENDW
  {auto rr=__builtin_amdgcn_permlane32_swap(__float_as_uint(l_reg),__float_as_uint(l_reg),false,false);l_reg=__uint_as_float(rr[0])+__uint_as_float(rr[1]);}
  if(hi==0)wsf[32+r32]=l_reg;asm volatile("s_waitcnt lgkmcnt(0)":::"memory");
  float rli[16];
  #pragma unroll
  for(int r=0;r<16;++r)rli[r]=__builtin_amdgcn_rcpf(wsf[32+crow(r,hi)]);
  bf16*Ow=O+(rowbase+q0+wid*QBLK)*DM+h*D;
  { bf16*stg=(bf16*)(shm+LDS_OST)+wid*2048;
    #pragma unroll
    for(int r=0;r<16;++r){const int orow=crow(r,hi);
      #pragma unroll
      for(int d0=0;d0<2;++d0)stg[orow*64+d0*32+r32]=__float2bfloat16(o[d0][r]*rli[r]);}
    asm volatile("s_waitcnt lgkmcnt(0)":::"memory");
    #pragma unroll
    for(int i=0;i<4;++i){const int row=i*8+(lane>>3),ch=lane&7; const u32x4 v=*(const u32x4*)(stg+row*64+ch*8); ATTN_STORE16(Ow+(long)row*DM+ch*8,v);} }
  asm volatile("s_waitcnt lgkmcnt(0)\n\ts_barrier":::"memory");
  #undef DMA_K
  #undef MLOAD
  #undef MPIN
  #undef DMA_V
  #undef CMASK
  #undef START
  #undef RESC
  #undef ROT
}
constexpr int ATTN_LDS_BYTES=LDS_BYTES;
#undef SBAR
#undef WAIT_BAR
}
namespace mk {
using pg8::bf16_t; using pg8::f32x4; using pg8::u32x4; using pg8::bf16x8; using pg8::Unit; using pg8::Gemm;
constexpr int T = 65536, SEQ = 4096, NBATCH = 16, DM = 1024;
constexpr int NTHREADS = 512, NWAVES = 8;
constexpr size_t MiB = 1u << 20;
constexpr size_t WS_CTL = 0;
constexpr size_t WS_EID = 1 * MiB, WS_GATE = 2 * MiB, WS_SLOT = 3 * MiB;
constexpr size_t WS_WTIN = 4 * MiB;
constexpr size_t WS_WTA = 16 * MiB, WS_WTB = 17 * MiB, WS_WTOUT = 18 * MiB, WS_WTLORA = 20 * MiB;
constexpr size_t WS_WTGU = 21 * MiB;
constexpr size_t WS_WTDN = 85 * MiB;
constexpr size_t WS_KN = 117 * MiB;
constexpr size_t WS_MISC = 125 * MiB;
constexpr size_t WS_AP = 145 * MiB;
constexpr size_t WS_MASK = 177 * MiB;
constexpr size_t WS_YB = 209 * MiB;
constexpr size_t WS_RW = 273 * MiB;
constexpr size_t WS_Q = 497 * MiB, WS_K = 561 * MiB, WS_V = 625 * MiB, WS_QI = 689 * MiB;
constexpr size_t WS_SGA = 753 * MiB, WS_SGB = 881 * MiB;
constexpr size_t WS_END = 1009 * MiB;
constexpr size_t WS_H1B = WS_RW;
constexpr size_t WS_TOKMAP = WS_Q;
constexpr size_t WS_MA = WS_Q;
constexpr size_t WS_XS = WS_Q;
constexpr size_t WS_ACT = 769 * MiB;
constexpr int NROWS_PAD = 131072 + 32 * 256;
static_assert(WS_XS + (size_t)NROWS_PAD * 2048 <= WS_ACT && WS_ACT + (size_t)NROWS_PAD * 1024 <= WS_END, "overlay map");
constexpr size_t DO_XBF = 0;
constexpr size_t DO_OMW = 0, DO_ASIG = 64 * MiB, DO_G = 128 * MiB, DO_YA = 192 * MiB;
constexpr size_t DO_LNS = 128 * MiB;

constexpr int LDS_TOTAL = 155648;
constexpr int LDS_TAB = 131072;

struct Params { const float* in[30]; float* out; char* ws; };
typedef unsigned u32x2 __attribute__((ext_vector_type(2)));

__device__ __forceinline__ float xrow_sum(float x) {
    float a = x, b = x; asm volatile("s_nop 1\n\tv_permlane16_swap_b32 %0, %1" : "+v"(a), "+v"(b)); x = a + b;
    a = x; b = x; asm volatile("s_nop 1\n\tv_permlane32_swap_b32 %0, %1" : "+v"(a), "+v"(b)); return a + b;
}
__device__ __forceinline__ float wave_sum(float x) {
    x += __builtin_bit_cast(float, __builtin_amdgcn_mov_dpp(__builtin_bit_cast(int, x), 0xB1, 0xF, 0xF, true));
    x += __builtin_bit_cast(float, __builtin_amdgcn_mov_dpp(__builtin_bit_cast(int, x), 0x4E, 0xF, 0xF, true));
    x += __builtin_bit_cast(float, __builtin_amdgcn_mov_dpp(__builtin_bit_cast(int, x), 0x141, 0xF, 0xF, true));
    x += __builtin_bit_cast(float, __builtin_amdgcn_mov_dpp(__builtin_bit_cast(int, x), 0x140, 0xF, 0xF, true));
    return xrow_sum(x);
}
typedef float mkf2_t __attribute__((ext_vector_type(2))); typedef __bf16 mkb2_t __attribute__((ext_vector_type(2)));
__device__ __forceinline__ unsigned pk2(float lo, float hi) { const mkf2_t v = {lo, hi}; const mkb2_t b = __builtin_convertvector(v, mkb2_t); return __builtin_bit_cast(unsigned, b); }
__device__ __forceinline__ unsigned f2bf(float f) { return pk2(f, 0.f) & 0xffffu; }
__device__ __forceinline__ float bf2f(bf16_t v) { return __builtin_bit_cast(float, (unsigned)v << 16); }
__device__ __forceinline__ float bflo(unsigned w) { return __builtin_bit_cast(float, w << 16); }
__device__ __forceinline__ float bfhi(unsigned w) { return __builtin_bit_cast(float, w & 0xffff0000u); }
__device__ __forceinline__ float sigmoidf_(float x) { return __builtin_amdgcn_rcpf(1.f + __expf(-x)); }

template <class Src>
__device__ __forceinline__ void transpose_item(const Src& S, int K, bf16_t* dst, LAS float* scr, int k0, int n0, int lane) {
    float tv[32];
#pragma unroll
    for (int i = 0; i < 32; ++i) tv[i] = S(k0 + 2 * i + (lane >> 5), n0 + (lane & 31));
#pragma unroll
    for (int i = 0; i < 32; ++i) scr[(2 * i + (lane >> 5)) * 33 + (lane & 31)] = tv[i];
    asm volatile("s_waitcnt lgkmcnt(0)" ::: "memory");
    const int c = lane & 7;
#pragma unroll
    for (int j = 0; j < 4; ++j) { const int n = (lane >> 3) + 8 * j; const LAS float* s = scr + (8 * c) * 33 + n;
        u32x4 o; o.x = pk2(s[0 * 33], s[1 * 33]); o.y = pk2(s[2 * 33], s[3 * 33]); o.z = pk2(s[4 * 33], s[5 * 33]); o.w = pk2(s[6 * 33], s[7 * 33]);
        *(u32x4*)(dst + (size_t)(n0 + n) * K + k0 + 8 * c) = o; }
    asm volatile("s_waitcnt lgkmcnt(0)" ::: "memory");
}
struct SrcWin { const float* w; __device__ __forceinline__ float operator()(int k, int n) const {
    int c; if (n < 3840) c = n; else if (n < 5888) c = n + 72; else if (n < 5960) c = n - 5888 + 3840; else return 0.f;
    return w[(size_t)k * 5960 + c]; } };
struct SrcPlain { const float* w; int N; __device__ __forceinline__ float operator()(int k, int n) const { return w[(size_t)k * N + n]; } };
struct SrcGU { const float* g; long ud; __device__ __forceinline__ float operator()(int k, int n) const {
    const int pn = n >> 8, c = n & 255, bj = c >> 7;
    const int hj = 128 * pn + (c & 127); return g[(long)k * 512 + hj + (bj ? ud : 0l)]; } };

__device__ __forceinline__ void phase_prologue(const Params& p, LAS unsigned char* lds) {
    const int tid = mk_tid(), lane = tid & 63, wave = tid >> 6;
    const int gw = blockIdx.x * NWAVES + wave, NGW = gridDim.x * NWAVES;
    LAS float* scr = (LAS float*)(lds + wave * 16384);
    char* ws = p.ws;
    if (blockIdx.x == 0 && tid < 64) ((unsigned*)(ws + WS_CTL))[tid] = 0u;
    constexpr int I_IN = 16 * 192, I_A = 8 * 32, I_B = 8 * 32, I_O = 16 * 32, I_GU = 32 * 16 * 32, I_DN = 32 * 8 * 32;
    constexpr int NITEMS = I_IN + I_A + I_B + I_O + I_GU + I_DN;
    for (int it = gw; it < NITEMS; it += NGW) {
        int r = it;
        if (r < I_IN) { SrcWin S{p.in[1]}; transpose_item(S, 1024, (bf16_t*)(ws + WS_WTIN), scr, (r / 192) * 64, (r % 192) * 32, lane); continue; } r -= I_IN;
        if (r < I_A) { SrcPlain S{p.in[13], 1024}; transpose_item(S, 512, (bf16_t*)(ws + WS_WTA), scr, (r / 32) * 64, (r % 32) * 32, lane); continue; } r -= I_A;
        if (r < I_B) { SrcPlain S{p.in[17], 1024}; transpose_item(S, 512, (bf16_t*)(ws + WS_WTB), scr, (r / 32) * 64, (r % 32) * 32, lane); continue; } r -= I_B;
        if (r < I_O) { SrcPlain S{p.in[18], 1024}; transpose_item(S, 1024, (bf16_t*)(ws + WS_WTOUT), scr, (r / 32) * 64, (r % 32) * 32, lane); continue; } r -= I_O;
        if (r < I_GU) { const int e = r / 512, q = r % 512; SrcGU S{p.in[25] + (size_t)e * 1024 * 512, (long)(p.in[26] - p.in[25])};
            transpose_item(S, 1024, (bf16_t*)(ws + WS_WTGU) + (size_t)e * 1024 * 1024, scr, (q / 32) * 64, (q % 32) * 32, lane); continue; } r -= I_GU;
        { const int e = r / 256, q = r % 256; SrcPlain S{p.in[27] + (size_t)e * 512 * 1024, 1024};
            transpose_item(S, 512, (bf16_t*)(ws + WS_WTDN) + (size_t)e * 1024 * 512, scr, (q / 32) * 64, (q % 32) * 32, lane); }
    }
    if (blockIdx.x == 1) for (int i = tid; i < 4096; i += NTHREADS) ((float*)(ws + WS_CTL + 131072))[(i & 3) * 1024 + (i >> 2)] = p.in[21][i];
    { bf16_t* wl = (bf16_t*)(ws + WS_WTLORA); const int gt = blockIdx.x * NTHREADS + tid, NGT = gridDim.x * NTHREADS;
      for (int i = gt; i < 1536 * 256; i += NGT) { const int n = i >> 8, k = i & 255; float v = 0.f;
          if (n < 512) { if (k < 64) v = p.in[4][k * 512 + n]; }
          else if (n < 1024) { if (k >= 64 && k < 128) v = p.in[6][(k - 64) * 512 + (n - 512)]; }
          else { if (k >= 128) v = p.in[7][(k - 128) * 512 + (n - 1024)]; }
          wl[i] = (bf16_t)f2bf(v); } }
    { const f32x4* x4 = (const f32x4*)p.in[0]; unsigned long long* o8 = (unsigned long long*)((char*)p.out + DO_XBF);
      const size_t gt = (size_t)blockIdx.x * NTHREADS + tid, NGT = (size_t)gridDim.x * NTHREADS;
      for (size_t i = gt; i < (size_t)T * DM / 4; i += 4 * NGT) { f32x4 v[4];
#pragma unroll
          for (int q = 0; q < 4; ++q) v[q] = (i + q * NGT < (size_t)T * DM / 4) ? x4[i + q * NGT] : (f32x4){0.f, 0.f, 0.f, 0.f};
#pragma unroll
          for (int q = 0; q < 4; ++q) if (i + q * NGT < (size_t)T * DM / 4) o8[i + q * NGT] = (unsigned long long)pk2(v[q].x, v[q].y) | ((unsigned long long)pk2(v[q].z, v[q].w) << 32); } }
}

struct EpiIn {
    static constexpr bool PERM = true, AFTER_DRAIN = false;
    char* ws;
    __device__ __forceinline__ void operator()(const f32x4 (&acc)[2][2][4][2], const Unit& u, int wr, int wc, int fr, int fq) const {
        asm volatile("" : "+v"(fr), "+v"(fq));
        const int pn = u.pn, row0 = u.pm * 256 + wr * 64 + fr, cl = wc * 32 + 8 * fq;
        if (pn == 23) {
            if (cl < 72) { float* dst = (float*)(ws + WS_MISC);
#pragma unroll
                for (int ai = 0; ai < 2; ++ai)
#pragma unroll
                    for (int m = 0; m < 4; ++m) { float* d = dst + (size_t)(row0 + ai * 128 + m * 16) * 80 + cl; *(f32x4*)d = acc[ai][0][m][0]; *(f32x4*)(d + 4) = acc[ai][0][m][1]; } }
            return;
        }
        bf16_t* base; int ld, colt, mode = 0;
        if (pn < 7) { base = (bf16_t*)(ws + WS_RW); ld = 1792; colt = pn * 256; }
        else if (pn < 9) { base = (bf16_t*)(ws + WS_Q); ld = 512; colt = (pn - 7) * 256; mode = 2; }
        else if (pn < 11) { base = (bf16_t*)(ws + WS_K); ld = 512; colt = (pn - 9) * 256; }
        else if (pn < 13) { base = (bf16_t*)(ws + WS_V); ld = 512; colt = (pn - 11) * 256; }
        else if (pn < 15) { base = (bf16_t*)(ws + WS_QI); ld = 512; colt = (pn - 13) * 256; }
        else if (pn < 19) { base = (bf16_t*)(ws + WS_SGA); ld = 1024; colt = (pn - 15) * 256; mode = 1; }
        else { base = (bf16_t*)(ws + WS_SGB); ld = 1024; colt = (pn - 19) * 256; mode = 1; }
#pragma unroll
        for (int ai = 0; ai < 2; ++ai)
#pragma unroll
            for (int m = 0; m < 4; ++m) { bf16_t* rowp = base + (size_t)(row0 + ai * 128 + m * 16) * ld + colt + cl;
#pragma unroll
                for (int bj = 0; bj < 2; ++bj) { f32x4 v0 = acc[ai][bj][m][0], v1 = acc[ai][bj][m][1];
                    if (mode == 1) {
#pragma unroll
                        for (int i = 0; i < 4; ++i) { v0[i] = sigmoidf_(v0[i]); v1[i] = sigmoidf_(v1[i]); } }
                    else if (mode == 2) { v0 = v0 * attn_body::C2; v1 = v1 * attn_body::C2; }
                    u32x4 w; w.x = pk2(v0[0], v0[1]); w.y = pk2(v0[2], v0[3]); w.z = pk2(v1[0], v1[1]); w.w = pk2(v1[2], v1[3]);
                    *(u32x4*)(rowp + bj * 128) = w; } }
    }
};
struct EpiLora {
    static constexpr bool PERM = true, AFTER_DRAIN = false;
    char* dout;
    __device__ __forceinline__ void operator()(const f32x4 (&acc)[2][2][4][2], const Unit& u, int wr, int wc, int fr, int fq) const {
        asm volatile("" : "+v"(fr), "+v"(fq));
        const int pn = u.pn, seg = pn >> 1, row0 = u.pm * 256 + wr * 64 + fr, col0 = (pn & 1) * 256 + wc * 32 + 8 * fq;
        bf16_t* base = (bf16_t*)(dout + (size_t)seg * (64 * MiB));
#pragma unroll
        for (int ai = 0; ai < 2; ++ai)
#pragma unroll
            for (int m = 0; m < 4; ++m)
#pragma unroll
                for (int bj = 0; bj < 2; ++bj) { const f32x4 v0 = acc[ai][bj][m][0], v1 = acc[ai][bj][m][1]; u32x4 w;
                    w.x = pk2(v0[0], v0[1]); w.y = pk2(v0[2], v0[3]); w.z = pk2(v1[0], v1[1]); w.w = pk2(v1[2], v1[3]);
                    *(u32x4*)(base + (size_t)(row0 + ai * 128 + m * 16) * 512 + col0 + bj * 128) = w; }
    }
};
struct EpiGateMul {
    static constexpr bool PERM = true, AFTER_DRAIN = false;
    const bf16_t* gate; bf16_t* dst; const bf16_t* addsrc;
    __device__ __forceinline__ void operator()(const f32x4 (&acc)[2][2][4][2], const Unit& u, int wr, int wc, int fr, int fq) const {
        asm volatile("" : "+v"(fr), "+v"(fq));
        const int row0 = u.pm * 256 + wr * 64 + fr, col0 = u.pn * 256 + wc * 32 + 8 * fq;
#pragma unroll
        for (int ai = 0; ai < 2; ++ai)
#pragma unroll
            for (int m = 0; m < 4; ++m)
#pragma unroll
                for (int bj = 0; bj < 2; ++bj) { const size_t off = (size_t)(row0 + ai * 128 + m * 16) * 1024 + col0 + bj * 128;
                    const u32x4 g = *(const u32x4*)(gate + off); u32x4 d = {0u, 0u, 0u, 0u}; if (addsrc) d = *(const u32x4*)(addsrc + off);
                    const f32x4 v0 = acc[ai][bj][m][0], v1 = acc[ai][bj][m][1]; u32x4 w;
                    w.x = pk2(bflo(d.x) + bflo(g.x) * v0[0], bfhi(d.x) + bfhi(g.x) * v0[1]); w.y = pk2(bflo(d.y) + bflo(g.y) * v0[2], bfhi(d.y) + bfhi(g.y) * v0[3]);
                    w.z = pk2(bflo(d.z) + bflo(g.z) * v1[0], bfhi(d.z) + bfhi(g.z) * v1[1]); w.w = pk2(bflo(d.w) + bflo(g.w) * v1[2], bfhi(d.w) + bfhi(g.w) * v1[3]);
                    *(u32x4*)(dst + off) = w; }
    }
};
struct EpiResid {
    static constexpr bool PERM = true, AFTER_DRAIN = false;
    const float* x; bf16_t* out;
    static constexpr float alpha = 1.189207115002721f;
    __device__ __forceinline__ void operator()(const f32x4 (&acc)[2][2][4][2], const Unit& u, int wr, int wc, int fr, int fq) const {
        asm volatile("" : "+v"(fr), "+v"(fq));
        const int row0 = u.pm * 256 + wr * 64 + fr, col0 = u.pn * 256 + wc * 32 + 8 * fq;
#pragma unroll
        for (int ai = 0; ai < 2; ++ai)
#pragma unroll
            for (int m = 0; m < 4; ++m) { float ps = 0.f, pq = 0.f;
#pragma unroll
                for (int bj = 0; bj < 2; ++bj) { const size_t off = (size_t)(row0 + ai * 128 + m * 16) * 1024 + col0 + bj * 128;
                    const f32x4 x0 = *(const f32x4*)(x + off), x1 = *(const f32x4*)(x + off + 4);
                    const f32x4 v0 = x0 * alpha + acc[ai][bj][m][0], v1 = x1 * alpha + acc[ai][bj][m][1]; u32x4 w; w.x = pk2(v0[0], v0[1]); w.y = pk2(v0[2], v0[3]); w.z = pk2(v1[0], v1[1]); w.w = pk2(v1[2], v1[3]);
                    *(u32x4*)(out + off) = w;
                    ps += ((v0[0] + v0[1]) + (v0[2] + v0[3])) + ((v1[0] + v1[1]) + (v1[2] + v1[3]));
                    pq += ((v0[0] * v0[0] + v0[1] * v0[1]) + (v0[2] * v0[2] + v0[3] * v0[3])) + ((v1[0] * v1[0] + v1[1] * v1[1]) + (v1[2] * v1[2] + v1[3] * v1[3])); }
                ps = xrow_sum(ps); pq = xrow_sum(pq);
                if (fq == 0) *(float2*)((char*)out + DO_LNS + ((unsigned)(row0 + ai * 128 + m * 16) * 128u + (unsigned)(u.pn * 4 + wc) * 8u)) = make_float2(ps, pq); }
    }
};
struct EpiSwiglu {
    static constexpr bool PERM = true, AFTER_DRAIN = false;
    bf16_t* act;
    __device__ __forceinline__ void operator()(const f32x4 (&acc)[2][2][4][2], const Unit& u, int wr, int wc, int fr, int fq) const {
        asm volatile("" : "+v"(fr), "+v"(fq));
        const int row0 = u.pm * 256 + wr * 64 + fr, col0 = (u.pn & 3) * 128 + 32 * wc + 8 * fq;
#pragma unroll
        for (int ai = 0; ai < 2; ++ai)
#pragma unroll
            for (int m = 0; m < 4; ++m) { float a[8];
#pragma unroll
                for (int n = 0; n < 2; ++n)
#pragma unroll
                    for (int i = 0; i < 4; ++i) { const float g = acc[ai][0][m][n][i]; a[4 * n + i] = g * sigmoidf_(g) * acc[ai][1][m][n][i]; }
                u32x4 w; w.x = pk2(a[0], a[1]); w.y = pk2(a[2], a[3]); w.z = pk2(a[4], a[5]); w.w = pk2(a[6], a[7]);
                *(u32x4*)(act + (size_t)(row0 + ai * 128 + m * 16) * 512 + col0) = w; }
    }
};
struct EpiDown {
    static constexpr bool PERM = true, AFTER_DRAIN = false;
    bf16_t* ys;
    __device__ __forceinline__ void operator()(const f32x4 (&acc)[2][2][4][2], const Unit& u, int wr, int wc, int fr, int fq) const {
        asm volatile("" : "+v"(fr), "+v"(fq));
        const int row0 = u.pm * 256 + wr * 64 + fr, col0 = (u.pn & 3) * 256 + wc * 32 + 8 * fq;
#pragma unroll
        for (int ai = 0; ai < 2; ++ai)
#pragma unroll
            for (int m = 0; m < 4; ++m)
#pragma unroll
                for (int bj = 0; bj < 2; ++bj) { const f32x4 v0 = acc[ai][bj][m][0], v1 = acc[ai][bj][m][1]; u32x4 w;
                    w.x = pk2(v0[0], v0[1]); w.y = pk2(v0[2], v0[3]); w.z = pk2(v1[0], v1[1]); w.w = pk2(v1[2], v1[3]);
                    *(u32x4*)(ys + (size_t)(row0 + ai * 128 + m * 16) * 1024 + col0 + bj * 128) = w; }
    }
};
struct MoeOrder {
    const LAS int* tab;
    int G, c; const int* tokmap;
    __device__ __forceinline__ int srcrow(const Unit& u, int r) const {
        const int e = u.pn >> 2, slot = u.pm * 256 - tab[1024 + e] + r; return slot < tab[1100 + e] ? tokmap[e * 65536 + slot] : 0; }
    __device__ __forceinline__ bool next(int i, Unit& u) const {
        const int vc = (G & 7) ? c : (c & 7) * (G >> 3) + (c >> 3);
        const int L = i * G + vc; const int nt = tab[0]; if (L >= nt * 4) return false;
        const int ti = L >> 2; u.pm = ti; u.pn = tab[1 + ti] * 4 + (L & 3); return true; }
    __device__ __forceinline__ void a_ready(const Unit&) const {}
    __device__ __forceinline__ void done(const Unit&) const {}
};
__device__ __forceinline__ void moe_tables(const Params& p, LAS int* tab) {
    const int tid = mk_tid(); const unsigned* cnt = (const unsigned*)(p.ws + WS_CTL);
    __syncthreads();
    if (tid == 0) { int ts = 0; for (int e = 0; e < 32; ++e) { const int c = (int)cnt[e]; tab[1024 + e] = ts * 256; tab[1100 + e] = c; const int nt = (c + 255) >> 8; for (int j = 0; j < nt; ++j) tab[1 + ts + j] = e; ts += nt; } tab[0] = ts; tab[1024 + 32] = ts * 256; }
    __syncthreads();
}

__device__ __forceinline__ float dpp_sum8(float x) {
    x += __builtin_bit_cast(float, __builtin_amdgcn_mov_dpp(__builtin_bit_cast(int, x), 0xB1, 0xF, 0xF, true));
    x += __builtin_bit_cast(float, __builtin_amdgcn_mov_dpp(__builtin_bit_cast(int, x), 0x4E, 0xF, 0xF, true));
    x += __builtin_bit_cast(float, __builtin_amdgcn_mov_dpp(__builtin_bit_cast(int, x), 0x141, 0xF, 0xF, true));
    return x;
}
__device__ __forceinline__ float dpp_sum16(float x) {
    x += __builtin_bit_cast(float, __builtin_amdgcn_mov_dpp(__builtin_bit_cast(int, x), 0xB1, 0xF, 0xF, true));
    x += __builtin_bit_cast(float, __builtin_amdgcn_mov_dpp(__builtin_bit_cast(int, x), 0x4E, 0xF, 0xF, true));
    x += __builtin_bit_cast(float, __builtin_amdgcn_mov_dpp(__builtin_bit_cast(int, x), 0x141, 0xF, 0xF, true));
    x += __builtin_bit_cast(float, __builtin_amdgcn_mov_dpp(__builtin_bit_cast(int, x), 0x140, 0xF, 0xF, true));
    return x;
}
__device__ __forceinline__ void phase_prep(const Params& p) {
    const int tid = mk_tid(), lane = tid & 63, wave = tid >> 6;
    const int gw = blockIdx.x * NWAVES + wave, NGW = gridDim.x * NWAVES;
    const bf16_t* RW = (const bf16_t*)(p.ws + WS_RW); const float* MISC = (const float*)(p.ws + WS_MISC);
    bf16_t* AP = (bf16_t*)(p.ws + WS_AP); bf16_t* KN = (bf16_t*)(p.ws + WS_KN);
    const int ac = 4 * lane;
    const int rc = ac < 64 ? 512 + ac : (ac < 128 ? 1600 + (ac - 64) : 1664 + (ac - 128));
    const f32x4 mu = *(const f32x4*)(p.in[2] + rc);
    const int kl = lane & 15;
    const f32x4 lg = *(const f32x4*)(p.in[14] + 4 * kl), lb = *(const f32x4*)(p.in[15] + 4 * kl);
#define UNPK4(u_) (f32x4){bflo((u_).x), bfhi((u_).x), bflo((u_).y), bfhi((u_).y)}
    for (int tok0 = gw * 4; tok0 < T; tok0 += NGW * 4) {
        u32x2 cu[4], pv[4]; f32x4 kx[4];
#pragma unroll
        for (int q = 0; q < 4; ++q) { const int tok = tok0 + q; const bf16_t* cur = RW + (size_t)tok * 1792 + rc; const bool hp = (tok & (SEQ - 1)) != 0;
            cu[q] = *(const u32x2*)cur; pv[q] = hp ? *(const u32x2*)(cur - 1792) : (u32x2){0u, 0u};
            kx[q] = *(const f32x4*)(MISC + (size_t)tok * 80 + 4 * kl); }
#pragma unroll
        for (int q = 0; q < 4; ++q) { const int tok = tok0 + q;
            const f32x4 c = UNPK4(cu[q]), pr = UNPK4(pv[q]); const f32x4 x = c + (pr - c) * mu; f32x4 o;
#pragma unroll
            for (int i = 0; i < 4; ++i) o[i] = ac < 64 ? 1.f - 2.f * __builtin_amdgcn_rcpf(1.f + __expf(2.f * x[i])) : (ac < 128 ? x[i] : sigmoidf_(x[i]));
            *(u32x2*)(AP + (size_t)tok * 256 + ac) = (u32x2){pk2(o[0], o[1]), pk2(o[2], o[3])};
            const float mean = dpp_sum16((kx[q].x + kx[q].y) + (kx[q].z + kx[q].w)) * (1.f / 64.f); const f32x4 d = kx[q] - mean;
            const float var = dpp_sum16((d.x * d.x + d.y * d.y) + (d.z * d.z + d.w * d.w)) * (1.f / 64.f);
            const f32x4 kn = d * __builtin_amdgcn_rsqf(var + 1e-5f) * lg + lb;
            if (lane < 16) *(u32x2*)(KN + (size_t)tok * 64 + 4 * kl) = (u32x2){pk2(kn[0], kn[1]), pk2(kn[2], kn[3])}; }
    }
#undef UNPK4
}

typedef _Float16 h8 __attribute__((ext_vector_type(8)));
struct IxTeam { int tw, ttid, lane; LAS unsigned char* lds; LAS unsigned* bar; unsigned gen; };
__device__ __forceinline__ void team_sync(IxTeam& tm) {
    asm volatile("s_waitcnt lgkmcnt(0)" ::: "memory");
    if (tm.lane == 0) {
        const unsigned old = __hip_atomic_fetch_add(&tm.bar[0], 1u, __ATOMIC_RELAXED, __HIP_MEMORY_SCOPE_WORKGROUP);
        if (old == 3u) { __hip_atomic_store(&tm.bar[0], 0u, __ATOMIC_RELAXED, __HIP_MEMORY_SCOPE_WORKGROUP); __hip_atomic_fetch_add(&tm.bar[1], 1u, __ATOMIC_RELAXED, __HIP_MEMORY_SCOPE_WORKGROUP); }
        else { while (__hip_atomic_load(&tm.bar[1], __ATOMIC_RELAXED, __HIP_MEMORY_SCOPE_WORKGROUP) == tm.gen) __builtin_amdgcn_s_sleep(1); }
    }
    tm.gen += 1u;
    asm volatile("s_waitcnt lgkmcnt(0)" ::: "memory");
}
constexpr int SC = 32;
typedef float f2 __attribute__((ext_vector_type(2)));
struct ScanRaw { u32x2 r, k, v, rp, kp, vp, w, a, g; };
struct ScanKeep { f32x4 v, g; float bonus; };
constexpr int SCL_VEC = 0, SCL_VBUF = SCL_VEC + 2 * SC * 1024, SCL_YBUF = SCL_VBUF + 2 * SC * 256, SCL_DUMMY = SCL_YBUF + 2 * SC * 256, SCL_TOT = SCL_DUMMY + 8704, SCL_PEND = SCL_TOT + 2048, SCL_HBAR = SCL_PEND + 512, SCL_END = SCL_HBAR + 16;
__device__ __forceinline__ void scan_item(const Params& p, LAS unsigned char* lds, int bh) {
    const int b = bh >> 3, h = bh & 7;
    const int tid = mk_tid(), lane = tid & 63, wave = tid >> 6;
    const bf16_t* RW = (const bf16_t*)(p.ws + WS_RW);
    const bf16_t* OMW = (const bf16_t*)((char*)p.out + DO_OMW); const bf16_t* ASIG = (const bf16_t*)((char*)p.out + DO_ASIG); const bf16_t* GG = (const bf16_t*)((char*)p.out + DO_G);
    bf16_t* YA = (bf16_t*)((char*)p.out + DO_YA);
    const size_t row0 = (size_t)b * SEQ;
    constexpr int NCH = SEQ / SC;
    __syncthreads();
    if (tid < 4) ((LAS unsigned*)(lds + SCL_HBAR))[tid] = 0u;
    __syncthreads();
    if (wave >= 4) {
        const int hw_ = wave - 4, tokl = lane >> 4, cg = lane & 15, col = h * 64 + 4 * cg;
        const f32x4 mu_r = *(const f32x4*)(p.in[2] + col), mu_k = *(const f32x4*)(p.in[2] + 576 + col), mu_v = *(const f32x4*)(p.in[2] + 1088 + col);
        const f32x4 w0c = *(const f32x4*)(p.in[3] + col), a0c = *(const f32x4*)(p.in[5] + col), kkc = *(const f32x4*)(p.in[8] + col), kac = *(const f32x4*)(p.in[9] + col);
        const f32x4 rkc = *(const f32x4*)(p.in[10] + col), lxg = *(const f32x4*)(p.in[11] + col), lxb = *(const f32x4*)(p.in[12] + col);
        ScanRaw R[2]; ScanKeep K0[2], K1[2];
        struct { f32x4 dec, na, kb, k2, r, v; } PV[2];
        IxTeam htm; htm.tw = hw_; htm.ttid = tid & 255; htm.lane = lane; htm.lds = lds; htm.bar = (LAS unsigned*)(lds + SCL_HBAR); htm.gen = 0u;
#define SCAN_LOAD(c_, q_) do { const int t_ = (c_) * SC + hw_ * 8 + (q_) * 4 + tokl; const size_t rw_ = row0 + t_; const bf16_t* cur_ = RW + rw_ * 1792 + col; const bf16_t* prv_ = cur_ - 1792; \
        R[q_].r = *(const u32x2*)cur_; R[q_].k = *(const u32x2*)(cur_ + 576); R[q_].v = *(const u32x2*)(cur_ + 1088); \
        if (t_ > 0) { R[q_].rp = *(const u32x2*)prv_; R[q_].kp = *(const u32x2*)(prv_ + 576); R[q_].vp = *(const u32x2*)(prv_ + 1088); } else { R[q_].rp = (u32x2){0u, 0u}; R[q_].kp = R[q_].rp; R[q_].vp = R[q_].rp; } \
        R[q_].w = *(const u32x2*)(OMW + rw_ * 512 + col); R[q_].a = *(const u32x2*)(ASIG + rw_ * 512 + col); R[q_].g = *(const u32x2*)(GG + rw_ * 512 + col); } while (0)
#define UNPK(u_) (f32x4){bflo((u_).x), bfhi((u_).x), bflo((u_).y), bfhi((u_).y)}
#define SCAN_PREP1(q_) do { \
        f32x4 r = UNPK(R[q_].r), k = UNPK(R[q_].k), v = UNPK(R[q_].v); const f32x4 rp = UNPK(R[q_].rp), kp = UNPK(R[q_].kp), vp = UNPK(R[q_].vp); \
        r += (rp - r) * mu_r; k += (kp - k) * mu_k; v += (vp - v) * mu_v; \
        const f32x4 wr = UNPK(R[q_].w) + w0c, ar = UNPK(R[q_].a) + a0c; f32x4 a, omw; \
        _Pragma("unroll") for (int i = 0; i < 4; ++i) { a[i] = sigmoidf_(ar[i]); \
            const float z = -wr[i]; const float sp = z > 20.f ? z : __logf(1.f + __expf(z)); const float e = __expf(-sp - 0.5f); \
            omw[i] = e < 0.1f ? e * (1.f - e * (0.5f - e * ((1.f / 6.f) - e * ((1.f / 24.f) - e * (1.f / 120.f))))) : 1.f - __expf(-e); } \
        const f32x4 kkr = k * kkc; const float n2 = dpp_sum16((kkr.x * kkr.x + kkr.y * kkr.y) + (kkr.z * kkr.z + kkr.w * kkr.w)); \
        const f32x4 kk = kkr * __builtin_amdgcn_rsqf(fmaxf(n2, 1e-24f)); const f32x4 k2 = k * ((a - 1.f) * kac + 1.f); \
        const f32x4 rb = r * k2 * rkc; K0[q_].bonus = dpp_sum16((rb.x + rb.y) + (rb.z + rb.w)); K0[q_].v = v; K0[q_].g = UNPK(R[q_].g); \
        PV[q_].dec = 1.f - omw; PV[q_].na = -kk; PV[q_].kb = kk * a; PV[q_].k2 = k2; PV[q_].r = r; PV[q_].v = v; } while (0)
#define ROWPFX(x_) do { _Pragma("unroll") for (int i = 0; i < 4; ++i) { float t_ = __shfl_up(x_[i], 16); if (tokl >= 1) x_[i] *= t_; t_ = __shfl_up(x_[i], 32); if (tokl >= 2) x_[i] *= t_; } } while (0)
#define ROW3(x_) (f32x4){__shfl(x_[0], 48 + cg), __shfl(x_[1], 48 + cg), __shfl(x_[2], 48 + cg), __shfl(x_[3], 48 + cg)}
#define SCAN_PREP(c_) do { const int bf_ = (c_) & 1; \
        SCAN_PREP1(0); SCAN_PREP1(1); \
        f32x4 pin0 = PV[0].dec, pin1 = PV[1].dec; ROWPFX(pin0); ROWPFX(pin1); \
        { const f32x4 t0_ = ROW3(pin0); pin1 = pin1 * t0_; } \
        LAS f32x4* tot_ = (LAS f32x4*)(lds + SCL_TOT) + bf_ * 64; \
        if (tokl == 3) tot_[hw_ * 16 + cg] = pin1;                                     \
        team_sync(htm); \
        f32x4 pre_ = {1.f, 1.f, 1.f, 1.f}; \
        _Pragma("unroll") for (int w_ = 0; w_ < 3; ++w_) if (w_ < hw_) pre_ = pre_ * tot_[w_ * 16 + cg]; \
        _Pragma("unroll") for (int q_ = 0; q_ < 2; ++q_) { const int tk_ = hw_ * 8 + q_ * 4 + tokl; \
            const f32x4 pinc = (q_ ? pin1 : pin0) * pre_; f32x4 rin, rdec; \
            _Pragma("unroll") for (int i = 0; i < 4; ++i) { rin[i] = __builtin_amdgcn_rcpf(pinc[i]); rdec[i] = __builtin_amdgcn_rcpf(PV[q_].dec[i]); } \
            LAS float* vp_ = (LAS float*)(lds + SCL_VEC) + (bf_ * SC + tk_) * 256 + 4 * cg; \
            *(LAS f32x4*)(vp_) = PV[q_].na * (pinc * rdec); *(LAS f32x4*)(vp_ + 64) = PV[q_].kb * rin; *(LAS f32x4*)(vp_ + 128) = PV[q_].k2 * rin; *(LAS f32x4*)(vp_ + 192) = PV[q_].r * pinc; \
            *(LAS f32x4*)((LAS float*)(lds + SCL_VBUF) + (bf_ * SC + tk_) * 64 + 4 * cg) = PV[q_].v; \
            if (q_ == 1 && hw_ == 3 && tokl == 3) ((LAS f32x4*)(lds + SCL_PEND))[bf_ * 16 + cg] = pinc; } } while (0)
#define SCAN_POST(c_, q_) do { const int tk_ = hw_ * 8 + (q_) * 4 + tokl; const int bf_ = (c_) & 1; \
        const f32x4 y = *(const LAS f32x4*)((LAS float*)(lds + SCL_YBUF) + (bf_ * SC + tk_) * 64 + 4 * cg); \
        const float mean = dpp_sum16((y.x + y.y) + (y.z + y.w)) * (1.f / 64.f); const f32x4 d = y - mean; \
        const float var = dpp_sum16((d.x * d.x + d.y * d.y) + (d.z * d.z + d.w * d.w)) * (1.f / 64.f); const float rs = __builtin_amdgcn_rsqf(var + 64e-5f); \
        const f32x4 o = (d * rs * lxg + lxb + K1[q_].v * K1[q_].bonus) * K1[q_].g; \
        *(u32x2*)(YA + (row0 + (size_t)(c_) * SC + tk_) * 512 + col) = (u32x2){pk2(o.x, o.y), pk2(o.z, o.w)}; } while (0)
        SCAN_LOAD(0, 0); SCAN_LOAD(0, 1);
        SCAN_PREP(0);
        SCAN_LOAD(1, 0); SCAN_LOAD(1, 1);
        K1[0] = K0[0]; K1[1] = K0[1];
        __syncthreads();
        for (int c = 0; c <= NCH; ++c) {
            if (c >= 1) { SCAN_POST(c - 1, 0); SCAN_POST(c - 1, 1); }
            K1[0] = K0[0]; K1[1] = K0[1];
            if (c + 1 < NCH) { SCAN_PREP(c + 1); }
            if (c + 2 < NCH) { SCAN_LOAD(c + 2, 0); SCAN_LOAD(c + 2, 1); }
            if (c < NCH) __syncthreads();
        }
#undef SCAN_LOAD
#undef UNPK
#undef SCAN_PREP
#undef SCAN_PREP1
#undef ROWPFX
#undef ROW3
#undef SCAN_POST
    } else {
        const int rp = lane >> 3, jg = lane & 7, i0 = wave * 16 + rp * 2;
        const int yoff = (jg == 0) ? i0 : (SCL_DUMMY - SCL_YBUF) / 4 + 2 * lane;
        f2 s0[4], s1[4];
#pragma unroll
        for (int j = 0; j < 4; ++j) { s0[j] = (f2){0.f, 0.f}; s1[j] = s0[j]; }
        __syncthreads();
        for (int c = 0; c < NCH; ++c) {
            const int bf = c & 1;
            const LAS float* vecb = (const LAS float*)(lds + SCL_VEC) + bf * SC * 256; const LAS float* vbb = (const LAS float*)(lds + SCL_VBUF) + bf * SC * 64 + i0;
            LAS float* ybb = (LAS float*)(lds + SCL_YBUF) + ((jg == 0) ? bf * SC * 64 : 0) + yoff;
#if defined(MK_REP) && MK_REP == 302
            f2 k0_[4], k1_[4];
#pragma unroll
            for (int j = 0; j < 4; ++j) { k0_[j] = s0[j]; k1_[j] = s1[j]; }
            for (int rep_ = 0; rep_ < 2; ++rep_) {
#pragma unroll
            for (int j = 0; j < 4; ++j) { s0[j] = k0_[j]; s1[j] = k1_[j]; asm volatile("" : "+v"(s0[j]), "+v"(s1[j]) :: "memory"); }
#endif
#define LDV(t_, A, B, K, Rr, V) do { const LAS f32x4* q_ = (const LAS f32x4*)(vecb + (t_) * 256) + 2 * jg; A##0 = q_[0]; A##1 = q_[1]; B##0 = q_[16]; B##1 = q_[17]; \
        K##0 = q_[32]; K##1 = q_[33]; Rr##0 = q_[48]; Rr##1 = q_[49]; V = *(const LAS f2*)(vbb + (t_) * 64); } while (0)
#define LO2(v_) __builtin_shufflevector(v_, v_, 0, 1)
#define HI2(v_) __builtin_shufflevector(v_, v_, 2, 3)
#define FMA2(a_, b_, c_) __builtin_elementwise_fma(a_, b_, c_)
            f32x4 va0, va1, vb0, vb1, vk0, vk1, vr0, vr1; f2 vv;
            LDV(0, va, vb, vk, vr, vv);
#pragma unroll 2
            for (int tk = 0; tk < SC; ++tk) {
                f32x4 na0, na1, nb0, nb1, nk0, nk1, nr0, nr1; f2 nv;
                { const int tn = (tk + 1 < SC) ? tk + 1 : tk; LDV(tn, na, nb, nk, nr, nv); }
                f2 p0 = s0[0] * LO2(va0), p1 = s1[0] * LO2(va0);
                p0 = FMA2(s0[1], HI2(va0), p0); p1 = FMA2(s1[1], HI2(va0), p1); p0 = FMA2(s0[2], LO2(va1), p0); p1 = FMA2(s1[2], LO2(va1), p1); p0 = FMA2(s0[3], HI2(va1), p0); p1 = FMA2(s1[3], HI2(va1), p1);
                const float sa0 = dpp_sum8(p0.x + p0.y), sa1 = dpp_sum8(p1.x + p1.y);
                const f2 sa0v = {sa0, sa0}, sa1v = {sa1, sa1}, v0v = {vv.x, vv.x}, v1v = {vv.y, vv.y};
                s0[0] = FMA2(v0v, LO2(vk0), FMA2(sa0v, LO2(vb0), s0[0])); s1[0] = FMA2(v1v, LO2(vk0), FMA2(sa1v, LO2(vb0), s1[0]));
                s0[1] = FMA2(v0v, HI2(vk0), FMA2(sa0v, HI2(vb0), s0[1])); s1[1] = FMA2(v1v, HI2(vk0), FMA2(sa1v, HI2(vb0), s1[1]));
                s0[2] = FMA2(v0v, LO2(vk1), FMA2(sa0v, LO2(vb1), s0[2])); s1[2] = FMA2(v1v, LO2(vk1), FMA2(sa1v, LO2(vb1), s1[2]));
                s0[3] = FMA2(v0v, HI2(vk1), FMA2(sa0v, HI2(vb1), s0[3])); s1[3] = FMA2(v1v, HI2(vk1), FMA2(sa1v, HI2(vb1), s1[3]));
                f2 q0 = s0[0] * LO2(vr0), q1 = s1[0] * LO2(vr0);
                q0 = FMA2(s0[1], HI2(vr0), q0); q1 = FMA2(s1[1], HI2(vr0), q1); q0 = FMA2(s0[2], LO2(vr1), q0); q1 = FMA2(s1[2], LO2(vr1), q1); q0 = FMA2(s0[3], HI2(vr1), q0); q1 = FMA2(s1[3], HI2(vr1), q1);
                const float y0 = dpp_sum8(q0.x + q0.y), y1 = dpp_sum8(q1.x + q1.y);
                *(LAS f2*)(ybb + tk * 64) = (f2){y0, y1};
                va0 = na0; va1 = na1; vb0 = nb0; vb1 = nb1; vk0 = nk0; vk1 = nk1; vr0 = nr0; vr1 = nr1; vv = nv;
            }
            { const LAS f32x4* pe = (const LAS f32x4*)(lds + SCL_PEND) + bf * 16 + 2 * jg; const f32x4 e0 = pe[0], e1 = pe[1];
              s0[0] = s0[0] * LO2(e0); s0[1] = s0[1] * HI2(e0); s0[2] = s0[2] * LO2(e1); s0[3] = s0[3] * HI2(e1);
              s1[0] = s1[0] * LO2(e0); s1[1] = s1[1] * HI2(e0); s1[2] = s1[2] * LO2(e1); s1[3] = s1[3] * HI2(e1); }
#undef LDV
#undef LO2
#undef HI2
#undef FMA2
#if defined(MK_REP) && MK_REP == 302
            }
#endif
            __syncthreads();
        }
    }
}

constexpr int IX_TEAM_BYTES = 61440;
constexpr int IX_HIST = 0;
constexpr int IX_MASK = 32768, IX_MROW = 129;
constexpr int IX_CAP = 128, IX_CAND = IX_MASK + 8448;
constexpr int IX_MISC = IX_CAND + 16384;
constexpr int IX_CTL = 2 * IX_TEAM_BYTES;
static_assert(IX_MISC + 3072 <= IX_TEAM_BYTES && IX_CTL + 32 <= LDS_TOTAL - 64, "indexer LDS map");
struct IxSel { int B0; unsigned Klo, Khi; };
__device__ __forceinline__ unsigned ix_key(float x) { const unsigned h = (unsigned)__builtin_bit_cast(unsigned short, (_Float16)x); return (h & 0x8000u) ? (~h & 0xffffu) : (h | 0x8000u); }
__device__ __forceinline__ void ix_blockA(const bool DIAG, const bf16x8 a0, const bf16x8 a1, const bf16x8 (&qf)[9][2], const float (&hw)[8], int s0, int quad, int n, int tq,
                                          LAS unsigned* hist, unsigned short* KS) {
    f32x4 acc[9];
#pragma unroll
    for (int h = 0; h < 9; ++h) { acc[h] = (f32x4){0.f, 0.f, 0.f, 0.f}; acc[h] = __builtin_amdgcn_mfma_f32_16x16x32_bf16(a0, qf[h][0], acc[h], 0, 0, 0); }
#pragma unroll
    for (int h = 0; h < 9; ++h) acc[h] = __builtin_amdgcn_mfma_f32_16x16x32_bf16(a1, qf[h][1], acc[h], 0, 0, 0);
    __builtin_amdgcn_sched_barrier(0);
    f32x4 idx = acc[8];
#pragma unroll
    for (int h = 0; h < 8; ++h)
#pragma unroll
        for (int j = 0; j < 4; ++j) idx[j] = __builtin_fmaf(hw[h], __builtin_fabsf(acc[h][j]), idx[j]);
    const int sb = s0 + quad * 4; unsigned k[4];
#pragma unroll
    for (int j = 0; j < 4; ++j) { k[j] = ix_key(idx[j]); if (!DIAG || sb + j <= tq) __hip_atomic_fetch_add(&hist[n * 512 + (k[j] >> 7)], 1u, __ATOMIC_RELAXED, __HIP_MEMORY_SCOPE_WORKGROUP); }
    *(u32x2*)(KS + s0 * 16 + n * 16 + quad * 4) = (u32x2){k[0] | (k[1] << 16), k[2] | (k[3] << 16)};
}
template <int MODE>
__device__ __forceinline__ void ix_blockK(const bool DIAG, const u32x2 kw, int s0, int quad, int n, int tq, const IxSel& S, LAS unsigned* hist, LAS unsigned* mrow, LAS int* ccnt, LAS int* candk, LAS int* cands) {
    const int sb = s0 + quad * 4; const unsigned k[4] = {kw.x & 0xffffu, kw.x >> 16, kw.y & 0xffffu, kw.y >> 16};
    if (MODE == 1) {
#pragma unroll
        for (int j = 0; j < 4; ++j) if ((!DIAG || sb + j <= tq) && (int)(k[j] >> 7) == S.B0) __hip_atomic_fetch_add(&hist[n * 512 + (k[j] & 127u)], 1u, __ATOMIC_RELAXED, __HIP_MEMORY_SCOPE_WORKGROUP);
    } else {
        unsigned m = 0u, cm = 0u;
#pragma unroll
        for (int j = 0; j < 4; ++j) { const bool ok = !DIAG || sb + j <= tq; if (ok && k[j] > S.Khi) m |= 1u << j; if (ok && k[j] >= S.Klo && k[j] <= S.Khi) cm |= 1u << j; }
        {
            unsigned t = m << (4 * quad);
            { auto r = __builtin_amdgcn_permlane16_swap(t, t, false, false); t = r[0] | r[1]; }
            { auto r = __builtin_amdgcn_permlane32_swap(t, t, false, false); t = r[0] | r[1]; }
            if (quad == 0) ((LAS unsigned short*)mrow)[n * (IX_MROW * 2) + (s0 >> 4)] = (unsigned short)t; }
        if (cm) {
            int sl = __hip_atomic_fetch_add(&ccnt[n], (int)__builtin_popcount(cm), __ATOMIC_RELAXED, __HIP_MEMORY_SCOPE_WORKGROUP);
#pragma unroll
            for (int j = 0; j < 4; ++j) if ((cm >> j) & 1u) { if (sl < IX_CAP) { candk[n * IX_CAP + sl] = (int)k[j]; cands[n * IX_CAP + sl] = sb + j; } ++sl; } }
    }
}
constexpr int IX_NW = 4;
__device__ __forceinline__ void ix_passA(const bf16_t* KNb, const bf16x8 (&qf)[9][2], const float (&hw)[8], int qg, int tw, int quad, int n, int tq, LAS unsigned* hist, unsigned short* KS) {
    if (tw > qg) return;
    const int nb = (qg - tw) / IX_NW + 1;
    const bf16_t* kp0 = KNb + (size_t)(tw * 16 + n) * 64 + quad * 8;
    constexpr size_t KSTEP = (size_t)IX_NW * 16 * 64;
#define IX_LD(i_, x0_, x1_) do { const int ii_ = (i_) < nb ? (i_) : nb - 1; const bf16_t* q_ = kp0 + (size_t)ii_ * KSTEP; x0_ = *(const bf16x8*)q_; x1_ = *(const bf16x8*)(q_ + 32); } while (0)
#define IX_DO(i_, x0_, x1_) do { if ((i_) < nb) { const int kb_ = tw + IX_NW * (i_); const bf16x8 a0_ = x0_, a1_ = x1_; IX_LD((i_) + 4, x0_, x1_); \
        ix_blockA(kb_ == qg, a0_, a1_, qf, hw, kb_ * 16, quad, n, tq, hist, KS); } } while (0)
    bf16x8 r00, r01, r10, r11, r20, r21, r30, r31;
    IX_LD(0, r00, r01); IX_LD(1, r10, r11); IX_LD(2, r20, r21); IX_LD(3, r30, r31);
#pragma unroll 1
    for (int i = 0; i < nb; i += 4) { IX_DO(i, r00, r01); IX_DO(i + 1, r10, r11); IX_DO(i + 2, r20, r21); IX_DO(i + 3, r30, r31); }
#undef IX_LD
#undef IX_DO
}
template <int MODE>
__device__ __forceinline__ void ix_passK(const unsigned short* KS, int qg, int tw, int quad, int n, int tq, const IxSel& S, LAS unsigned* hist, LAS unsigned* mrow, LAS int* ccnt, LAS int* candk, LAS int* cands) {
    if (tw > qg) return;
    const int nb = (qg - tw) / IX_NW + 1;
    const unsigned short* kp0 = KS + tw * 256 + n * 16 + quad * 4;
#define IX_LD(i_, x_) do { const int ii_ = (i_) < nb ? (i_) : nb - 1; x_ = *(const u32x2*)(kp0 + ii_ * (IX_NW * 256)); } while (0)
#define IX_DO(i_, x_) do { if ((i_) < nb) { const int kb_ = tw + IX_NW * (i_); const u32x2 kw_ = x_; IX_LD((i_) + 4, x_); \
        ix_blockK<MODE>(kb_ == qg, kw_, kb_ * 16, quad, n, tq, S, hist, mrow, ccnt, candk, cands); } } while (0)
    u32x2 r0, r1, r2, r3;
    IX_LD(0, r0); IX_LD(1, r1); IX_LD(2, r2); IX_LD(3, r3);
#pragma unroll 1
    for (int i = 0; i < nb; i += 4) { IX_DO(i, r0); IX_DO(i + 1, r1); IX_DO(i + 2, r2); IX_DO(i + 3, r3); }
#undef IX_LD
#undef IX_DO
}
__device__ __forceinline__ void ix_search(IxTeam& tm, LAS unsigned* hist, LAS int* segsum, LAS int* needv, LAS int* outB, LAS int* outG, LAS int* outC) {
    const int qn = tm.ttid >> 4, seg = tm.ttid & 15;
    { int sum = 0;
#pragma unroll 4
      for (int w = 0; w < 32; ++w) sum += (int)hist[qn * 512 + seg * 32 + w];
      segsum[qn * 16 + seg] = sum; }
    team_sync(tm);
    { const int need = needv[qn]; int above = 0;
#pragma unroll 1
      for (int s2 = seg + 1; s2 < 16; ++s2) above += segsum[qn * 16 + s2];
      const int mine = segsum[qn * 16 + seg];
      if (above < need && above + mine >= need) { int cum = above;
#pragma unroll 1
          for (int bin = seg * 32 + 31; bin >= seg * 32; --bin) { const int cnt = (int)hist[qn * 512 + bin];
              if (cum + cnt >= need) { outB[qn] = bin; outG[qn] = cum; outC[qn] = cnt; break; } cum += cnt; } } }
    team_sync(tm);
}
__device__ __forceinline__ void indexer_unit(const Params& p, IxTeam& tm, unsigned short* KS, int b, int qg) {
    int ttid = tm.ttid, lane = tm.lane; const int tw = tm.tw; LAS unsigned char* lds = tm.lds;
    asm volatile("" : "+v"(ttid), "+v"(lane));
    LAS unsigned* hist = (LAS unsigned*)(lds + IX_HIST);
    LAS unsigned* mrow = (LAS unsigned*)(lds + IX_MASK);
    LAS int* candk = (LAS int*)(lds + IX_CAND);
    LAS int* cands = (LAS int*)(lds + IX_CAND + 8192);
    LAS int* ccnt = (LAS int*)(lds + IX_MISC);
    LAS int* thrB = ccnt + 16; LAS int* thrG = ccnt + 32; LAS int* thrC = ccnt + 48;
    LAS int* thrB1 = ccnt + 64; LAS int* thrG1 = ccnt + 80; LAS int* thrC1 = ccnt + 96; LAS int* needv = ccnt + 112;
    LAS int* segsum = ccnt + 128;
    unsigned* MASK = (unsigned*)(p.ws + WS_MASK);
    const int t0 = qg * 16; const size_t rowb = (size_t)b * SEQ;
    if (qg < 16) {
        for (int i = ttid; i < 2048; i += 256) { const int n = i >> 7, w = i & 127, tq = t0 + n; const int s0 = 32 * w;
            const unsigned m = tq >= s0 + 31 ? 0xffffffffu : (tq < s0 ? 0u : ((2u << (tq - s0)) - 1u));
            MASK[(rowb + t0) * 128 + i] = m; }
        return;
    }
    for (int i = ttid; i < (8192 + 16 * IX_MROW) / 4; i += 256) ((LAS u32x4*)hist)[i] = (u32x4){0u, 0u, 0u, 0u};
    if (ttid < 16) { ccnt[ttid] = 0; needv[ttid] = 256; }
    const bf16_t* QI = (const bf16_t*)(p.ws + WS_QI); const bf16_t* KNb = (const bf16_t*)(p.ws + WS_KN) + rowb * 64; const float* MISC = (const float*)(p.ws + WS_MISC);
    const int n = lane & 15, quad = lane >> 4, tq = t0 + n;
    bf16x8 qf[9][2]; float hw[8];
#pragma unroll
    for (int h = 0; h < 8; ++h) { hw[h] = MISC[(rowb + tq) * 80 + 64 + h] * (0.5f * 0.125f * 0.35355339059327373f);
#pragma unroll
        for (int ks = 0; ks < 2; ++ks) qf[h][ks] = *(const bf16x8*)(QI + (rowb + tq) * 512 + h * 64 + ks * 32 + quad * 8); }
    { float s2 = 0.f;
#pragma unroll
      for (int h = 0; h < 8; ++h) { float qq = 0.f;
#pragma unroll
          for (int ks = 0; ks < 2; ++ks)
#pragma unroll
              for (int i = 0; i < 8; ++i) { const float e = bf2f((bf16_t)qf[h][ks][i]); qq = __builtin_fmaf(e, e, qq); }
          s2 = __builtin_fmaf(hw[h] * hw[h], qq, s2); }
      s2 = xrow_sum(s2);
      const float rs = rsqrtf(fmaxf(s2, 1e-30f));
#pragma unroll
      for (int h = 0; h < 8; ++h) hw[h] *= rs; }
#pragma unroll
    for (int ks = 0; ks < 2; ++ks)
#pragma unroll
        for (int i = 0; i < 8; i += 2) { float e0 = 0.f, e1 = 0.f;
#pragma unroll
            for (int h = 0; h < 8; ++h) { e0 = __builtin_fmaf(hw[h], bf2f((bf16_t)qf[h][ks][i]), e0); e1 = __builtin_fmaf(hw[h], bf2f((bf16_t)qf[h][ks][i + 1]), e1); }
            qf[8][ks][i] = (short)f2bf(e0); qf[8][ks][i + 1] = (short)f2bf(e1); }
    team_sync(tm);
    ix_passA(KNb, qf, hw, qg, tw, quad, n, tq, hist, KS);
    team_sync(tm);
    ix_search(tm, hist, segsum, needv, thrB, thrG, thrC);
    IxSel S; S.B0 = thrB[n]; S.Klo = (unsigned)S.B0 << 7; S.Khi = S.Klo | 127u;
    int refined;
    { int mx = 0;
#pragma unroll
      for (int q = 0; q < 16; ++q) mx = max(mx, thrC[q]);
      refined = mx > IX_CAP / 2; }
    if (refined) {
        team_sync(tm);
        for (int i = ttid; i < 8192 / 4; i += 256) ((LAS u32x4*)hist)[i] = (u32x4){0u, 0u, 0u, 0u};
        if (ttid < 16) needv[ttid] = 256 - thrG[ttid];
        team_sync(tm);
        ix_passK<1>(KS, qg, tw, quad, n, tq, S, hist, mrow, ccnt, candk, cands);
        team_sync(tm);
        ix_search(tm, hist, segsum, needv, thrB1, thrG1, thrC1);
        S.Klo = ((unsigned)S.B0 << 7) | (unsigned)thrB1[n]; S.Khi = S.Klo;
    }
    ix_passK<2>(KS, qg, tw, quad, n, tq, S, hist, mrow, ccnt, candk, cands);
    team_sync(tm);
    { const int qn = ttid >> 4, sub = ttid & 15; const int nc = min(ccnt[qn], IX_CAP), need = 256 - thrG[qn] - (refined ? thrG1[qn] : 0);
#ifdef MK_CHK
      if (ccnt[qn] > MK_CHK) ((unsigned*)(p.ws + WS_CTL))[50] = 2u;
#endif
      for (int c = sub; c < nc; c += 16) { const int v = candk[qn * IX_CAP + c]; const int s = cands[qn * IX_CAP + c]; int rank = 0;
          const int vs = (v << 12) | (4095 - s);
#pragma unroll 8
          for (int c2 = 0; c2 < ((nc + 7) & ~7); ++c2) { const int w2 = c2 < nc ? ((candk[qn * IX_CAP + c2] << 12) | (4095 - cands[qn * IX_CAP + c2])) : 0; rank += (w2 > vs) ? 1 : 0; }
          if (rank < need) __hip_atomic_fetch_or(&mrow[qn * IX_MROW + (s >> 5)], 1u << (s & 31), __ATOMIC_RELAXED, __HIP_MEMORY_SCOPE_WORKGROUP); } }
    team_sync(tm);
    for (int i = ttid; i < 2048; i += 256) MASK[(rowb + t0) * 128 + i] = mrow[(i >> 7) * IX_MROW + (i & 127)];
    team_sync(tm);
}

constexpr int RT_WPITCH = 1028;
constexpr size_t WS_WGT = WS_CTL + 131072;
__device__ __forceinline__ void phase_ln_router(const Params& p, LAS unsigned char* lds, bool dry = false) {
    const int tid = mk_tid(), lane = tid & 63, wave = tid >> 6;
    LAS float* WE = (LAS float*)lds;
    constexpr int OFF_MISC = 32 * RT_WPITCH * 4;
    LAS int* lcnt = (LAS int*)(lds + OFF_MISC);
    LAS int* lbase = lcnt + 32;
    LAS unsigned short* tks = (LAS unsigned short*)(lcnt + 64);
    LAS unsigned char* tke = (LAS unsigned char*)(tks + 512);
    LAS float* lgs = (LAS float*)(lds + OFF_MISC + 256 + 1024 + 512) + wave * 576;
    static_assert(OFF_MISC + 256 + 1024 + 512 + 8 * 576 * 4 <= LDS_TOTAL - 64, "router LDS map");
    for (int i = tid; i < 1024 * 32; i += NTHREADS) WE[(i & 31) * RT_WPITCH + (i >> 5)] = p.in[23][i];
    const bf16_t* H = (const bf16_t*)p.out; bf16_t* H1B = (bf16_t*)(p.ws + WS_H1B); const float* WGT = (const float*)(p.ws + WS_WGT);
    int* EID = (int*)(p.ws + WS_EID); float* GATE = (float*)(p.ws + WS_GATE); int* SLOT = (int*)(p.ws + WS_SLOT); unsigned* gcnt = (unsigned*)(p.ws + WS_CTL);
    const float* g1 = p.in[19]; const float* b1 = p.in[20];
    const int tokr = lane & 15, kq = lane >> 4;
    const LAS float* we0 = WE + tokr * RT_WPITCH + 8 * kq; const LAS float* we1 = we0 + 16 * RT_WPITCH;
    const float* wg = WGT + (tokr & 3) * 1024 + 8 * kq;
    for (int tile = blockIdx.x; tile < T / 256; tile += gridDim.x) {
        if (tid < 32) lcnt[tid] = 0;
        __syncthreads();
        const int tokA = tile * 256 + wave * 32 + tokr;
        const u32x4* hrow = (const u32x4*)(H + (size_t)tokA * DM) + kq;
        u32x4* orow = (u32x4*)(H1B + (size_t)tokA * DM) + kq;
        constexpr int GS = 16 * (DM / 8);
        float mean[2], rstd[2];
        { const float* L = (const float*)((const char*)p.out + DO_LNS);
#pragma unroll
          for (int gq = 0; gq < 2; ++gq) { const f32x4* q4 = (const f32x4*)(L + ((size_t)(tokA + 16 * gq) * 16 + 4 * kq) * 2); const f32x4 a = q4[0], b = q4[1];
              const float sm = xrow_sum((a.x + a.z) + (b.x + b.z)), sq = xrow_sum((a.y + a.w) + (b.y + b.w));
              mean[gq] = sm * (1.f / DM); rstd[gq] = __builtin_amdgcn_rsqf(fmaxf(sq * (1.f / DM) - mean[gq] * mean[gq], 0.f) + 1e-5f); } }
        f32x4 acc[2][3];
#pragma unroll
        for (int gq = 0; gq < 2; ++gq)
#pragma unroll
            for (int o = 0; o < 3; ++o) acc[gq][o] = (f32x4){0.f, 0.f, 0.f, 0.f};
        {
          u32x4 wA = hrow[0], wB = hrow[GS];
          f32x4 g[2], bb[2], b2[2], b0[2], b1v[2];
#pragma unroll
          for (int h = 0; h < 2; ++h) { g[h] = *(const f32x4*)(g1 + 8 * kq + 4 * h); bb[h] = *(const f32x4*)(b1 + 8 * kq + 4 * h); b2[h] = *(const f32x4*)(wg + 4 * h);
              b0[h] = *(const LAS f32x4*)(we0 + 4 * h); b1v[h] = *(const LAS f32x4*)(we1 + 4 * h); }
#pragma unroll 2
          for (int S = 0; S < 32; ++S) { const int sn = (S + 1) & 31;
              const u32x4 nwA = hrow[4 * sn], nwB = hrow[GS + 4 * sn];
              f32x4 ng[2], nbb[2], nb2[2], nb0[2], nb1v[2];
#pragma unroll
              for (int h = 0; h < 2; ++h) { ng[h] = *(const f32x4*)(g1 + 32 * sn + 8 * kq + 4 * h); nbb[h] = *(const f32x4*)(b1 + 32 * sn + 8 * kq + 4 * h); nb2[h] = *(const f32x4*)(wg + 32 * sn + 4 * h);
                  nb0[h] = *(const LAS f32x4*)(we0 + 32 * sn + 4 * h); nb1v[h] = *(const LAS f32x4*)(we1 + 32 * sn + 4 * h); }
              __builtin_amdgcn_sched_barrier(0);
              f32x4 hv[2][2];
#pragma unroll
              for (int gq = 0; gq < 2; ++gq) { const u32x4 w = gq ? wB : wA;
                  hv[gq][0] = ((f32x4){bflo(w.x), bfhi(w.x), bflo(w.y), bfhi(w.y)} - mean[gq]) * rstd[gq] * g[0] + bb[0];
                  hv[gq][1] = ((f32x4){bflo(w.z), bfhi(w.z), bflo(w.w), bfhi(w.w)} - mean[gq]) * rstd[gq] * g[1] + bb[1];
                  orow[gq * GS + 4 * S] = (u32x4){pk2(hv[gq][0].x, hv[gq][0].y), pk2(hv[gq][0].z, hv[gq][0].w), pk2(hv[gq][1].x, hv[gq][1].y), pk2(hv[gq][1].z, hv[gq][1].w)}; }
#pragma unroll
              for (int h = 0; h < 2; ++h)
#pragma unroll
                  for (int j = 0; j < 4; ++j)
#pragma unroll
                      for (int gq = 0; gq < 2; ++gq) { acc[gq][0] = __builtin_amdgcn_mfma_f32_16x16x4f32(hv[gq][h][j], b0[h][j], acc[gq][0], 0, 0, 0);
                          acc[gq][1] = __builtin_amdgcn_mfma_f32_16x16x4f32(hv[gq][h][j], b1v[h][j], acc[gq][1], 0, 0, 0); acc[gq][2] = __builtin_amdgcn_mfma_f32_16x16x4f32(hv[gq][h][j], b2[h][j], acc[gq][2], 0, 0, 0); }
              wA = nwA; wB = nwB;
#pragma unroll
              for (int h = 0; h < 2; ++h) { g[h] = ng[h]; bb[h] = nbb[h]; b2[h] = nb2[h]; b0[h] = nb0[h]; b1v[h] = nb1v[h]; } } }
#pragma unroll
        for (int it = 0; it < 2; ++it) {
            const int tl0 = wave * 32 + it * 16;
            const f32x4 acc0 = acc[it][0], acc1 = acc[it][1], acc2 = acc[it][2];
#pragma unroll
            for (int j = 0; j < 4; ++j) { LAS float* lr = lgs + (4 * kq + j) * 36; lr[4 + tokr] = acc0[j]; lr[20 + tokr] = acc1[j]; if (tokr < 4) lr[tokr] = acc2[j]; }
            asm volatile("s_waitcnt lgkmcnt(0)" ::: "memory");
            if (lane < 16) {
                const int t = lane, tl = tl0 + t, tokt = tile * 256 + tl; const LAS float* lg = lgs + t * 36;
                float gl[4];
#pragma unroll
                for (int o = 0; o < 4; ++o) gl[o] = lg[o] + p.in[22][o];
                float gm = gl[0]; int gs = 0;
#pragma unroll
                for (int o = 1; o < 4; ++o) if (gl[o] > gm) { gm = gl[o]; gs = o; }
                float gden = 0.f;
#pragma unroll
                for (int o = 0; o < 4; ++o) gden += __expf(gl[o] - gm);
                const float pg = 1.f / gden;
                float el[8];
#pragma unroll
                for (int o = 0; o < 8; ++o) el[o] = lg[4 + gs * 8 + o] + p.in[24][gs * 8 + o];
                float m1 = el[0]; int i1 = 0;
#pragma unroll
                for (int o = 1; o < 8; ++o) if (el[o] > m1) { m1 = el[o]; i1 = o; }
                float m2 = -INFINITY; int i2 = 0;
#pragma unroll
                for (int o = 0; o < 8; ++o) if (o != i1 && el[o] > m2) { m2 = el[o]; i2 = o; }
                const float e2 = __expf(m2 - m1); const float ga = pg / (1.f + e2), gb = pg * e2 / (1.f + e2);
                const int ea = gs * 8 + i1, eb = gs * 8 + i2;
                EID[tokt * 2] = ea; EID[tokt * 2 + 1] = eb; GATE[tokt * 2] = ga; GATE[tokt * 2 + 1] = gb;
                tke[tl * 2] = (unsigned char)ea; tke[tl * 2 + 1] = (unsigned char)eb;
                tks[tl * 2] = (unsigned short)__hip_atomic_fetch_add(&lcnt[ea], 1, __ATOMIC_RELAXED, __HIP_MEMORY_SCOPE_WORKGROUP);
                tks[tl * 2 + 1] = (unsigned short)__hip_atomic_fetch_add(&lcnt[eb], 1, __ATOMIC_RELAXED, __HIP_MEMORY_SCOPE_WORKGROUP);
            }
        }
        __syncthreads();
        if (tid < 32 && !dry) lbase[tid] = (int)__hip_atomic_fetch_add(&gcnt[tid], (unsigned)lcnt[tid], __ATOMIC_RELAXED, __HIP_MEMORY_SCOPE_AGENT);
        __syncthreads();
        if (!dry) { const int e_ = tke[tid], sl_ = lbase[e_] + (int)tks[tid]; SLOT[tile * 512 + tid] = sl_; ((int*)(p.ws + WS_TOKMAP))[e_ * 65536 + sl_] = tile * 256 + (tid >> 1); }
        __syncthreads();
    }
}

__device__ __forceinline__ void phase_permute(const Params& p, LAS int* tab) {
    const int tid = mk_tid(), lane = tid & 63, wave = tid >> 6;
    const int gw = blockIdx.x * NWAVES + wave, NGW = gridDim.x * NWAVES;
    const int* EID = (const int*)(p.ws + WS_EID); const int* SLOT = (const int*)(p.ws + WS_SLOT);
    const u32x4* H1B = (const u32x4*)(p.ws + WS_H1B); u32x4* XS = (u32x4*)(p.ws + WS_XS);
    for (int i = gw; i < T * 2; i += NGW) { const int tok = i >> 1; const int dst = tab[1024 + EID[i]] + SLOT[i];
        const u32x4 a = H1B[(size_t)tok * 128 + lane], b2 = H1B[(size_t)tok * 128 + 64 + lane];
        XS[(size_t)dst * 128 + lane] = a; XS[(size_t)dst * 128 + 64 + lane] = b2; }
}

__device__ __forceinline__ void phase_final(const Params& p, LAS int* tab, bool dry = false) {
    const int tid = mk_tid(), lane = tid & 63, wave = tid >> 6;
    const int gw = blockIdx.x * NWAVES + wave, NGW = gridDim.x * NWAVES;
    const int* EID = (const int*)(p.ws + WS_EID); const int* SLOT = (const int*)(p.ws + WS_SLOT); const float* GATE = (const float*)(p.ws + WS_GATE);
    const bf16_t* YS = (const bf16_t*)(p.ws + WS_XS); const float alpha = 1.189207115002721f;
    const float* g2 = p.in[28]; const float* b2 = p.in[29];
    float tsscale = 1.f;
#ifdef MK_TS
    { const volatile unsigned long long* ts = (const volatile unsigned long long*)(p.ws + WS_CTL) + 32; float f = (float)ts[1] * 1e-5f - (MK_TS == 4 ? 0.7f : 0.f); f = f > 1.f ? 1.f : (f < 0.f ? 0.f : f); tsscale = 1.f + sqrtf(3e-4f * f); }
#endif
#ifdef MK_CHK
#ifndef MK_CHKSEL
#define MK_CHKSEL 7
#endif
    { const volatile unsigned* cw = (const volatile unsigned*)(p.ws + WS_CTL); const bool bad = ((MK_CHKSEL & 1) && cw[50] == 1u) || ((MK_CHKSEL & 4) && cw[50] == 2u) || ((MK_CHKSEL & 2) && cw[51] != 0u);
      if (bad && blockIdx.x == 0 && tid == 0) p.out[0] = __builtin_nanf(""); }
#endif
    for (int tok0 = gw * 2; tok0 < T; tok0 += NGW * 2) {
        int r0[2], r1[2]; float ga[2], gb[2]; unsigned long long hw_[2][4], ya[2][4], yb[2][4];
#pragma unroll
        for (int q = 0; q < 2; ++q) { const int tok = tok0 + q; r0[q] = tab[1024 + EID[tok * 2]] + SLOT[tok * 2]; r1[q] = tab[1024 + EID[tok * 2 + 1]] + SLOT[tok * 2 + 1]; ga[q] = GATE[tok * 2]; gb[q] = GATE[tok * 2 + 1]; }
#pragma unroll
        for (int q = 0; q < 2; ++q) { const int tok = tok0 + q; const unsigned long long* hb = (const unsigned long long*)((const bf16_t*)(p.ws + WS_H1B) + (size_t)tok * DM);
#pragma unroll
            for (int j = 0; j < 4; ++j) { hw_[q][j] = hb[lane + 64 * j]; ya[q][j] = ((const unsigned long long*)(YS + (size_t)r0[q] * DM))[lane + 64 * j]; yb[q][j] = ((const unsigned long long*)(YS + (size_t)r1[q] * DM))[lane + 64 * j]; } }
#pragma unroll
        for (int q = 0; q < 2; ++q) { const int tok = tok0 + q; f32x4* hr = (f32x4*)(p.out + (size_t)tok * DM) + lane; f32x4 v[4]; float s = 0.f;
#pragma unroll
            for (int j = 0; j < 4; ++j) { const unsigned h0 = (unsigned)hw_[q][j], h1_ = (unsigned)(hw_[q][j] >> 32); const f32x4 hv = {bflo(h0), bfhi(h0), bflo(h1_), bfhi(h1_)};
                const unsigned a0 = (unsigned)ya[q][j], a1 = (unsigned)(ya[q][j] >> 32), c0 = (unsigned)yb[q][j], c1 = (unsigned)(yb[q][j] >> 32);
                v[j].x = alpha * hv.x + ga[q] * bflo(a0) + gb[q] * bflo(c0); v[j].y = alpha * hv.y + ga[q] * bfhi(a0) + gb[q] * bfhi(c0);
                v[j].z = alpha * hv.z + ga[q] * bflo(a1) + gb[q] * bflo(c1); v[j].w = alpha * hv.w + ga[q] * bfhi(a1) + gb[q] * bfhi(c1);
                s += (v[j].x + v[j].y) + (v[j].z + v[j].w); }
            const float mean = wave_sum(s) * (1.f / DM); float s2 = 0.f;
#pragma unroll
            for (int j = 0; j < 4; ++j) { v[j] = v[j] - mean; s2 += (v[j].x * v[j].x + v[j].y * v[j].y) + (v[j].z * v[j].z + v[j].w * v[j].w); }
            const float rstd = __builtin_amdgcn_rsqf(wave_sum(s2) * (1.f / DM) + 1e-5f);
#pragma unroll
            for (int j = 0; j < 4; ++j) { const f32x4 g = ((const f32x4*)g2)[lane + 64 * j], bb = ((const f32x4*)b2)[lane + 64 * j]; const f32x4 o = (v[j] * rstd * g + bb) * tsscale; if (!dry) hr[64 * j] = o; } }
    }
}

#ifdef MK_CHK
#ifndef MK_CHK_MISM
#define MK_CHK_MISM 16
#endif
#ifndef MK_CHK_ATT
#define MK_CHK_ATT 1e-3f
#endif
__device__ __forceinline__ void phase_check(const Params& p, LAS unsigned char* lds) {
    const int tid = mk_tid(), blk = blockIdx.x;
    LAS float* sc = (LAS float*)lds;
    LAS int* red = (LAS int*)(lds + 16384);
    LAS float* redf = (LAS float*)(lds + 16384 + 64);
    LAS float* ov = (LAS float*)(lds + 16384 + 128);
    const int b = blk & 15, t = ((blk >> 4) * 263 + 290 + 37 * blk) & 4095, h = (blk >> 2) & 7;
    const size_t rowb = (size_t)b * SEQ, row = rowb + t;
    const bf16_t* QI = (const bf16_t*)(p.ws + WS_QI); const bf16_t* KN = (const bf16_t*)(p.ws + WS_KN); const float* MISC = (const float*)(p.ws + WS_MISC);
    const unsigned* MASK = (const unsigned*)(p.ws + WS_MASK) + row * 128;
    unsigned* ctl = (unsigned*)(p.ws + WS_CTL);
    if (tid < 8) red[tid] = 0; if (tid < 4) redf[tid] = 0.f; if (tid < 64) ov[tid] = 0.f;
    for (int s_ = tid; s_ <= t; s_ += NTHREADS) { float acc = 0.f;
        for (int hh = 0; hh < 8; ++hh) { float d = 0.f; for (int k = 0; k < 64; ++k) d += bf2f(QI[row * 512 + hh * 64 + k]) * bf2f(KN[(rowb + s_) * 64 + k]);
            acc += (MISC[row * 80 + 64 + hh] * 0.35355339059327373f) * fmaxf(d * 0.125f, 0.f); }
        sc[s_] = acc; }
    __syncthreads();
    int mism = 0, pc = 0;
    for (int s_ = tid; s_ <= t; s_ += NTHREADS) { const float v = sc[s_]; int rank = 0;
        for (int s2 = 0; s2 <= t; ++s2) { const float v2 = sc[s2]; rank += (v2 > v || (v2 == v && s2 < s_)) ? 1 : 0; }
        const int ref = rank < 256 ? 1 : 0, got = (int)((MASK[s_ >> 5] >> (s_ & 31)) & 1u); mism += ref != got; pc += got; }
    for (int s_ = t + 1 + tid; s_ < 4096; s_ += NTHREADS) pc += 4096 * (int)((MASK[s_ >> 5] >> (s_ & 31)) & 1u);
    __hip_atomic_fetch_add(&red[0], mism, __ATOMIC_RELAXED, __HIP_MEMORY_SCOPE_WORKGROUP); __hip_atomic_fetch_add(&red[1], pc, __ATOMIC_RELAXED, __HIP_MEMORY_SCOPE_WORKGROUP);
    __syncthreads();
    if (tid == 0) { const int want = t + 1 < 256 ? t + 1 : 256; if (red[1] != want) ctl[50] = 2u; else if (red[0] > MK_CHK_MISM) ctl[50] = 1u; }
    const bf16_t* Q = (const bf16_t*)(p.ws + WS_Q); const bf16_t* K = (const bf16_t*)(p.ws + WS_K); const bf16_t* V = (const bf16_t*)(p.ws + WS_V); const bf16_t* YB = (const bf16_t*)(p.ws + WS_YB);
    __syncthreads();
    for (int s_ = tid; s_ <= t; s_ += NTHREADS) { float l = -INFINITY;
        if ((MASK[s_ >> 5] >> (s_ & 31)) & 1u) { float d = 0.f; for (int k = 0; k < 64; ++k) d += bf2f(Q[row * 512 + h * 64 + k]) * bf2f(K[(rowb + s_) * 512 + h * 64 + k]);
            const int dist = t - s_; int bk = dist; if (dist >= 16) { bk = 16 + (int)(log2f((float)dist * 0.0625f) * (16.f / 3.f)); bk = bk > 31 ? 31 : bk; }
            l = d + p.in[16][bk * 8 + h] * 1.4426950408889634f; }
        sc[s_] = l; }
    __syncthreads();
    float mx = -INFINITY; for (int s_ = 0; s_ <= t; ++s_) mx = fmaxf(mx, sc[s_]);
    float den = 0.f; for (int s_ = 0; s_ <= t; ++s_) den += exp2f(sc[s_] - mx);
    { const int d = tid & 63, part = tid >> 6; float o = 0.f;
      for (int s_ = part; s_ <= t; s_ += 8) { const float l = sc[s_]; if (l > -INFINITY) o += exp2f(l - mx) * bf2f(V[(rowb + s_) * 512 + h * 64 + d]); }
      __hip_atomic_fetch_add(&ov[d], o / den, __ATOMIC_RELAXED, __HIP_MEMORY_SCOPE_WORKGROUP); }
    __syncthreads();
    if (tid < 64) { const float ref = ov[tid], got = bf2f(YB[row * 512 + h * 64 + tid]); const float df = ref - got;
        __hip_atomic_fetch_add(&redf[0], df * df, __ATOMIC_RELAXED, __HIP_MEMORY_SCOPE_WORKGROUP); __hip_atomic_fetch_add(&redf[1], ref * ref, __ATOMIC_RELAXED, __HIP_MEMORY_SCOPE_WORKGROUP); }
    __syncthreads();
    if (tid == 0) { if (!(redf[0] <= MK_CHK_ATT * redf[1] + 1e-12f)) ctl[51] = 1u; }
    __syncthreads();
}
#endif
constexpr int NPHASE = 14;
template <int PH> __device__ __forceinline__ void run_phase(const Params& p, unsigned char* lds_g) {
    LAS unsigned char* lds = (LAS unsigned char*)lds_g;
    const int G = gridDim.x, c = blockIdx.x;
    if constexpr (PH == 0) phase_prologue(p, lds);
    if constexpr (PH == 1) { Gemm g{(const bf16_t*)((char*)p.out + DO_XBF), (const bf16_t*)(p.ws + WS_WTIN), T, 6144, 1024}; pg8::StaticOrder S; S.init(T, 6144, G, c);
        EpiIn E{p.ws}; pg8::gemm_phase<EpiIn, pg8::StaticOrder, true, true>(lds, g, S, E); }
    if constexpr (PH == 2) phase_prep(p);
    if constexpr (PH == 3) { Gemm g{(const bf16_t*)(p.ws + WS_AP), (const bf16_t*)(p.ws + WS_WTLORA), T, 1536, 256}; pg8::StaticOrder S; S.init(T, 1536, G, c);
        EpiLora E{(char*)p.out}; pg8::gemm_phase<EpiLora, pg8::StaticOrder, true, true>(lds, g, S, E); }
    if constexpr (PH == 4) {
        for (int bh = c; bh < 128; bh += G) scan_item(p, lds, bh);
        __syncthreads();
        { const int tid_ = mk_tid(); IxTeam tm; tm.tw = __builtin_amdgcn_readfirstlane((tid_ >> 6) & 3); tm.ttid = tid_ & 255; tm.lane = tid_ & 63; const int team = __builtin_amdgcn_readfirstlane(tid_ >> 8);
          tm.lds = lds + team * IX_TEAM_BYTES; tm.bar = (LAS unsigned*)(lds + IX_CTL + team * 16); tm.gen = 0u;
          if (tm.ttid < 4) tm.bar[tm.ttid] = 0u;
          __syncthreads();
          unsigned short* KS = (unsigned short*)(p.ws + (team ? WS_YB : WS_AP)) + (size_t)blockIdx.x * 65536;
          for (int qi = 0; qi < 8; ++qi) { const int xq = (c + qi) & 7; unsigned* qctr = (unsigned*)(p.ws + WS_CTL) + 40 + xq;
              for (;;) { team_sync(tm); if (tm.ttid == 0) tm.bar[2] = __hip_atomic_fetch_add(qctr, 1u, __ATOMIC_RELAXED, __HIP_MEMORY_SCOPE_AGENT); team_sync(tm);
                  const unsigned u = tm.bar[2]; if (u >= 512u) break; indexer_unit(p, tm, KS, 2 * xq + (int)(u & 1u), 255 - (int)(u >> 1)); } } }
    }
    if constexpr (PH == 6) {
        LAS float* bd = (LAS float*)(lds + attn_body::LDS_BIAS);
        for (int i = mk_tid(); i < 8 * 128; i += NTHREADS) { const int h = i >> 7, d = i & 127; int bk = d;
            if (d >= 16) { bk = 16 + (int)(log2f((float)d * 0.0625f) * (16.f / 3.f)); bk = bk > 31 ? 31 : bk; }
            bd[i] = (p.in[16][bk * 8 + h] - p.in[16][31 * 8 + h]) * 1.4426950408889634f; }
        __syncthreads();
        for (int v = c; v < 256; v += G) { const int bh = v >> 1, od = v & 1;
            for (int i = 0; i < 8; ++i) { const int pr = 2 * (i >> 1) + od; const int qb = (i & 1) ? 15 - pr : pr;
                attn_body::attn_unit<8>(bh >> 3, bh & 7, qb, (const attn_body::bf16*)(p.ws + WS_Q), (const attn_body::bf16*)(p.ws + WS_K), (const attn_body::bf16*)(p.ws + WS_V),
                                        (attn_body::bf16*)(p.ws + WS_YB), (const unsigned long long*)(p.ws + WS_MASK), (char*)lds_g); } }
    }
    if constexpr (PH == 7) { Gemm g{(const bf16_t*)((char*)p.out + DO_YA), (const bf16_t*)(p.ws + WS_WTA), T, 1024, 512}; pg8::StaticOrder S; S.init(T, 1024, G, c);
        EpiGateMul E{(const bf16_t*)(p.ws + WS_SGA), (bf16_t*)(p.ws + WS_MA), nullptr}; pg8::gemm_phase<EpiGateMul, pg8::StaticOrder, true, true>(lds, g, S, E); }
    if constexpr (PH == 8) { Gemm g{(const bf16_t*)(p.ws + WS_YB), (const bf16_t*)(p.ws + WS_WTB), T, 1024, 512}; pg8::StaticOrder S; S.init(T, 1024, G, c);
        EpiGateMul E{(const bf16_t*)(p.ws + WS_SGB), (bf16_t*)(p.ws + WS_SGA), (const bf16_t*)(p.ws + WS_MA)}; pg8::gemm_phase<EpiGateMul, pg8::StaticOrder, true, true>(lds, g, S, E); }
    if constexpr (PH == 9) { Gemm g{(const bf16_t*)(p.ws + WS_SGA), (const bf16_t*)(p.ws + WS_WTOUT), T, 1024, 1024}; pg8::StaticOrder S; S.init(T, 1024, G, c);
        EpiResid E{p.in[0], (bf16_t*)p.out}; pg8::gemm_phase<EpiResid, pg8::StaticOrder, true, true>(lds, g, S, E); }
    if constexpr (PH == 10) phase_ln_router(p, lds);
    if constexpr (PH == 11) { LAS int* tab = (LAS int*)(lds + LDS_TAB); moe_tables(p, tab); phase_permute(p, tab); }
    if constexpr (PH == 12) { LAS int* tab = (LAS int*)(lds + LDS_TAB); moe_tables(p, tab);
        { Gemm g{(const bf16_t*)(p.ws + WS_H1B), (const bf16_t*)(p.ws + WS_WTGU), NROWS_PAD, 32 * 1024, 1024}; MoeOrder S{tab, G, c, (const int*)(p.ws + WS_TOKMAP)};
          EpiSwiglu E{(bf16_t*)(p.ws + WS_ACT)}; pg8::gemm_phase<EpiSwiglu, MoeOrder, true, true, true>(lds, g, S, E); } }
    if constexpr (PH == 13) { LAS int* tab = (LAS int*)(lds + LDS_TAB); moe_tables(p, tab);
        { Gemm g{(const bf16_t*)(p.ws + WS_ACT), (const bf16_t*)(p.ws + WS_WTDN), NROWS_PAD, 32 * 1024, 512}; MoeOrder S{tab, G, c, nullptr};
          EpiDown E{(bf16_t*)(p.ws + WS_XS)}; pg8::gemm_phase<EpiDown, MoeOrder, true, true>(lds, g, S, E); } }
    if constexpr (PH == 14) { LAS int* tab = (LAS int*)(lds + LDS_TAB); moe_tables(p, tab); phase_final(p, tab); }
}

template <int PH> __global__ void __launch_bounds__(NTHREADS, 2) k_phase(Params p) {
    extern __shared__ __attribute__((aligned(16))) unsigned char lds[];
    run_phase<PH>(p, lds);
}
__global__ void __launch_bounds__(NTHREADS, 2) k_all(Params p) {
    extern __shared__ __attribute__((aligned(16))) unsigned char lds[];
    cooperative_groups::grid_group grid = cooperative_groups::this_grid();
    unsigned* barw = (unsigned*)(p.ws + WS_CTL) + 16384;
    volatile LAS unsigned* bst = (volatile LAS unsigned*)((LAS unsigned char*)lds + LDS_TOTAL - 16);
    if (mk_tid() < 2) bst[mk_tid()] = 0u;
    if (blockIdx.x == 0) for (int i = mk_tid(); i < XCD_BAR_WORDS; i += NTHREADS) barw[i] = 0u;
    __syncthreads();
#ifndef MK_REP
#define MK_REP -1
#endif
#define MK_DRY() (((volatile unsigned*)(p.ws + WS_CTL))[62] == 0u)
#ifdef MK_TS
#define MK_STAMP(n) do { if (blockIdx.x == 0 && mk_tid() == 0) { const unsigned long long t_ = __builtin_amdgcn_s_memrealtime(); volatile unsigned long long* q_ = (volatile unsigned long long*)(p.ws + WS_CTL) + 32; if ((n) == MK_TS) q_[1] = t_ - q_[3]; q_[3] = t_; } } while (0)
#else
#define MK_STAMP(n) do {} while (0)
#endif
#define MK_PH(n) do { run_phase<n>(p, lds); xcd_barrier(bar); MK_STAMP(n); if (MK_REP == (n)) { run_phase<n>(p, lds); xcd_barrier(bar); } } while (0)
#ifdef MK_TS
    if (blockIdx.x == 0 && mk_tid() == 0) { ((volatile unsigned long long*)(p.ws + WS_CTL))[32] = 0; ((volatile unsigned long long*)(p.ws + WS_CTL))[35] = __builtin_amdgcn_s_memrealtime(); }
#endif
    run_phase<0>(p, lds); grid.sync(); MK_STAMP(0);
    const XcdBarrier bar = xcd_barrier_post(barw, bst);
    MK_PH(1); MK_PH(2); MK_PH(3); MK_PH(4);
    if (MK_REP == 44) { if (blockIdx.x == 0 && mk_tid() < 8) __hip_atomic_store((unsigned*)(p.ws + WS_CTL) + 40 + mk_tid(), 0u, __ATOMIC_RELAXED, __HIP_MEMORY_SCOPE_AGENT); xcd_barrier(bar); run_phase<4>(p, lds); xcd_barrier(bar); }
    MK_PH(6);
#ifdef MK_CHK
    phase_check(p, (LAS unsigned char*)lds); xcd_barrier(bar);
#endif
    run_phase<7>(p, lds); if (MK_REP == 7) run_phase<7>(p, lds);
    MK_PH(8); MK_PH(9); MK_PH(10); MK_PH(12); MK_PH(13);
    if (MK_REP == 200) { for (int i = 0; i < 20; ++i) xcd_barrier(bar); }
#ifdef MK_TS
    if (blockIdx.x == 0 && mk_tid() == 0) ((volatile unsigned long long*)(p.ws + WS_CTL))[34] = __builtin_amdgcn_s_memrealtime();
    xcd_barrier(bar);
#endif
    run_phase<14>(p, lds);
    if (MK_REP == 14) { xcd_barrier(bar); run_phase<14>(p, lds); }
}
}

extern "C" void kernel_launch(void* const* d_in, const int* in_sizes, int n_in, void* d_out, int out_size,
                              void* d_ws, size_t ws_size, hipStream_t stream) {
    mk::Params p{};
    for (int i = 0; i < 30; ++i) p.in[i] = (const float*)d_in[i];
    p.out = (float*)d_out; p.ws = (char*)d_ws;
    if (ws_size < mk::WS_END) { fprintf(stderr, "workspace too small: %zu\n", ws_size); return; }
    static int grid_blocks = 0;
    if (!grid_blocks) {
        int dev = 0, cus = 0, per_cu = 0;
        (void)hipGetDevice(&dev);
        (void)hipDeviceGetAttribute(&cus, hipDeviceAttributeMultiprocessorCount, dev);
        (void)hipFuncSetAttribute((const void*)mk::k_all, hipFuncAttributeMaxDynamicSharedMemorySize, mk::LDS_TOTAL);
        (void)hipOccupancyMaxActiveBlocksPerMultiprocessor(&per_cu, mk::k_all, mk::NTHREADS, mk::LDS_TOTAL);
        grid_blocks = cus * (per_cu > 1 ? 1 : per_cu); if (grid_blocks > 256) grid_blocks = 256;
    }
    void* args[] = {&p};
    hipError_t e = hipLaunchCooperativeKernel((void*)mk::k_all, dim3(grid_blocks), dim3(mk::NTHREADS), args, mk::LDS_TOTAL, stream);
    if (e != hipSuccess) fprintf(stderr, "cooperative launch failed: %s (grid %d)\n", hipGetErrorString(e), grid_blocks);
}
```
